# Optimizing an MI355X kernel written in HIP

```python
import jax, jax.numpy as jnp
from jax import lax
import numpy as np

D_MODEL = 2048
BATCH = 4
SEQ = 2048
DEPTH = 4

CHUNK = 64
N_HEADS = 16
HEAD_DIM = D_MODEL // N_HEADS
D_FF = 5632
BLOCK_Q = 128
LEFT_CHUNKS = 8
BAND = LEFT_CHUNKS + 1
REL_CLIP = 256
N_A = DEPTH // 2
N_B = DEPTH - N_A
EPS = 1e-6

kernel_name = "yoco_stickbreak_chunkband_macaron"


def rms_norm(x, g):
    x32 = x.astype(jnp.float32)
    y = x32 * lax.rsqrt(jnp.mean(x32 * x32, axis=-1, keepdims=True) + EPS)
    return (y * g.astype(jnp.float32)).astype(x.dtype)


def swiglu(x, w_gate, w_up, w_down):
    return (jax.nn.silu(x @ w_gate) * (x @ w_up)) @ w_down


def stick_breaking_attention(q, k, v):
    seq = q.shape[1]
    scale = HEAD_DIM ** -0.5
    outs = []
    for i in range(seq // BLOCK_Q):
        q0 = i * BLOCK_Q
        kl = q0 + BLOCK_Q
        z = jnp.einsum('bqhd,bkhd->bhqk', q[:, q0:kl], k[:, :kl]).astype(jnp.float32) * scale
        t_pos = q0 + jnp.arange(BLOCK_Q)
        s_pos = jnp.arange(kl)
        mask = s_pos[None, :] < t_pos[:, None]
        log_1m = jnp.where(mask, jax.nn.log_sigmoid(-z), 0.0)
        log_a = jax.nn.log_sigmoid(z) + lax.cumsum(log_1m, axis=3, reverse=True) - log_1m
        a = jnp.where(mask, jnp.exp(log_a), 0.0)
        outs.append(jnp.einsum('bhqk,bkhd->bqhd', a.astype(v.dtype), v[:, :kl]))
    out = jnp.concatenate(outs, axis=1)
    return out.reshape(out.shape[0], seq, N_HEADS * HEAD_DIM)


def chunked_band_attention(q, k_pad, v_pad, rel_bias):
    b, seq, h, dh = q.shape
    nc = seq // CHUNK
    scale = HEAD_DIM ** -0.5
    qc = q.reshape(b, nc, CHUNK, h, dh)
    kc = k_pad.reshape(b, nc + LEFT_CHUNKS, CHUNK, h, dh)
    vc = v_pad.reshape(b, nc + LEFT_CHUNKS, CHUNK, h, dh)
    scores = jnp.concatenate(
        [jnp.einsum('bnqhd,bnkhd->bhnqk', qc, kc[:, j:j + nc]) for j in range(BAND)],
        axis=-1).astype(jnp.float32) * scale
    i_pos = jnp.arange(CHUNK)
    p_pos = jnp.arange(BAND * CHUNK)
    rel = LEFT_CHUNKS * CHUNK + i_pos[:, None] - p_pos[None, :]
    idx = jnp.clip(rel, -REL_CLIP, REL_CLIP) + REL_CLIP
    bias = rel_bias[:, idx].astype(jnp.float32)
    c_idx = jnp.arange(nc)
    valid = (c_idx[:, None] - LEFT_CHUNKS + p_pos[None, :] // CHUNK) >= 0
    scores = scores + bias[None, :, None]
    scores = jnp.where(valid[None, None, :, None, :], scores, -jnp.inf)
    probs = jax.nn.softmax(scores, axis=-1).astype(v_pad.dtype)
    out = jnp.einsum('bhnqk,bnkhd->bnqhd', probs[..., :CHUNK], vc[:, 0:nc])
    for j in range(1, BAND):
        out = out + jnp.einsum('bhnqk,bnkhd->bnqhd',
                               probs[..., j * CHUNK:(j + 1) * CHUNK], vc[:, j:j + nc])
    return out.reshape(b, seq, h * dh)


def setup_inputs(seed: int = 0) -> dict:
    key = jax.random.key(seed)
    ks = jax.random.split(key, 16)
    f32 = jnp.float32
    d, f = D_MODEL, D_FF
    x = jax.random.normal(ks[0], (BATCH, SEQ, d), f32)
    g_ffn = 1.0 + 0.05 * jax.random.normal(ks[1], (DEPTH, 2, d), f32)
    w_ffn_gate = jax.random.normal(ks[2], (DEPTH, 2, d, f), f32) * d ** -0.5
    w_ffn_up = jax.random.normal(ks[3], (DEPTH, 2, d, f), f32) * d ** -0.5
    w_ffn_down = jax.random.normal(ks[4], (DEPTH, 2, f, d), f32) * f ** -0.5
    g_mix = 1.0 + 0.05 * jax.random.normal(ks[5], (DEPTH, d), f32)
    w_qkv_a = jax.random.normal(ks[6], (N_A, d, 3 * d), f32) * d ** -0.5
    w_o_a = jax.random.normal(ks[7], (N_A, d, d), f32) * d ** -0.5
    g_kv = 1.0 + 0.05 * jax.random.normal(ks[8], (d,), f32)
    w_kv_shared = jax.random.normal(ks[9], (d, 2 * d), f32) * d ** -0.5
    w_q_b = jax.random.normal(ks[10], (N_B, d, d), f32) * d ** -0.5
    w_o_b = jax.random.normal(ks[11], (N_B, d, d), f32) * d ** -0.5
    rel_bias_b = 0.1 * jax.random.normal(ks[12], (N_B, N_HEADS, 2 * REL_CLIP + 1), f32)
    g_final = 1.0 + 0.05 * jax.random.normal(ks[13], (d,), f32)
    return {"x": x, "g_ffn": g_ffn, "w_ffn_gate": w_ffn_gate, "w_ffn_up": w_ffn_up,
            "w_ffn_down": w_ffn_down, "g_mix": g_mix, "w_qkv_a": w_qkv_a, "w_o_a": w_o_a,
            "g_kv": g_kv, "w_kv_shared": w_kv_shared, "w_q_b": w_q_b, "w_o_b": w_o_b,
            "rel_bias_b": rel_bias_b, "g_final": g_final}


def reference(x, g_ffn, w_ffn_gate, w_ffn_up, w_ffn_down, g_mix, w_qkv_a, w_o_a,
              g_kv, w_kv_shared, w_q_b, w_o_b, rel_bias_b, g_final):
    b, seq, d = x.shape
    h = x
    k_pad = None
    v_pad = None
    for layer in range(DEPTH):
        h = h + 0.5 * swiglu(rms_norm(h, g_ffn[layer, 0]), w_ffn_gate[layer, 0],
                             w_ffn_up[layer, 0], w_ffn_down[layer, 0])
        if layer < N_A:
            u = rms_norm(h, g_mix[layer])
            qkv = (u @ w_qkv_a[layer]).reshape(b, seq, 3, N_HEADS, HEAD_DIM)
            mix = stick_breaking_attention(qkv[:, :, 0], qkv[:, :, 1], qkv[:, :, 2])
            h = h + mix @ w_o_a[layer]
        else:
            if layer == N_A:
                kv = (rms_norm(h, g_kv) @ w_kv_shared).reshape(b, seq, 2, N_HEADS, HEAD_DIM)
                pad = ((0, 0), (LEFT_CHUNKS * CHUNK, 0), (0, 0), (0, 0))
                k_pad = jnp.pad(kv[:, :, 0], pad)
                v_pad = jnp.pad(kv[:, :, 1], pad)
            lb = layer - N_A
            u = rms_norm(h, g_mix[layer])
            q = (u @ w_q_b[lb]).reshape(b, seq, N_HEADS, HEAD_DIM)
            mix = chunked_band_attention(q, k_pad, v_pad, rel_bias_b[lb])
            h = h + mix @ w_o_b[lb]
        h = h + 0.5 * swiglu(rms_norm(h, g_ffn[layer, 1]), w_ffn_gate[layer, 1],
                             w_ffn_up[layer, 1], w_ffn_down[layer, 1])
    return rms_norm(h, g_final)
```

```cpp
#include <hip/hip_runtime.h>
#include <cstdio>
#include <cstdint>
namespace pg8 {
#define PG8_LAS __attribute__((address_space(3)))
typedef unsigned short bf16_t;
typedef short bf16x8 __attribute__((ext_vector_type(8)));
typedef float f32x4 __attribute__((ext_vector_type(4)));
typedef unsigned u32x4 __attribute__((ext_vector_type(4)));
constexpr int BM = 256, BK = 64, HALF = 128, HTB = HALF * BK * 2  , STAGE_BYTES = 8 * HTB, NXCD = 8, WGM = 8;

__host__ __device__ __forceinline__ int lds_byte(int r, int c) { const int st = (r >> 4) * 2 + (c >> 5), rr = r & 15, cc = c & 31, ob = rr * 64 + cc * 2; return st * 1024 + (ob ^ (((ob >> 9) & 1) << 5)); }
__host__ __device__ __forceinline__ void stage_rc(int b, int& R, int& C) { const int st = b / 1024, sb = b % 1024, swz = sb ^ (((sb >> 9) & 1) << 5); R = (st >> 1) * 16 + swz / 64; C = (st & 1) * 32 + (swz % 64) / 2; }
__host__ __device__ __forceinline__ int perm32(int rho) { const int n = rho >> 4, i = rho & 15; return 8 * (i >> 2) + 4 * n + (i & 3); }

struct Unit { int pm, pn; };
struct Gemm { const bf16_t* A; const bf16_t* Bt; int M, N, K; };

struct StaticOrder {
    int nM, nN, nwg, G, c;
    __host__ __device__ void init(int M, int N, int G_, int c_) { nM = M / BM; nN = N / BM; nwg = nM * nN; G = G_; c = c_; }
    __host__ __device__ bool next(int i, Unit& u) const {
        const long L = (long)i * G + c; if (L >= nwg) return false;
        int wgid = (int)L; { const int q = nwg / NXCD, r = nwg % NXCD, xcd = wgid % NXCD, off = wgid / NXCD; wgid = (xcd < r ? xcd * (q + 1) : r * (q + 1) + (xcd - r) * q) + off; }
        const int nig = WGM * nN, gid = wgid / nig, fm = gid * WGM, gsz = (nM - fm) < WGM ? (nM - fm) : WGM;
        u.pm = fm + ((wgid % nig) % gsz); u.pn = (wgid % nig) / gsz; return true;
    }
    __device__ __forceinline__ void a_ready(const Unit&) const {}
    __device__ __forceinline__ void done(const Unit&) const {}
};

__device__ __forceinline__ unsigned cvt_pk_bf16(float lo, float hi) { unsigned r; asm volatile("v_cvt_pk_bf16_f32 %0, %1, %2" : "=v"(r) : "v"(lo), "v"(hi)); return r; }
typedef float f32x2 __attribute__((ext_vector_type(2)));
__device__ __forceinline__ float row_scale(const float* ssq, int row, int fq) {
    const f32x4* p = (const f32x4*)(ssq + (size_t)row * 32 + fq * 8);
    const f32x4 a = p[0], b = p[1];
    float s = ((a[0] + a[1]) + (a[2] + a[3])) + ((b[0] + b[1]) + (b[2] + b[3]));
    s += __shfl_xor(s, 16); s += __shfl_xor(s, 32);
    return __builtin_amdgcn_rsqf(s * (1.0f / 2048.0f) + 1e-6f);
}
struct EpiSwiglu {
    static constexpr bool PERM = true, AFTER_DRAIN = false;
    bf16_t* O; int ldc; const float* ssq;
    __device__ __forceinline__ void operator()(const f32x4 (&acc)[2][2][4][2], const Unit& u, int wr, int wc, int fr, int fq) const {
        const int row0 = u.pm * BM + wr * 64 + fr, col0 = u.pn * HALF + wc * 32 + 8 * fq;
#pragma unroll
        for (int ai = 0; ai < 2; ++ai)
#pragma unroll
            for (int m = 0; m < 4; ++m) {
                const int row = row0 + ai * HALF + m * 16; const float s = row_scale(ssq, row, fq);
                float o[8];
#pragma unroll
                for (int n = 0; n < 2; ++n)
#pragma unroll
                    for (int i = 0; i < 4; ++i) { const float g = acc[ai][0][m][n][i] * s, up = acc[ai][1][m][n][i] * s;
                        const float e = __builtin_amdgcn_exp2f(-1.4426950408889634f * g);
                        o[n * 4 + i] = g * __builtin_amdgcn_rcpf(1.0f + e) * up; }
                u32x4 w; w.x = cvt_pk_bf16(o[0], o[1]); w.y = cvt_pk_bf16(o[2], o[3]); w.z = cvt_pk_bf16(o[4], o[5]); w.w = cvt_pk_bf16(o[6], o[7]);
                *(u32x4*)(O + (size_t)row * ldc + col0) = w; }
    }
};
struct EpiScaleBf16 {
    static constexpr bool PERM = true, AFTER_DRAIN = false;
    bf16_t* O; size_t split_stride; const float* ssq;
    __device__ __forceinline__ void operator()(const f32x4 (&acc)[2][2][4][2], const Unit& u, int wr, int wc, int fr, int fq) const {
        const int row0 = u.pm * BM + wr * 64 + fr; const int t = u.pn >> 3; bf16_t* base = O + (size_t)t * split_stride;
        const int col0 = (u.pn & 7) * BM + wc * 32 + 8 * fq;
#pragma unroll
        for (int ai = 0; ai < 2; ++ai)
#pragma unroll
            for (int m = 0; m < 4; ++m) {
                const int row = row0 + ai * HALF + m * 16; const float s = row_scale(ssq, row, fq);
                bf16_t* rowp = base + (size_t)row * 2048 + col0;
#pragma unroll
                for (int bj = 0; bj < 2; ++bj) { const f32x4 v0 = acc[ai][bj][m][0] * s, v1 = acc[ai][bj][m][1] * s;
                    u32x4 w; w.x = cvt_pk_bf16(v0[0], v0[1]); w.y = cvt_pk_bf16(v0[2], v0[3]); w.z = cvt_pk_bf16(v1[0], v1[1]); w.w = cvt_pk_bf16(v1[2], v1[3]);
                    *(u32x4*)(rowp + bj * HALF) = w; } }
    }
};
struct EpiResid {
    static constexpr bool PERM = false, AFTER_DRAIN = false;
    const float* base; float* out; bf16_t* hb; float* ssq; float coef;
    __device__ __forceinline__ void operator()(const f32x4 (&acc)[2][2][4][2], const Unit& u, int wr, int wc, int fr, int fq) const {
        typedef unsigned u32x2v __attribute__((ext_vector_type(2)));
        const int row0 = u.pm * BM + wr * 64 + fr, col0 = u.pn * BM + wc * 32 + 4 * fq;
#pragma unroll
        for (int ai = 0; ai < 2; ++ai)
#pragma unroll
            for (int m = 0; m < 4; ++m) {
                const int row = row0 + ai * HALF + m * 16; const size_t off = (size_t)row * 2048 + col0; float ss = 0.f;
#pragma unroll
                for (int bj = 0; bj < 2; ++bj)
#pragma unroll
                    for (int n = 0; n < 2; ++n) { const f32x4 bs = *(const f32x4*)(base + off + bj * HALF + n * 16); const f32x4 o = bs + acc[ai][bj][m][n] * coef;
                        *(f32x4*)(out + off + bj * HALF + n * 16) = o;
                        u32x2v w; w.x = cvt_pk_bf16(o[0], o[1]); w.y = cvt_pk_bf16(o[2], o[3]); *(u32x2v*)(hb + off + bj * HALF + n * 16) = w;
                        ss += (o[0] * o[0] + o[1] * o[1]) + (o[2] * o[2] + o[3] * o[3]); }
                ss += __shfl_xor(ss, 16); ss += __shfl_xor(ss, 32);
                if (fq == 0) ssq[(size_t)row * 32 + u.pn * 4 + wc] = ss;
                asm volatile("" ::: "memory"); }
    }
};

template <class Epi, class Sched, bool ALIGN_EPI = false, bool SP2 = false>
__device__ __forceinline__ void gemm_phase(PG8_LAS unsigned char* lds, const Gemm g, const Sched& S, const Epi& E, const int tid) {
    const int wid = __builtin_amdgcn_readfirstlane(tid >> 6), lane = tid & 63, wr = wid >> 2, wc = wid & 3, fr = lane & 15, fq = lane >> 4;
    const int K = g.K, nt = K / BK;
    unsigned voffA[2], voffB[2];
#pragma unroll
    for (int i = 0; i < 2; ++i) { int R, C; stage_rc(tid * 16 + i * 8192, R, C); const int Rb = Epi::PERM ? ((R & ~31) + perm32(R & 31)) : R;
        voffA[i] = (unsigned)(R * K + C) * 2u; voffB[i] = (unsigned)(Rb * K + C) * 2u; }
    const size_t kstep = (size_t)(BK * 2);
    const size_t hstep = (size_t)HALF * K * 2;
    const size_t tstep = 2 * hstep;
    const unsigned ldsw = (unsigned)wid * 1024u;
    const int aoff = lds_byte(wr * 64 + fr, fq * 8), boff = lds_byte(wc * 32 + fr, fq * 8);
#define PG8_SA(b, h) (((b) * 2 + (h)) * HTB)
#define PG8_SB(b, h) ((4 + (b) * 2 + (h)) * HTB)
#define PG8_STAGE(bufoff, gbase, voff) do { _Pragma("unroll") for (int _i = 0; _i < 2; ++_i) \
        __builtin_amdgcn_global_load_lds((const unsigned*)((const char*)(gbase) + (voff)[_i]), (PG8_LAS unsigned*)(lds + (bufoff) + ldsw + _i * 8192), 16, 0, 0); } while (0)
#define PG8_LDA(dst, b, h) do { _Pragma("unroll") for (int m = 0; m < 4; ++m) _Pragma("unroll") for (int k = 0; k < 2; ++k) dst[m][k] = *(const PG8_LAS bf16x8*)(lds + PG8_SA(b, h) + aoff + m * 2048 + k * 1024); } while (0)
#define PG8_LDB(dst, b, h) do { _Pragma("unroll") for (int n = 0; n < 2; ++n) _Pragma("unroll") for (int k = 0; k < 2; ++k) dst[n][k] = *(const PG8_LAS bf16x8*)(lds + PG8_SB(b, h) + boff + n * 2048 + k * 1024); } while (0)
#define PG8_MMA(ai, bj, At, Bt) do { __builtin_amdgcn_s_setprio(1); _Pragma("unroll") for (int m = 0; m < 4; ++m) _Pragma("unroll") for (int n = 0; n < 2; ++n) _Pragma("unroll") for (int k = 0; k < 2; ++k) \
        acc[ai][bj][m][n] = __builtin_amdgcn_mfma_f32_16x16x32_bf16(Bt[n][k], At[m][k], acc[ai][bj][m][n], 0, 0, 0); __builtin_amdgcn_s_setprio(0); } while (0)
#define PG8_WAIT_V(n) asm volatile("s_waitcnt vmcnt(" #n ")" ::: "memory")
#define PG8_WAIT_L(n) asm volatile("s_waitcnt lgkmcnt(" #n ")" ::: "memory")
#define PG8_BAR __builtin_amdgcn_s_barrier()
#define PG8_SCHED __builtin_amdgcn_sched_barrier(0)
    Unit cur, nxt; int ui = 0;
    if (!S.next(0, cur)) return;
    f32x4 acc[2][2][4][2];
#pragma unroll
    for (int a = 0; a < 2; ++a)
#pragma unroll
        for (int b = 0; b < 2; ++b)
#pragma unroll
            for (int m = 0; m < 4; ++m)
#pragma unroll
                for (int n = 0; n < 2; ++n) acc[a][b][m][n] = (f32x4){0.f, 0.f, 0.f, 0.f};
    bf16x8 At[4][2], B0[2][2], B1[2][2];
    const char* cA = (const char*)g.A + (size_t)cur.pm * tstep; const char* cB = (const char*)g.Bt + (size_t)cur.pn * tstep;
    S.a_ready(cur);
    if constexpr (SP2) {
        PG8_STAGE(PG8_SB(0, 0), cB, voffB); PG8_STAGE(PG8_SB(0, 1), cB + hstep, voffB); PG8_STAGE(PG8_SA(0, 0), cA, voffA); PG8_STAGE(PG8_SA(0, 1), cA + hstep, voffA);
        if (wr == 1) PG8_BAR;
        PG8_WAIT_V(2); PG8_BAR;
        PG8_STAGE(PG8_SB(1, 0), cB + kstep, voffB); PG8_STAGE(PG8_SA(1, 0), cA + kstep, voffA); PG8_STAGE(PG8_SB(1, 1), cB + hstep + kstep, voffB);
        PG8_WAIT_V(6); PG8_BAR;
    } else {
        PG8_STAGE(PG8_SB(0, 0), cB, voffB); PG8_STAGE(PG8_SA(0, 0), cA, voffA); PG8_STAGE(PG8_SB(0, 1), cB + hstep, voffB); PG8_STAGE(PG8_SA(0, 1), cA + hstep, voffA);
        if (wr == 1) PG8_BAR;
        PG8_WAIT_V(4); PG8_BAR;
        PG8_STAGE(PG8_SB(1, 0), cB + kstep, voffB); PG8_STAGE(PG8_SA(1, 0), cA + kstep, voffA); PG8_STAGE(PG8_SB(1, 1), cB + hstep + kstep, voffB);
        PG8_WAIT_V(6); PG8_BAR;
    }
    for (;;) {
        const bool has_next = S.next(ui + 1, nxt);
        const char* nA = has_next ? (const char*)g.A + (size_t)nxt.pm * tstep : cA; const char* nB = has_next ? (const char*)g.Bt + (size_t)nxt.pn * tstep : cB;
        for (int t = 0; t < nt; t += 2) {
            const bool last = (t == nt - 2);
            const char* a1 = cA + (size_t)(t + 1) * kstep;
            const char* a2 = last ? nA : cA + (size_t)(t + 2) * kstep; const char* b2 = last ? nB : cB + (size_t)(t + 2) * kstep;
            const char* a3 = a2 + kstep; const char* b3 = b2 + kstep;
            if (last && has_next) S.a_ready(nxt);
            if constexpr (SP2) {
            PG8_LDB(B0, 0, 0); PG8_LDB(B1, 0, 1); PG8_SCHED; PG8_LDA(At, 0, 0); PG8_STAGE(PG8_SA(1, 1), a1 + hstep, voffA);
            PG8_WAIT_V(8); PG8_WAIT_L(0); PG8_BAR; PG8_MMA(0, 0, At, B0); PG8_MMA(0, 1, At, B1); PG8_BAR; PG8_SCHED;
            PG8_LDA(At, 0, 1); PG8_STAGE(PG8_SB(0, 0), b2, voffB); PG8_STAGE(PG8_SB(0, 1), b2 + hstep, voffB); PG8_STAGE(PG8_SA(0, 0), a2, voffA);
            PG8_WAIT_V(8); PG8_WAIT_L(0); PG8_BAR; PG8_MMA(1, 0, At, B0); PG8_MMA(1, 1, At, B1); PG8_BAR; PG8_SCHED;
            PG8_LDB(B0, 1, 0); PG8_LDB(B1, 1, 1); PG8_SCHED; PG8_LDA(At, 1, 0); PG8_STAGE(PG8_SA(0, 1), a2 + hstep, voffA);
            PG8_WAIT_V(8); PG8_WAIT_L(0); PG8_BAR; PG8_MMA(0, 0, At, B0); PG8_MMA(0, 1, At, B1); PG8_BAR; PG8_SCHED;
            PG8_LDA(At, 1, 1); PG8_STAGE(PG8_SB(1, 0), b3, voffB); PG8_STAGE(PG8_SB(1, 1), b3 + hstep, voffB); PG8_STAGE(PG8_SA(1, 0), a3, voffA);
            PG8_WAIT_V(8); PG8_WAIT_L(0); PG8_BAR; PG8_MMA(1, 0, At, B0); PG8_MMA(1, 1, At, B1); PG8_BAR; PG8_SCHED;
            } else {
            PG8_LDB(B0, 0, 0); PG8_SCHED; PG8_LDA(At, 0, 0); PG8_STAGE(PG8_SA(1, 1), a1 + hstep, voffA);
            PG8_WAIT_L(8); PG8_BAR; PG8_WAIT_L(0); PG8_MMA(0, 0, At, B0); PG8_BAR; PG8_SCHED;
            PG8_LDB(B1, 0, 1); PG8_STAGE(PG8_SB(0, 0), b2, voffB);
            PG8_BAR; PG8_WAIT_L(0); PG8_MMA(0, 1, At, B1); PG8_BAR;
            PG8_LDA(At, 0, 1); PG8_STAGE(PG8_SA(0, 0), a2, voffA);
            PG8_BAR; PG8_WAIT_L(0); PG8_MMA(1, 0, At, B0); PG8_BAR; PG8_SCHED;
            PG8_STAGE(PG8_SB(0, 1), b2 + hstep, voffB);
            PG8_WAIT_V(6); PG8_BAR; PG8_MMA(1, 1, At, B1); PG8_BAR;
            PG8_LDB(B0, 1, 0); PG8_SCHED; PG8_LDA(At, 1, 0); PG8_STAGE(PG8_SA(0, 1), a2 + hstep, voffA);
            PG8_WAIT_L(8); PG8_BAR; PG8_WAIT_L(0); PG8_MMA(0, 0, At, B0); PG8_BAR; PG8_SCHED;
            PG8_LDB(B1, 1, 1); PG8_STAGE(PG8_SB(1, 0), b3, voffB);
            PG8_BAR; PG8_WAIT_L(0); PG8_MMA(0, 1, At, B1); PG8_BAR;
            PG8_LDA(At, 1, 1); PG8_STAGE(PG8_SA(1, 0), a3, voffA);
            PG8_BAR; PG8_WAIT_L(0); PG8_MMA(1, 0, At, B0); PG8_BAR; PG8_SCHED;
            PG8_STAGE(PG8_SB(1, 1), b3 + hstep, voffB);
            PG8_WAIT_V(6); PG8_BAR; PG8_MMA(1, 1, At, B1); PG8_BAR;
            }
        }
        if constexpr (ALIGN_EPI) { if (wr == 0) PG8_BAR; }
        if constexpr (!Epi::AFTER_DRAIN) { E(acc, cur, wr, wc, fr, fq); S.done(cur); }
        if (!has_next) break;
#pragma unroll
        for (int a = 0; a < 2; ++a)
#pragma unroll
            for (int b = 0; b < 2; ++b)
#pragma unroll
                for (int m = 0; m < 4; ++m)
#pragma unroll
                    for (int n = 0; n < 2; ++n) acc[a][b][m][n] = (f32x4){0.f, 0.f, 0.f, 0.f};
        cur = nxt; cA = nA; cB = nB; ++ui;
        if constexpr (ALIGN_EPI) { if (wr == 1) PG8_BAR; }
    }
    PG8_WAIT_V(0);
    if constexpr (!ALIGN_EPI) { if (wr == 0) PG8_BAR; }
    PG8_BAR;
    if constexpr (Epi::AFTER_DRAIN) { E.fused(acc, cur, wr, wc, fr, fq, lds, wid, lane); S.done(cur); }
#undef PG8_SA
#undef PG8_SB
#undef PG8_STAGE
#undef PG8_LDA
#undef PG8_LDB
#undef PG8_MMA
#undef PG8_WAIT_V
#undef PG8_WAIT_L
#undef PG8_BAR
#undef PG8_SCHED
}
}

#define GAS __attribute__((address_space(1)))
#define LAS __attribute__((address_space(3)))
typedef unsigned short bf16;
typedef unsigned v4u __attribute__((ext_vector_type(4)));
typedef float f32x4 __attribute__((ext_vector_type(4)));
typedef short bf16x8 __attribute__((ext_vector_type(8)));
typedef GAS unsigned gu32;
typedef GAS unsigned long long gu64;
#define RLX_AGENT __ATOMIC_RELAXED, __HIP_MEMORY_SCOPE_AGENT
#define LDS_WAIT() asm volatile("s_waitcnt lgkmcnt(0)" ::: "memory")
#define VM_WAIT() asm volatile("s_waitcnt vmcnt(0)" ::: "memory")
__device__ __forceinline__ unsigned long long rt() { return __builtin_amdgcn_s_memrealtime(); }
__device__ __forceinline__ unsigned f2bf(float f) { unsigned u = __builtin_bit_cast(unsigned, f); return (u + 0x7fffu + ((u >> 16) & 1u)) >> 16; }
__device__ __forceinline__ unsigned pk2(float lo, float hi) { return f2bf(lo) | (f2bf(hi) << 16); }

#define XB_TMO      128
#define XB_XCNT(j)  (256  + 64 * (j))
#define XB_XSUB(j)  (1280 + 64 * (j))
#define XB_XGEN(j)  (2304 + 64 * (j))
#define XB_TOP      3328
#define XB_TOPGEN   3392
#define XCD_BAR_WORDS 3456
#define XB_SPIN_CAP (1u << 18)

__device__ __forceinline__ unsigned xb_ld(unsigned* p)              { return __hip_atomic_load(p, __ATOMIC_RELAXED, __HIP_MEMORY_SCOPE_AGENT); }
__device__ __forceinline__ unsigned xb_add(unsigned* p, unsigned v) { return __hip_atomic_fetch_add(p, v, __ATOMIC_RELAXED, __HIP_MEMORY_SCOPE_AGENT); }
__device__ __forceinline__ unsigned xb_xcc_id() { return (unsigned)__builtin_amdgcn_s_getreg((3 << 11) | 20) & 0xFu; }
#define XB_SPIN(cond, bar) do { unsigned _sp = 0; while (cond) { __builtin_amdgcn_s_sleep(1); \
    if ((++_sp & 255u) == 0u) { if (xb_ld(&(bar)[XB_TMO])) break; if (_sp > XB_SPIN_CAP) { atomicAdd(&(bar)[XB_TMO], 1u); break; } } } } while (0)

struct XcdBarrier {
    unsigned* bar; unsigned x;
    volatile LAS unsigned* st;
};

__device__ __forceinline__ XcdBarrier xcd_barrier_post(unsigned* bar, volatile LAS unsigned* st) {
    XcdBarrier b; b.bar = bar; b.x = xb_xcc_id(); b.st = st;
    if (threadIdx.x == 0) (void)xb_add(&bar[XB_XCNT(b.x)], 1u);
    return b;
}
__device__ __forceinline__ void xcd_barrier_complete(unsigned* bar, unsigned x, unsigned& nloc, unsigned& nx) {
    const unsigned G = gridDim.x * gridDim.y * gridDim.z;
    unsigned sum, cnt, mine, sp = 0u;
    for (;;) {
        sum = 0u; cnt = 0u; mine = 0u;
#pragma unroll
        for (unsigned j = 0; j < 16; ++j) { const unsigned c = xb_ld(&bar[XB_XCNT(j)]); sum += c; cnt += (c > 0u) ? 1u : 0u; mine = (j == x) ? c : mine; }
        if (sum == G) break;
        __builtin_amdgcn_s_sleep(1);
        if ((++sp & 255u) == 0u) { if (xb_ld(&bar[XB_TMO])) break; if (sp > XB_SPIN_CAP) { atomicAdd(&bar[XB_TMO], 1u); break; } }
    }
    nloc = mine > 0u ? mine : 1u; nx = cnt > 0u ? cnt : 1u;
}

__device__ __forceinline__ void xcd_barrier(const XcdBarrier& b) {
    asm volatile("s_waitcnt vmcnt(0)" ::: "memory");
    __syncthreads();
    if (threadIdx.x == 0) {
        unsigned* bar = b.bar;
        __builtin_amdgcn_s_waitcnt(0);
        unsigned nloc = b.st[0], nx = b.st[1];
        if (nloc == 0u) { xcd_barrier_complete(bar, b.x, nloc, nx); b.st[0] = nloc; b.st[1] = nx; }
        const unsigned old = xb_add(&bar[XB_XSUB(b.x)], 1u);
        const unsigned gen = old / nloc;
        if (old + 1u == (gen + 1u) * nloc) {
            __builtin_amdgcn_fence(__ATOMIC_RELEASE, "agent");
            asm volatile("s_waitcnt vmcnt(0)" ::: "memory");
            const unsigned og = xb_add(&bar[XB_TOP], 1u);
            const unsigned tg = og / nx;
            if (og + 1u == (tg + 1u) * nx) xb_add(&bar[XB_TOPGEN], 1u);
            else XB_SPIN(xb_ld(&bar[XB_TOPGEN]) == tg, bar);
            __builtin_amdgcn_fence(__ATOMIC_ACQUIRE, "agent");
            xb_add(&bar[XB_XGEN(b.x)], 1u);
            asm volatile("s_waitcnt vmcnt(0)" ::: "memory");
        } else {
            XB_SPIN(xb_ld(&bar[XB_XGEN(b.x)]) == gen, bar);
            __builtin_amdgcn_fence(__ATOMIC_ACQUIRE, "agent");
            asm volatile("s_waitcnt vmcnt(0)" ::: "memory");
        }
    }
    __syncthreads();
}

constexpr int BATCH = 4, SEQ = 2048, DM = 2048, NH = 16, HD = 128, FF = 5632, DEPTH = 4;
constexpr int M = BATCH * SEQ;
constexpr float RMS_EPS = 1e-6f;
constexpr int NWAVES = 8;

constexpr size_t MiB = 1u << 20;
constexpr size_t WS_CTL = 0, CTL_ZERO_BYTES = 1 * MiB;
constexpr size_t WS_SSQ = 1 * MiB;
constexpr size_t WS_H = 2 * MiB;
constexpr size_t WS_HB = 66 * MiB;
constexpr size_t WS_Q = 98 * MiB, WS_K = 130 * MiB, WS_V = 162 * MiB;
constexpr size_t WS_MIX = 194 * MiB;
constexpr size_t WS_ACT = 226 * MiB;
constexpr size_t WS_W = 320 * MiB;
constexpr size_t W_FFN_STRIDE = 66 * MiB, W_FFN_DOWN = 44 * MiB;
constexpr size_t WS_WATT = WS_W + 8 * W_FFN_STRIDE;
constexpr size_t WS_END = WS_WATT + 112 * MiB;
constexpr int CW_BAR = 4096;

constexpr int RING_OFF = 0;
constexpr int LDSCTL_OFF = 139264;
constexpr int LDS_BYTES = 147456;

namespace att {
using bf16x8 = __attribute__((ext_vector_type(8))) short;
using s16x4  = __attribute__((ext_vector_type(4))) short;
using f32x16 = __attribute__((ext_vector_type(16))) float;
using u32x4  = __attribute__((ext_vector_type(4))) unsigned;
constexpr int D = 128, QBLK = 32, KVBLK = 64, PITCH = 2048;
constexpr float SCALE = 0.088388347648318440f, LOG2E = 1.4426950408889634f;
constexpr int SHM_V = KVBLK * D * 2, SHM_K = KVBLK * D * 2;
constexpr int OFF_V = 0, OFF_K = 2 * SHM_V, OFF_WS = 2 * SHM_V + 2 * SHM_K, OFF_BIAS = OFF_WS + NWAVES * 256;
#define KSWZ(row, colB) ((row) * 256 + ((colB) ^ (((row) & 7) << 4)))
#define SBAR() __builtin_amdgcn_sched_barrier(0)
__device__ __forceinline__ int crow(int r, int hi) { return (r & 3) + 8 * (r >> 2) + 4 * hi; }
__device__ __forceinline__ unsigned cvtpk(float lo, float hi) { unsigned r; asm volatile("v_cvt_pk_bf16_f32 %0, %1, %2" : "=v"(r) : "v"(lo), "v"(hi)); return r; }
__device__ __forceinline__ void qkt(f32x16& p0, f32x16& p1, const char* Ks, const bf16x8* qr, int r32, int hi) {
  p0 = f32x16{}; p1 = f32x16{};
#pragma unroll
  for (int d0 = 0; d0 < 8; ++d0) { int cb = (d0 * 16 + hi * 8) * 2;
    bf16x8 b0 = *reinterpret_cast<const bf16x8*>(Ks + KSWZ(r32, cb));
    bf16x8 b1 = *reinterpret_cast<const bf16x8*>(Ks + KSWZ(32 + r32, cb));
    p0 = __builtin_amdgcn_mfma_f32_32x32x16_bf16(b0, qr[d0], p0, 0, 0, 0);
    p1 = __builtin_amdgcn_mfma_f32_32x32x16_bf16(b1, qr[d0], p1, 0, 0, 0); }
}
__device__ __forceinline__ int v_st(int k, int c) { const int kk = (k & ~0xC) | ((k & 4) << 1) | ((k & 8) >> 1); return ((kk >> 3) * 4 + (c >> 5)) * 512 + ((kk & 7) * 32 + (c & 31)) * 2; }
__device__ __forceinline__ int v_rd_base(int lane) { return ((lane & 3) << 3) | (((lane >> 2) & 3) << 6) | (((lane >> 4) & 1) << 5) | (((lane >> 5) & 1) << 8); }
constexpr int v_rd_off(int d0, int ks, int half) { return d0 * 512 + ks * 4096 + half * 2048; }
template <int OFF> __device__ __forceinline__ s16x4 tr_read(int vb) {
  s16x4 r; asm volatile("ds_read_b64_tr_b16 %0, %1 offset:%2" : "=&v"(r) : "v"(vb), "i"(OFF) : "memory"); return r;
}
template <int D0> __device__ __forceinline__ void pv_one(f32x16& od, int vb, bf16x8 pa0, bf16x8 pa1, bf16x8 pa2, bf16x8 pa3) {
  const s16x4 l0 = tr_read<v_rd_off(D0, 0, 0)>(vb), h0 = tr_read<v_rd_off(D0, 0, 1)>(vb), l1 = tr_read<v_rd_off(D0, 1, 0)>(vb), h1 = tr_read<v_rd_off(D0, 1, 1)>(vb);
  const s16x4 l2 = tr_read<v_rd_off(D0, 2, 0)>(vb), h2 = tr_read<v_rd_off(D0, 2, 1)>(vb), l3 = tr_read<v_rd_off(D0, 3, 0)>(vb), h3 = tr_read<v_rd_off(D0, 3, 1)>(vb);
  asm volatile("s_waitcnt lgkmcnt(0)" ::: "memory"); SBAR();
#define PK(L, H) (bf16x8){L[0], L[1], L[2], L[3], H[0], H[1], H[2], H[3]}
  od = __builtin_amdgcn_mfma_f32_32x32x16_bf16(pa0, PK(l0, h0), od, 0, 0, 0);
  od = __builtin_amdgcn_mfma_f32_32x32x16_bf16(pa1, PK(l1, h1), od, 0, 0, 0);
  od = __builtin_amdgcn_mfma_f32_32x32x16_bf16(pa2, PK(l2, h2), od, 0, 0, 0);
  od = __builtin_amdgcn_mfma_f32_32x32x16_bf16(pa3, PK(l3, h3), od, 0, 0, 0);
#undef PK
}
__device__ __forceinline__ void pv_d0(f32x16* o, int vb, bf16x8 pa0, bf16x8 pa1, bf16x8 pa2, bf16x8 pa3) {
  pv_one<0>(o[0], vb, pa0, pa1, pa2, pa3); pv_one<1>(o[1], vb, pa0, pa1, pa2, pa3); pv_one<2>(o[2], vb, pa0, pa1, pa2, pa3); pv_one<3>(o[3], vb, pa0, pa1, pa2, pa3);
}
__device__ __forceinline__ void pack_p(const f32x16& p0, const f32x16& p1, bf16x8& pa0, bf16x8& pa1, bf16x8& pa2, bf16x8& pa3) {
#define PK4(P, BASE, OUT) do { unsigned a0 = cvtpk(P[BASE + 0], P[BASE + 1]), a1 = cvtpk(P[BASE + 2], P[BASE + 3]);   \
    unsigned b0 = cvtpk(P[BASE + 4], P[BASE + 5]), b1 = cvtpk(P[BASE + 6], P[BASE + 7]);                              \
    auto r0 = __builtin_amdgcn_permlane32_swap(a0, b0, false, false); auto r1 = __builtin_amdgcn_permlane32_swap(a1, b1, false, false); \
    u32x4 w = {r0[0], r1[0], r0[1], r1[1]}; OUT = *reinterpret_cast<bf16x8*>(&w); } while (0)
  PK4(p0, 0, pa0); PK4(p0, 8, pa1); PK4(p1, 0, pa2); PK4(p1, 8, pa3);
#undef PK4
}
__device__ __forceinline__ void swap2(float x, float& lo, float& hi) {
  auto rr = __builtin_amdgcn_permlane32_swap(__float_as_uint(x), __float_as_uint(x), false, false); lo = __uint_as_float(rr[0]); hi = __uint_as_float(rr[1]);
}
__device__ __forceinline__ unsigned short f2bf1(float f) { return (unsigned short)(cvtpk(f, 0.f) & 0xffffu); }

struct Stg { bf16x8 vs0, vs1, ks0, ks1; };
__device__ __forceinline__ void sload(Stg& s, const unsigned short* Kh, const unsigned short* Vh, int k0, int sr, int sc) {
  s.vs0 = *reinterpret_cast<const bf16x8*>(Vh + (size_t)(k0 + sr) * PITCH + sc); s.vs1 = *reinterpret_cast<const bf16x8*>(Vh + (size_t)(k0 + 32 + sr) * PITCH + sc);
  s.ks0 = *reinterpret_cast<const bf16x8*>(Kh + (size_t)(k0 + sr) * PITCH + sc); s.ks1 = *reinterpret_cast<const bf16x8*>(Kh + (size_t)(k0 + 32 + sr) * PITCH + sc);
}
__device__ __forceinline__ void swrite(const Stg& s, char* lds, int buf, int sr, int sc, int vst0, int vst1) {
  *(bf16x8*)(lds + OFF_V + buf * SHM_V + vst0) = s.vs0; *(bf16x8*)(lds + OFF_V + buf * SHM_V + vst1) = s.vs1; const int kc = sc * 2;
  *(bf16x8*)(lds + OFF_K + buf * SHM_K + KSWZ(sr, kc)) = s.ks0; *(bf16x8*)(lds + OFF_K + buf * SHM_K + KSWZ(32 + sr, kc)) = s.ks1;
}
__device__ __forceinline__ void store_o(const f32x16* o, const float* rs, unsigned short* Ow, int r32, int hi) {
#pragma unroll
  for (int r = 0; r < 16; ++r) { const int orow = crow(r, hi);
#pragma unroll
    for (int d0 = 0; d0 < 4; ++d0) Ow[(size_t)orow * PITCH + d0 * 32 + r32] = f2bf1(o[d0][r] * rs[r]); }
}

__device__ __forceinline__ void stick_unit(const unsigned short* Q, const unsigned short* K, const unsigned short* V, unsigned short* O, int b, int h, int qb, char* lds, const int tid) {
  const int wid = __builtin_amdgcn_readfirstlane(tid >> 6), lane = tid & 63, r32 = lane & 31, hi = lane >> 5;
  const int t = 256 * qb + 32 * wid + r32;
  const int tmaxw = 256 * qb + 32 * wid + 31;
  const size_t rowb = (size_t)b * SEQ;
  bf16x8 qr[8];
  { const unsigned short* Qw = Q + (rowb + t) * PITCH + h * HD + hi * 8;
#pragma unroll
    for (int d0 = 0; d0 < 8; ++d0) qr[d0] = *reinterpret_cast<const bf16x8*>(Qw + d0 * 16); }
  const unsigned short* Kh = K + rowb * PITCH + h * HD; const unsigned short* Vh = V + rowb * PITCH + h * HD;
  const int sr = tid >> 4, sc = (tid & 15) * 8, vst0 = v_st(sr, sc), vst1 = v_st(32 + sr, sc);
  const int vb0 = (int)(uintptr_t)(lds + OFF_V) + v_rd_base(lane);
  f32x16 o[4] = {}; float R = 0.f;
  const int NT = 4 * qb + 4; int buf = 0;
  Stg st;
  __syncthreads();
  sload(st, Kh, Vh, (NT - 1) * KVBLK, sr, sc); asm volatile("s_waitcnt vmcnt(0)" ::: "memory"); swrite(st, lds, 0, sr, sc, vst0, vst1); __syncthreads();
  for (int kt = NT - 1; kt >= 0; --kt) {
    if (kt > 0) sload(st, Kh, Vh, (kt - 1) * KVBLK, sr, sc);
    const int k0 = kt * KVBLK;
    if (k0 < tmaxw) {
      f32x16 p0, p1; constexpr float C2 = SCALE * LOG2E;
      qkt(p0, p1, lds + OFF_K + buf * SHM_K, qr, r32, hi);
      const int tkh = t - k0 - 4 * hi;
      float x0[16], x1[16];
#pragma unroll
      for (int r = 0; r < 16; ++r) {
        { const float y = p0[r] * C2; const float lg = __builtin_amdgcn_logf(1.0f + __builtin_amdgcn_exp2f(-__builtin_fabsf(y))); const float sp = fmaxf(y, 0.f) + lg;
          const bool valid = ((r & 3) + 8 * (r >> 2)) < tkh; x0[r] = valid ? -sp : 0.f; p0[r] = y - sp; }
        { const float y = p1[r] * C2; const float lg = __builtin_amdgcn_logf(1.0f + __builtin_amdgcn_exp2f(-__builtin_fabsf(y))); const float sp = fmaxf(y, 0.f) + lg;
          const bool valid = (32 + (r & 3) + 8 * (r >> 2)) < tkh; x1[r] = valid ? -sp : 0.f; p1[r] = y - sp; }
      }
      float in0[16], in1[16], G[16];
#pragma unroll
      for (int c = 0; c < 4; ++c) {
        in0[4 * c + 3] = 0.f; in0[4 * c + 2] = x0[4 * c + 3]; in0[4 * c + 1] = in0[4 * c + 2] + x0[4 * c + 2]; in0[4 * c] = in0[4 * c + 1] + x0[4 * c + 1];
        in1[4 * c + 3] = 0.f; in1[4 * c + 2] = x1[4 * c + 3]; in1[4 * c + 1] = in1[4 * c + 2] + x1[4 * c + 2]; in1[4 * c] = in1[4 * c + 1] + x1[4 * c + 1];
        swap2(in0[4 * c] + x0[4 * c], G[2 * c], G[2 * c + 1]); swap2(in1[4 * c] + x1[4 * c], G[8 + 2 * c], G[8 + 2 * c + 1]);
      }
      float SG[16]; SG[15] = 0.f;
#pragma unroll
      for (int g = 14; g >= 0; --g) SG[g] = SG[g + 1] + G[g + 1];
      const float total = SG[0] + G[0];
#pragma unroll
      for (int c = 0; c < 4; ++c) {
        const float b0 = R + (hi ? SG[2 * c + 1] : SG[2 * c]), b1 = R + (hi ? SG[8 + 2 * c + 1] : SG[8 + 2 * c]);
#pragma unroll
        for (int i = 0; i < 4; ++i) { const int r = 4 * c + i;
          const bool v0 = ((r & 3) + 8 * (r >> 2)) < tkh, v1 = (32 + (r & 3) + 8 * (r >> 2)) < tkh;
          const float a0 = __builtin_amdgcn_exp2f(p0[r] + (b0 + in0[r])), a1 = __builtin_amdgcn_exp2f(p1[r] + (b1 + in1[r]));
          p0[r] = v0 ? a0 : 0.f; p1[r] = v1 ? a1 : 0.f; }
      }
      R += total;
      bf16x8 pa0, pa1, pa2, pa3; pack_p(p0, p1, pa0, pa1, pa2, pa3);
      pv_d0(o, vb0 + buf * SHM_V, pa0, pa1, pa2, pa3);
    }
    if (kt > 0) { asm volatile("s_waitcnt vmcnt(0)" ::: "memory"); swrite(st, lds, buf ^ 1, sr, sc, vst0, vst1); }
    __syncthreads();
    buf ^= 1;
  }
  float rs[16];
#pragma unroll
  for (int r = 0; r < 16; ++r) rs[r] = 1.0f;
  store_o(o, rs, O + (rowb + 256 * qb + 32 * wid) * PITCH + h * HD, r32, hi);
}

__device__ __forceinline__ void band_unit(const unsigned short* Q, const unsigned short* K, const unsigned short* V, unsigned short* O, const float* bias  , int b, int h, int qb, char* lds, const int tid) {
  const int wid = __builtin_amdgcn_readfirstlane(tid >> 6), lane = tid & 63, r32 = lane & 31, hi = lane >> 5;
  const int t = 256 * qb + 32 * wid + r32;
  const int cq = 4 * qb + (wid >> 1);
  const size_t rowb = (size_t)b * SEQ;
  bf16x8 qr[8];
  { const unsigned short* Qw = Q + (rowb + t) * PITCH + h * HD + hi * 8;
#pragma unroll
    for (int d0 = 0; d0 < 8; ++d0) qr[d0] = *reinterpret_cast<const bf16x8*>(Qw + d0 * 16); }
  const unsigned short* Kh = K + rowb * PITCH + h * HD; const unsigned short* Vh = V + rowb * PITCH + h * HD;
  const int sr = tid >> 4, sc = (tid & 15) * 8, vst0 = v_st(sr, sc), vst1 = v_st(32 + sr, sc);
  const int vb0 = (int)(uintptr_t)(lds + OFF_V) + v_rd_base(lane);
  float* wsf = (float*)(lds + OFF_WS) + wid * 64; float* li_l = wsf; float* al_l = wsf + 32;
  float* bias_l = (float*)(lds + OFF_BIAS);
  f32x16 o[4] = {}; float m_reg = -1e30f, l_reg = 0.f;
  const int kc_lo = (4 * qb - 8) > 0 ? (4 * qb - 8) : 0, kc_hi = 4 * qb + 3; int buf = 0;
  Stg st;
  __syncthreads();
  for (int i = tid; i < 513; i += NWAVES * 64) bias_l[i] = bias[i];
  sload(st, Kh, Vh, kc_lo * KVBLK, sr, sc); asm volatile("s_waitcnt vmcnt(0)" ::: "memory"); swrite(st, lds, 0, sr, sc, vst0, vst1); __syncthreads();
  for (int kc = kc_lo; kc <= kc_hi; ++kc) {
    if (kc < kc_hi) sload(st, Kh, Vh, (kc + 1) * KVBLK, sr, sc);
    if (kc >= cq - 8 && kc <= cq) {
      f32x16 p0, p1;
      qkt(p0, p1, lds + OFF_K + buf * SHM_K, qr, r32, hi);
      const int dk = t - kc * KVBLK - 4 * hi + 256;
      float pmax = -1e30f;
#pragma unroll
      for (int r = 0; r < 16; ++r) {
        int i0 = dk - ((r & 3) + 8 * (r >> 2)), i1 = i0 - 32; i0 = i0 < 512 ? i0 : 512; i1 = i1 < 512 ? i1 : 512;
        p0[r] = (p0[r] * SCALE + bias_l[i0]) * LOG2E; p1[r] = (p1[r] * SCALE + bias_l[i1]) * LOG2E;
        pmax = fmaxf(pmax, fmaxf(p0[r], p1[r])); }
      { float lo, hh; swap2(pmax, lo, hh); pmax = fmaxf(lo, hh); }
      const float mn = fmaxf(m_reg, pmax); const float alpha = __builtin_amdgcn_exp2f(m_reg - mn); m_reg = mn;
      float ps = 0.f;
#pragma unroll
      for (int r = 0; r < 16; ++r) { p0[r] = __builtin_amdgcn_exp2f(p0[r] - mn); p1[r] = __builtin_amdgcn_exp2f(p1[r] - mn); ps += p0[r] + p1[r]; }
      { float lo, hh; swap2(ps, lo, hh); ps = lo + hh; }
      l_reg = l_reg * alpha + ps;
      if (__any(alpha < 1.f)) { if (hi == 0) al_l[r32] = alpha; asm volatile("s_waitcnt lgkmcnt(0)" ::: "memory");
#pragma unroll
        for (int r = 0; r < 16; ++r) { const float a = al_l[crow(r, hi)];
#pragma unroll
          for (int d = 0; d < 4; ++d) o[d][r] *= a; } }
      bf16x8 pa0, pa1, pa2, pa3; pack_p(p0, p1, pa0, pa1, pa2, pa3);
      pv_d0(o, vb0 + buf * SHM_V, pa0, pa1, pa2, pa3);
    }
    if (kc < kc_hi) { asm volatile("s_waitcnt vmcnt(0)" ::: "memory"); swrite(st, lds, buf ^ 1, sr, sc, vst0, vst1); }
    __syncthreads();
    buf ^= 1;
  }
  if (hi == 0) li_l[r32] = l_reg; asm volatile("s_waitcnt lgkmcnt(0)" ::: "memory");
  float rs[16];
#pragma unroll
  for (int r = 0; r < 16; ++r) rs[r] = __builtin_amdgcn_rcpf(li_l[crow(r, hi)]);
  store_o(o, rs, O + (rowb + 256 * qb + 32 * wid) * PITCH + h * HD, r32, hi);
}
#undef KSWZ
#undef SBAR
}

struct Frame {
    LAS unsigned char* lds;
    volatile LAS unsigned* MISC;
    gu32* ctl;
    int tid, lane, wave;
    int vcu, G;
};
__device__ __forceinline__ float wave_sum(float v) {
#pragma unroll
    for (int o = 1; o < 64; o <<= 1) v += __shfl_xor(v, o);
    return v;
}
__device__ __forceinline__ void tr_item(const float* W, int N, const float* gain, bf16* WT, int Kd, int k0, int n0, int drow, LAS float* scr, int lane) {
    const float* src = W + (size_t)k0 * N + n0 + lane;
#pragma unroll
    for (int bt = 0; bt < 4; ++bt) { float v[16];
#pragma unroll
        for (int i = 0; i < 16; ++i) v[i] = src[(size_t)(bt * 16 + i) * N];
#pragma unroll
        for (int i = 0; i < 16; ++i) scr[(bt * 16 + i) * 65 + lane] = v[i]; }
    const int c = lane & 7;
    float gk[8];
#pragma unroll
    for (int i = 0; i < 8; ++i) gk[i] = gain ? gain[k0 + 8 * c + i] : 1.0f;
    LDS_WAIT(); asm volatile("" ::: "memory");
#pragma unroll
    for (int j = 0; j < 8; ++j) { const int n = (lane >> 3) + 8 * j; const LAS float* s = scr + (8 * c) * 65 + n;
        v4u o; o.x = pk2(s[0 * 65] * gk[0], s[1 * 65] * gk[1]); o.y = pk2(s[2 * 65] * gk[2], s[3 * 65] * gk[3]); o.z = pk2(s[4 * 65] * gk[4], s[5 * 65] * gk[5]); o.w = pk2(s[6 * 65] * gk[6], s[7 * 65] * gk[7]);
        *(GAS v4u*)(WT + (size_t)(drow + n) * Kd + k0 + 8 * c) = o; }
    LDS_WAIT(); asm volatile("" ::: "memory");
}

struct Args { const float* in[14]; float* out; unsigned char* ws; int ph_lo, ph_hi; };

__device__ __forceinline__ bf16* w_gu(unsigned char* ws, int f) { return (bf16*)(ws + WS_W + (size_t)f * W_FFN_STRIDE); }
__device__ __forceinline__ bf16* w_dn(unsigned char* ws, int f) { return (bf16*)(ws + WS_W + (size_t)f * W_FFN_STRIDE + W_FFN_DOWN); }
__device__ __forceinline__ bf16* w_mix1(unsigned char* ws, int layer) { return (bf16*)(ws + WS_WATT + (size_t)layer * 32 * MiB); }
__device__ __forceinline__ bf16* w_mixo(unsigned char* ws, int layer) { return (bf16*)(ws + WS_WATT + (size_t)layer * 32 * MiB + (layer < 3 ? 24 : 8) * MiB); }

__device__ __forceinline__ void p0_prologue(Frame& F, const Args& a) {
    unsigned char* ws = a.ws;
    LAS float* scr = (LAS float*)(F.lds + RING_OFF + F.wave * 16640);
    const int gw = F.vcu * NWAVES + F.wave, NGW = F.G * NWAVES;
    const float *g_ffn = a.in[1], *wg = a.in[2], *wu = a.in[3], *wd = a.in[4], *g_mix = a.in[5], *wqkv = a.in[6], *woa = a.in[7], *g_kv = a.in[8], *wkv = a.in[9], *wqb = a.in[10], *wob = a.in[11];
    constexpr int I_FFN = 3 * 2816, I_ALLFFN = 8 * I_FFN, I_A = 4096, I_TOTAL = I_ALLFFN + 2 * I_A + 6144;
    for (int it = gw; it < I_TOTAL; it += NGW) {
        const float* W; const float* gain = nullptr; bf16* WT; int N, Kd, kb, nb, drow_add = 0; bool ilv = false; int mat = 0;
        int r = it;
        if (r < I_ALLFFN) { const int f = r / I_FFN; r -= f * I_FFN; mat = r / 2816; r -= mat * 2816;
            if (mat < 2) { N = FF; Kd = DM; W = (mat == 0 ? wg : wu) + (size_t)f * DM * FF; gain = g_ffn + (size_t)f * DM; WT = w_gu(ws, f); kb = r / 88; nb = r - kb * 88; ilv = true; }
            else { N = DM; Kd = FF; W = wd + (size_t)f * FF * DM; WT = w_dn(ws, f); kb = r / 32; nb = r - kb * 32; }
        } else { r -= I_ALLFFN;
            if (r < 2 * I_A) { const int l = r / I_A; r -= l * I_A;
                if (r < 3072) { N = 3 * DM; Kd = DM; W = wqkv + (size_t)l * DM * 3 * DM; gain = g_mix + (size_t)l * DM; WT = w_mix1(ws, l); kb = r / 96; nb = r - kb * 96; }
                else { r -= 3072; N = DM; Kd = DM; W = woa + (size_t)l * DM * DM; WT = w_mixo(ws, l); kb = r / 32; nb = r - kb * 32; }
            } else { r -= 2 * I_A;
                if (r < 2048) { N = 2 * DM; Kd = DM; W = wkv; gain = g_kv; WT = w_mix1(ws, 2); kb = r / 64; nb = r - kb * 64; drow_add = DM; }
                else { r -= 2048; const int which = r / 1024; r -= which * 1024; N = DM; Kd = DM; kb = r / 32; nb = r - kb * 32;
                    if (which == 0) { W = wqb; gain = g_mix + 2 * DM; WT = w_mix1(ws, 2); }
                    else if (which == 1) { W = wqb + (size_t)DM * DM; gain = g_mix + 3 * DM; WT = w_mix1(ws, 3); }
                    else if (which == 2) { W = wob; WT = w_mixo(ws, 2); }
                    else { W = wob + (size_t)DM * DM; WT = w_mixo(ws, 3); } }
            }
        }
        const int n0 = nb * 64; const int drow = ilv ? (256 * (n0 >> 7) + (n0 & 127) + 128 * mat) : (n0 + drow_add);
        tr_item(W, N, gain, WT, Kd, kb * 64, n0, drow, scr, F.lane);
    }
    const float* x = a.in[0]; bf16* hb = (bf16*)(ws + WS_HB); float* ssq = (float*)(ws + WS_SSQ);
    for (int m = gw; m < M; m += NGW) {
        const GAS f32x4* xr = (const GAS f32x4*)(x + (size_t)m * DM) + F.lane; f32x4 v[8]; float s = 0.f;
#pragma unroll
        for (int j = 0; j < 8; ++j) { v[j] = xr[64 * j]; s += (v[j].x * v[j].x + v[j].y * v[j].y) + (v[j].z * v[j].z + v[j].w * v[j].w); }
        s = wave_sum(s);
        GAS unsigned long long* o8 = (GAS unsigned long long*)(hb + (size_t)m * DM) + F.lane;
#pragma unroll
        for (int j = 0; j < 8; ++j) o8[64 * j] = (unsigned long long)pk2(v[j].x, v[j].y) | ((unsigned long long)pk2(v[j].z, v[j].w) << 32);
        if (F.lane < 32) ssq[(size_t)m * 32 + F.lane] = F.lane == 0 ? s : 0.f;
    }
}
__device__ __forceinline__ void final_norm(Frame& F, const Args& a) {
    const int gw = F.vcu * NWAVES + F.wave, NGW = F.G * NWAVES;
    const float* h = (const float*)(a.ws + WS_H); const float* ssq = (const float*)(a.ws + WS_SSQ); const float* g = a.in[13];
    f32x4 gv[8];
#pragma unroll
    for (int j = 0; j < 8; ++j) gv[j] = ((const GAS f32x4*)g)[F.lane + 64 * j];
    for (int m = gw; m < M; m += NGW) {
        float s = F.lane < 32 ? ssq[(size_t)m * 32 + F.lane] : 0.f; s = wave_sum(s);
        const float rs = __builtin_amdgcn_rsqf(s * (1.0f / DM) + RMS_EPS);
        const GAS f32x4* hr = (const GAS f32x4*)(h + (size_t)m * DM) + F.lane; GAS f32x4* orow = (GAS f32x4*)(a.out + (size_t)m * DM) + F.lane;
#pragma unroll
        for (int j = 0; j < 8; ++j) orow[64 * j] = hr[64 * j] * rs * gv[j];
    }
}

#ifndef MK_PER_PHASE
#define MK_PER_PHASE 0
#endif
constexpr int N_PHASES = 38;
__global__ void __launch_bounds__(NWAVES * 64, 2) mega_fwd(Args args) {
    extern __shared__ __attribute__((aligned(16))) unsigned char lds[];
    Frame F;
    F.lds = (LAS unsigned char*)lds;
    F.MISC = (volatile LAS unsigned*)(F.lds + LDSCTL_OFF);
    F.tid = threadIdx.x; F.lane = F.tid & 63; F.wave = __builtin_amdgcn_readfirstlane(F.tid >> 6);
    F.G = gridDim.x; { const int bx = blockIdx.x; F.vcu = (F.G % 8 == 0) ? (bx % 8) * (F.G / 8) + bx / 8 : bx; }
    unsigned char* ws = args.ws;
    F.ctl = (gu32*)(ws + WS_CTL);
    for (int u = F.tid; u < 256; u += NWAVES * 64) ((LAS unsigned*)(F.lds + LDSCTL_OFF))[u] = 0u;
    __syncthreads();
#if MK_PER_PHASE
#define GRID_BAR() do { } while (0)
#else
    XcdBarrier bar = xcd_barrier_post((unsigned*)(F.ctl + CW_BAR), F.MISC + 8);
#define GRID_BAR() xcd_barrier(bar)
#endif
    const int lo = args.ph_lo, hi = args.ph_hi;
#define IN(k) (lo <= (k) && (k) < hi)
#define BOTH(k) (IN(k) && (k) + 1 < hi)

    float* H = (float*)(ws + WS_H); bf16* HB = (bf16*)(ws + WS_HB); float* SSQ = (float*)(ws + WS_SSQ);
    bf16* QB = (bf16*)(ws + WS_Q); bf16* KB = (bf16*)(ws + WS_K); bf16* VB = (bf16*)(ws + WS_V); bf16* MIX = (bf16*)(ws + WS_MIX); bf16* ACT = (bf16*)(ws + WS_ACT);

    if (IN(0)) { p0_prologue(F, args); if (BOTH(0)) GRID_BAR(); }

#pragma unroll 1
    for (int s = 0; s < 12; ++s) {
        const int layer = s / 3, kind = s - 3 * layer, pb = 1 + 3 * s;
        int ltid = threadIdx.x; asm volatile("" : "+v"(ltid));
        if (IN(pb)) {
            if (kind != 1) {
                const int f = 2 * layer + (kind >> 1);
                pg8::Gemm g{HB, w_gu(ws, f), M, 2 * FF, DM}; pg8::StaticOrder S; S.init(M, 2 * FF, F.G, (int)blockIdx.x);
                pg8::EpiSwiglu E{ACT, FF, SSQ};
                pg8::gemm_phase<pg8::EpiSwiglu, pg8::StaticOrder, true, true>(F.lds + RING_OFF, g, S, E, ltid);
            } else {
                const int N = layer < 3 ? 3 * DM : DM;
                pg8::Gemm g{HB, w_mix1(ws, layer), M, N, DM}; pg8::StaticOrder S; S.init(M, N, F.G, (int)blockIdx.x);
                pg8::EpiScaleBf16 E{QB, (size_t)(WS_K - WS_Q) / 2, SSQ};
                pg8::gemm_phase<pg8::EpiScaleBf16, pg8::StaticOrder, true, true>(F.lds + RING_OFF, g, S, E, ltid);
            }
            if (BOTH(pb)) GRID_BAR();
        }
        if (kind == 1 && IN(pb + 1)) {
            for (int p = F.vcu; p < 256; p += F.G) {
                const int bh = p >> 2, j = p & 3, b = bh >> 4, h = bh & 15;
                if (layer < 2) { att::stick_unit(QB, KB, VB, MIX, b, h, 7 - j, (char*)lds + RING_OFF, ltid); att::stick_unit(QB, KB, VB, MIX, b, h, j, (char*)lds + RING_OFF, ltid); }
                else { const float* bias = args.in[12] + ((size_t)(layer - 2) * NH + h) * 513;
                       att::band_unit(QB, KB, VB, MIX, bias, b, h, 7 - j, (char*)lds + RING_OFF, ltid); att::band_unit(QB, KB, VB, MIX, bias, b, h, j, (char*)lds + RING_OFF, ltid); }
            }
            if (BOTH(pb + 1)) GRID_BAR();
        }
        if (IN(pb + 2)) {
            const bool ffn = kind != 1; const int f = 2 * layer + (kind >> 1);
            pg8::Gemm g{ffn ? ACT : MIX, ffn ? w_dn(ws, f) : w_mixo(ws, layer), M, DM, ffn ? FF : DM}; pg8::StaticOrder S; S.init(M, DM, F.G, (int)blockIdx.x);
            pg8::EpiResid E{s == 0 ? args.in[0] : (const float*)H, H, HB, SSQ, ffn ? 0.5f : 1.0f};
            pg8::gemm_phase<pg8::EpiResid, pg8::StaticOrder, true, true>(F.lds + RING_OFF, g, S, E, ltid);
            if (BOTH(pb + 2)) GRID_BAR();
        }
    }
    if (IN(37)) final_norm(F, args);
#undef IN
#undef BOTH
}

extern "C" void kernel_launch(void* const* d_in, const int* in_sizes, int n_in, void* d_out, int out_size, void* d_ws, size_t ws_size, hipStream_t stream) {
    static int grid = 0;
    if (grid == 0) {
        if (n_in != 14 || in_sizes[0] != M * DM || out_size != M * DM || ws_size < WS_END) { fprintf(stderr, "kernel_launch: shape mismatch: n_in %d in0 %d out %d ws %zu (need %zu)\n", n_in, n_in > 0 ? in_sizes[0] : -1, out_size, ws_size, (size_t)WS_END); grid = -1; return; }
        int dev = 0, cus = 0, per_cu = 0;
        if (hipGetDevice(&dev) != hipSuccess || hipDeviceGetAttribute(&cus, hipDeviceAttributeMultiprocessorCount, dev) != hipSuccess) { fprintf(stderr, "kernel_launch: device query failed\n"); grid = -1; return; }
        if (hipFuncSetAttribute((const void*)mega_fwd, hipFuncAttributeMaxDynamicSharedMemorySize, LDS_BYTES) != hipSuccess) { fprintf(stderr, "kernel_launch: hipFuncSetAttribute failed\n"); grid = -1; return; }
        if (hipOccupancyMaxActiveBlocksPerMultiprocessor(&per_cu, (const void*)mega_fwd, NWAVES * 64, LDS_BYTES) != hipSuccess || per_cu < 1) { fprintf(stderr, "kernel_launch: occupancy query reports %d workgroups per CU\n", per_cu); (void)hipGetLastError(); grid = -1; return; }
        grid = cus;
    }
    if (grid < 0) return;
    if (hipMemsetAsync((char*)d_ws + WS_CTL, 0, CTL_ZERO_BYTES, stream) != hipSuccess) { fprintf(stderr, "kernel_launch: hipMemsetAsync failed\n"); return; }
    Args a{};
    for (int i = 0; i < 14; ++i) a.in[i] = (const float*)d_in[i];
    a.out = (float*)d_out; a.ws = (unsigned char*)d_ws;
#if MK_PER_PHASE
    for (int ph = 0; ph < N_PHASES; ++ph) {
        if (ph >= 1 && ph <= 36) { const int s = (ph - 1) / 3, j = (ph - 1) % 3; if (j == 1 && (s % 3) != 1) continue; }
        a.ph_lo = ph; a.ph_hi = ph + 1;
        hipLaunchKernelGGL(mega_fwd, dim3(grid), dim3(NWAVES * 64), LDS_BYTES, stream, a);
    }
#else
    a.ph_lo = 0; a.ph_hi = N_PHASES;
    hipLaunchKernelGGL(mega_fwd, dim3(grid), dim3(NWAVES * 64), LDS_BYTES, stream, a);
#endif
    const hipError_t le = hipPeekAtLastError();
    if (le != hipSuccess) fprintf(stderr, "kernel_launch: launch failed: %s (grid %d)\n", hipGetErrorName(le), grid);
}
```

```cpp
#include <hip/hip_runtime.h>
#include <cstdio>
#include <cstdint>
#ifndef PROBE_DUP
#define PROBE_DUP 0
#endif
namespace pg8 {
#define PG8_LAS __attribute__((address_space(3)))
typedef unsigned short bf16_t;
typedef short bf16x8 __attribute__((ext_vector_type(8)));
typedef float f32x4 __attribute__((ext_vector_type(4)));
typedef unsigned u32x4 __attribute__((ext_vector_type(4)));
constexpr int BM = 256, BK = 64, HALF = 128, HTB = HALF * BK * 2  , STAGE_BYTES = 8 * HTB, NXCD = 8, WGM = 8;

__host__ __device__ __forceinline__ int lds_byte(int r, int c) { const int st = (r >> 4) * 2 + (c >> 5), rr = r & 15, cc = c & 31, ob = rr * 64 + cc * 2; return st * 1024 + (ob ^ (((ob >> 9) & 1) << 5)); }
__host__ __device__ __forceinline__ void stage_rc(int b, int& R, int& C) { const int st = b / 1024, sb = b % 1024, swz = sb ^ (((sb >> 9) & 1) << 5); R = (st >> 1) * 16 + swz / 64; C = (st & 1) * 32 + (swz % 64) / 2; }
__host__ __device__ __forceinline__ int perm32(int rho) { const int n = rho >> 4, i = rho & 15; return 8 * (i >> 2) + 4 * n + (i & 3); }

struct Unit { int pm, pn; };
struct Gemm { const bf16_t* A; const bf16_t* Bt; int M, N, K; };

struct StaticOrder {
    int nM, nN, nwg, G, c;
    __host__ __device__ void init(int M, int N, int G_, int c_) { nM = M / BM; nN = N / BM; nwg = nM * nN; G = G_; c = c_; }
    __host__ __device__ bool next(int i, Unit& u) const {
        const long L = (long)i * G + c; if (L >= nwg) return false;
        int wgid = (int)L; { const int q = nwg / NXCD, r = nwg % NXCD, xcd = wgid % NXCD, off = wgid / NXCD; wgid = (xcd < r ? xcd * (q + 1) : r * (q + 1) + (xcd - r) * q) + off; }
        const int nig = WGM * nN, gid = wgid / nig, fm = gid * WGM, gsz = (nM - fm) < WGM ? (nM - fm) : WGM;
        u.pm = fm + ((wgid % nig) % gsz); u.pn = (wgid % nig) / gsz; return true;
    }
    __device__ __forceinline__ void a_ready(const Unit&) const {}
    __device__ __forceinline__ void done(const Unit&) const {}
};

typedef float f32x2c __attribute__((ext_vector_type(2))); typedef __bf16 bf16x2c __attribute__((ext_vector_type(2)));
__device__ __forceinline__ unsigned cvt_pk_bf16(float lo, float hi) { const f32x2c v = {lo, hi}; const bf16x2c b = __builtin_convertvector(v, bf16x2c); return __builtin_bit_cast(unsigned, b); }
typedef float f32x2 __attribute__((ext_vector_type(2)));
__device__ __forceinline__ float row_scale(const float* ssq, int row, int fq) {
    const f32x4* p = (const f32x4*)(ssq + (size_t)row * 32 + fq * 8);
    const f32x4 a = p[0], b = p[1];
    float s = ((a[0] + a[1]) + (a[2] + a[3])) + ((b[0] + b[1]) + (b[2] + b[3]));
    s += __shfl_xor(s, 16); s += __shfl_xor(s, 32);
    return __builtin_amdgcn_rsqf(s * (1.0f / 2048.0f) + 1e-6f);
}
struct EpiSwiglu {
    static constexpr bool PERM = true, AFTER_DRAIN = false;
    bf16_t* O; int ldc; const float* ssq; const PG8_LAS float* tab; int pm0;
    __device__ __forceinline__ void operator()(const f32x4 (&acc)[2][2][4][2], const Unit& u, int wr, int wc, int fr, int fq) const {
        const int row0 = u.pm * BM + wr * 64 + fr, col0 = u.pn * HALF + wc * 32 + 8 * fq;
        float sc[8];
        if (u.pm == pm0) {
#pragma unroll
            for (int q = 0; q < 8; ++q) sc[q] = tab[wr * 64 + fr + (q >> 2) * HALF + (q & 3) * 16];
        } else {
#pragma unroll
            for (int q = 0; q < 8; ++q) sc[q] = row_scale(ssq, row0 + (q >> 2) * HALF + (q & 3) * 16, fq);
        }
#pragma unroll
        for (int ai = 0; ai < 2; ++ai)
#pragma unroll
            for (int m = 0; m < 4; ++m) {
                const int row = row0 + ai * HALF + m * 16; const float s = sc[ai * 4 + m];
                const float k = s * -1.4426950408889634f, s2 = s * s;
                float o[8];
#pragma unroll
                for (int n = 0; n < 2; ++n)
#pragma unroll
                    for (int i = 0; i < 4; ++i) { const float g = acc[ai][0][m][n][i], up = acc[ai][1][m][n][i];
                        const float r = __builtin_amdgcn_rcpf(1.0f + __builtin_amdgcn_exp2f(g * k));
                        o[n * 4 + i] = (g * up) * (r * s2); }
                u32x4 w; w.x = cvt_pk_bf16(o[0], o[1]); w.y = cvt_pk_bf16(o[2], o[3]); w.z = cvt_pk_bf16(o[4], o[5]); w.w = cvt_pk_bf16(o[6], o[7]);
                *(u32x4*)(O + (size_t)row * ldc + col0) = w; }
    }
};
struct EpiScaleBf16 {
    static constexpr bool PERM = true, AFTER_DRAIN = false;
    bf16_t* O; size_t split_stride; const float* ssq; const PG8_LAS float* tab; int pm0;
    __device__ __forceinline__ void operator()(const f32x4 (&acc)[2][2][4][2], const Unit& u, int wr, int wc, int fr, int fq) const {
        const int row0 = u.pm * BM + wr * 64 + fr; const int t = u.pn >> 3;
        float sc[8];
        if (u.pm == pm0) {
#pragma unroll
            for (int q = 0; q < 8; ++q) sc[q] = tab[wr * 64 + fr + (q >> 2) * HALF + (q & 3) * 16];
        } else {
#pragma unroll
            for (int q = 0; q < 8; ++q) sc[q] = row_scale(ssq, row0 + (q >> 2) * HALF + (q & 3) * 16, fq);
        } bf16_t* base = O + (size_t)t * split_stride;
        const int col0 = (u.pn & 7) * BM + wc * 32 + 8 * fq;
#pragma unroll
        for (int ai = 0; ai < 2; ++ai)
#pragma unroll
            for (int m = 0; m < 4; ++m) {
                const int row = row0 + ai * HALF + m * 16; const float s = sc[ai * 4 + m];
                bf16_t* rowp = base + (size_t)row * 2048 + col0;
#pragma unroll
                for (int bj = 0; bj < 2; ++bj) { const f32x4 v0 = acc[ai][bj][m][0] * s, v1 = acc[ai][bj][m][1] * s;
                    u32x4 w; w.x = cvt_pk_bf16(v0[0], v0[1]); w.y = cvt_pk_bf16(v0[2], v0[3]); w.z = cvt_pk_bf16(v1[0], v1[1]); w.w = cvt_pk_bf16(v1[2], v1[3]);
                    *(u32x4*)(rowp + bj * HALF) = w; } }
    }
};
#ifndef RESID_LO
#define RESID_LO 2
#endif
__device__ __forceinline__ float bf_lo(unsigned w) { return __uint_as_float(w << 16); }
__device__ __forceinline__ float bf_hi(unsigned w) { return __uint_as_float(w & 0xffff0000u); }
struct EpiResid {
    static constexpr bool PERM = true, AFTER_DRAIN = false;
    const bf16_t* bhi; const void* blo; bf16_t* ohi; void* olo; float* ssq; float coef;
    __device__ __forceinline__ void operator()(const f32x4 (&acc)[2][2][4][2], const Unit& u, int wr, int wc, int fr, int fq) const {
        typedef unsigned u32x2v __attribute__((ext_vector_type(2))); typedef float f32x2v __attribute__((ext_vector_type(2)));
        const int row0 = u.pm * BM + wr * 64 + fr, col0 = u.pn * BM + wc * 32 + 8 * fq;
        float ssr[8];
#if RESID_LO == 2
        const char* hb = (const char*)bhi; const char* lb = (const char*)blo; char* ho = (char*)ohi; char* lo_ = (char*)olo;
        const unsigned hoff0 = ((unsigned)row0 * 2048u + (unsigned)col0) * 2u, loff0 = (unsigned)row0 * 2048u + (unsigned)(u.pn * BM + wc * 64 + fq * 16);
        const float c512 = 512.0f, i512 = 1.0f / 512.0f;
#pragma unroll
        for (int ai = 0; ai < 2; ++ai)
#pragma unroll
            for (int m = 0; m < 4; ++m) {
                const unsigned rofs = (unsigned)(ai * HALF + m * 16) * 2048u;
                const u32x4 h0 = *(const u32x4*)(hb + hoff0 + rofs * 2u), h1 = *(const u32x4*)(hb + hoff0 + rofs * 2u + HALF * 2), l16 = *(const u32x4*)(lb + loff0 + rofs);
                unsigned wh[8], wl[4] = {0u, 0u, 0u, 0u}; float ss = 0.f;
#pragma unroll
                for (int bj = 0; bj < 2; ++bj)
#pragma unroll
                    for (int j = 0; j < 4; ++j) { const unsigned hw = bj ? h1[j] : h0[j]; const unsigned lw = l16[2 * bj + (j >> 1)];
                        const f32x2v lf = (j & 1) ? __builtin_amdgcn_cvt_pk_f32_fp8((int)lw, true) : __builtin_amdgcn_cvt_pk_f32_fp8((int)lw, false);
                        const float a0 = acc[ai][bj][m][j >> 1][(2 * j) & 3], a1 = acc[ai][bj][m][j >> 1][(2 * j + 1) & 3];
                        const float o0 = __builtin_fmaf(a0, coef, __builtin_fmaf(lf.x, i512, bf_lo(hw))), o1 = __builtin_fmaf(a1, coef, __builtin_fmaf(lf.y, i512, bf_hi(hw)));
                        const unsigned nh = cvt_pk_bf16(o0, o1); wh[4 * bj + j] = nh;
                        const float r0 = (o0 - bf_lo(nh)) * c512, r1 = (o1 - bf_hi(nh)) * c512;
                        wl[2 * bj + (j >> 1)] = (j & 1) ? (unsigned)__builtin_amdgcn_cvt_pk_fp8_f32(r0, r1, (int)wl[2 * bj + (j >> 1)], true) : (unsigned)__builtin_amdgcn_cvt_pk_fp8_f32(r0, r1, (int)wl[2 * bj + (j >> 1)], false);
                        ss = __builtin_fmaf(o0, o0, ss); ss = __builtin_fmaf(o1, o1, ss); }
                *(u32x4*)(ho + hoff0 + rofs * 2u) = (u32x4){wh[0], wh[1], wh[2], wh[3]}; *(u32x4*)(ho + hoff0 + rofs * 2u + HALF * 2) = (u32x4){wh[4], wh[5], wh[6], wh[7]};
                *(u32x4*)(lo_ + loff0 + rofs) = (u32x4){wl[0], wl[1], wl[2], wl[3]};
                ss += __shfl_xor(ss, 16); ss += __shfl_xor(ss, 32); ssr[ai * 4 + m] = ss;
                if (m == 3) asm volatile("" ::: "memory");
            }
#else
#pragma unroll
        for (int ai = 0; ai < 2; ++ai)
#pragma unroll
            for (int m = 0; m < 4; ++m) {
                const int q = ai * 4 + m; const int row = row0 + ai * HALF + m * 16; const size_t off = (size_t)row * 2048 + col0; float ss = 0.f;
                u32x4 hvq[2], lvq[2]; u32x2v l8q[2];
#pragma unroll
                for (int bj = 0; bj < 2; ++bj) { hvq[bj] = *(const u32x4*)(bhi + off + bj * HALF);
                    if (RESID_LO == 1) lvq[bj] = *(const u32x4*)((const bf16_t*)blo + off + bj * HALF);
                }
                if (RESID_LO == 2) { const u32x4 l16 = *(const u32x4*)((const unsigned char*)blo + (size_t)row * 2048 + u.pn * BM + wc * 64 + fq * 16);
                    l8q[0] = (u32x2v){l16[0], l16[1]}; l8q[1] = (u32x2v){l16[2], l16[3]}; }
                u32x4 w16 = {0u, 0u, 0u, 0u};
#pragma unroll
                for (int bj = 0; bj < 2; ++bj) { float o[8]; u32x4 wh, wl; u32x2v w8 = {0u, 0u};
#pragma unroll
                    for (int j = 0; j < 4; ++j) { const unsigned hw = hvq[bj][j]; float b0 = bf_lo(hw), b1 = bf_hi(hw);
                        if (RESID_LO == 1) { const unsigned lw = lvq[bj][j]; b0 += bf_lo(lw); b1 += bf_hi(lw); }
                        if (RESID_LO == 2) { const f32x2v lf = (j & 1) ? __builtin_amdgcn_cvt_pk_f32_fp8((int)l8q[bj][j >> 1], true) : __builtin_amdgcn_cvt_pk_f32_fp8((int)l8q[bj][j >> 1], false);
                            b0 += lf.x * (1.0f / 512.0f); b1 += lf.y * (1.0f / 512.0f); }
                        o[2 * j] = b0 + acc[ai][bj][m][j >> 1][(2 * j) & 3] * coef; o[2 * j + 1] = b1 + acc[ai][bj][m][j >> 1][(2 * j + 1) & 3] * coef;
                        const unsigned nh = cvt_pk_bf16(o[2 * j], o[2 * j + 1]); wh[j] = nh;
                        if (RESID_LO == 1) wl[j] = cvt_pk_bf16(o[2 * j] - bf_lo(nh), o[2 * j + 1] - bf_hi(nh));
                        if (RESID_LO == 2) { const float r0 = (o[2 * j] - bf_lo(nh)) * 512.0f, r1 = (o[2 * j + 1] - bf_hi(nh)) * 512.0f;
                            w8[j >> 1] = (j & 1) ? (unsigned)__builtin_amdgcn_cvt_pk_fp8_f32(r0, r1, (int)w8[j >> 1], true) : (unsigned)__builtin_amdgcn_cvt_pk_fp8_f32(r0, r1, (int)w8[j >> 1], false); }
                        ss += o[2 * j] * o[2 * j] + o[2 * j + 1] * o[2 * j + 1]; }
                    *(u32x4*)(ohi + off + bj * HALF) = wh;
                    if (RESID_LO == 1) *(u32x4*)((bf16_t*)olo + off + bj * HALF) = wl;
                    if (RESID_LO == 2) { w16[2 * bj] = w8[0]; w16[2 * bj + 1] = w8[1]; } }
                if (RESID_LO == 2) *(u32x4*)((unsigned char*)olo + (size_t)row * 2048 + u.pn * BM + wc * 64 + fq * 16) = w16;
                ss += __shfl_xor(ss, 16); ss += __shfl_xor(ss, 32); ssr[q] = ss;
                if (m == 3) asm volatile("" ::: "memory");
            }
#endif
        { const float v0 = fq == 0 ? ssr[0] : fq == 1 ? ssr[2] : fq == 2 ? ssr[4] : ssr[6], v1 = fq == 0 ? ssr[1] : fq == 1 ? ssr[3] : fq == 2 ? ssr[5] : ssr[7];
          float* p = ssq + (size_t)(row0 + (fq >> 1) * HALF + (fq & 1) * 32) * 32 + u.pn * 4 + wc; p[0] = v0; p[16 * 32] = v1; }
    }
};

template <class E1> struct EpiTwice {
    static constexpr bool PERM = E1::PERM, AFTER_DRAIN = false;
    E1 a, b;
    __device__ __forceinline__ void operator()(const f32x4 (&acc)[2][2][4][2], const Unit& u, int wr, int wc, int fr, int fq) const { a(acc, u, wr, wc, fr, fq); asm volatile("" ::: "memory"); b(acc, u, wr, wc, fr, fq); }
};
template <class Epi, class Sched, bool ALIGN_EPI = false, bool SP2 = false>
__device__ __forceinline__ void gemm_phase(PG8_LAS unsigned char* lds, const Gemm g, const Sched& S, const Epi& E, const int tid) {
    const int wid = __builtin_amdgcn_readfirstlane(tid >> 6), lane = tid & 63, wr = wid >> 2, wc = wid & 3, fr = lane & 15, fq = lane >> 4;
    const int K = g.K, nt = K / BK;
    unsigned voffA[2], voffB[2];
#pragma unroll
    for (int i = 0; i < 2; ++i) { int R, C; stage_rc(tid * 16 + i * 8192, R, C); const int Rb = Epi::PERM ? ((R & ~31) + perm32(R & 31)) : R;
        voffA[i] = (unsigned)(R * K + C) * 2u; voffB[i] = (unsigned)(Rb * K + C) * 2u; }
    const size_t kstep = (size_t)(BK * 2);
    const size_t hstep = (size_t)HALF * K * 2;
    const size_t tstep = 2 * hstep;
    const unsigned ldsw = (unsigned)wid * 1024u;
    const int aoff = lds_byte(wr * 64 + fr, fq * 8), boff = lds_byte(wc * 32 + fr, fq * 8);
#define PG8_SA(b, h) (((b) * 2 + (h)) * HTB)
#define PG8_SB(b, h) ((4 + (b) * 2 + (h)) * HTB)
#define PG8_STAGE(bufoff, gbase, voff) do { _Pragma("unroll") for (int _i = 0; _i < 2; ++_i) \
        __builtin_amdgcn_global_load_lds((const unsigned*)((const char*)(gbase) + (voff)[_i]), (PG8_LAS unsigned*)(lds + (bufoff) + ldsw + _i * 8192), 16, 0, 0); } while (0)
#define PG8_LDA(dst, b, h) do { _Pragma("unroll") for (int m = 0; m < 4; ++m) _Pragma("unroll") for (int k = 0; k < 2; ++k) dst[m][k] = *(const PG8_LAS bf16x8*)(lds + PG8_SA(b, h) + aoff + m * 2048 + k * 1024); } while (0)
#define PG8_LDB(dst, b, h) do { _Pragma("unroll") for (int n = 0; n < 2; ++n) _Pragma("unroll") for (int k = 0; k < 2; ++k) dst[n][k] = *(const PG8_LAS bf16x8*)(lds + PG8_SB(b, h) + boff + n * 2048 + k * 1024); } while (0)
#define PG8_MMA(ai, bj, At, Bt) do { __builtin_amdgcn_s_setprio(1); _Pragma("unroll") for (int m = 0; m < 4; ++m) _Pragma("unroll") for (int n = 0; n < 2; ++n) _Pragma("unroll") for (int k = 0; k < 2; ++k) \
        acc[ai][bj][m][n] = __builtin_amdgcn_mfma_f32_16x16x32_bf16(Bt[n][k], At[m][k], acc[ai][bj][m][n], 0, 0, 0); __builtin_amdgcn_s_setprio(0); } while (0)
#define PG8_WAIT_V(n) asm volatile("s_waitcnt vmcnt(" #n ")" ::: "memory")
#define PG8_WAIT_L(n) asm volatile("s_waitcnt lgkmcnt(" #n ")" ::: "memory")
#define PG8_BAR __builtin_amdgcn_s_barrier()
#define PG8_SCHED __builtin_amdgcn_sched_barrier(0)
    Unit cur, nxt; int ui = 0;
    if (!S.next(0, cur)) return;
    f32x4 acc[2][2][4][2];
#pragma unroll
    for (int a = 0; a < 2; ++a)
#pragma unroll
        for (int b = 0; b < 2; ++b)
#pragma unroll
            for (int m = 0; m < 4; ++m)
#pragma unroll
                for (int n = 0; n < 2; ++n) acc[a][b][m][n] = (f32x4){0.f, 0.f, 0.f, 0.f};
    bf16x8 At[4][2], B0[2][2], B1[2][2];
    const char* cA = (const char*)g.A + (size_t)cur.pm * tstep; const char* cB = (const char*)g.Bt + (size_t)cur.pn * tstep;
    S.a_ready(cur);
    if constexpr (SP2) {
        PG8_STAGE(PG8_SB(0, 0), cB, voffB); PG8_STAGE(PG8_SB(0, 1), cB + hstep, voffB); PG8_STAGE(PG8_SA(0, 0), cA, voffA); PG8_STAGE(PG8_SA(0, 1), cA + hstep, voffA);
        if (wr == 1) PG8_BAR;
        PG8_WAIT_V(2); PG8_BAR;
        PG8_STAGE(PG8_SB(1, 0), cB + kstep, voffB); PG8_STAGE(PG8_SA(1, 0), cA + kstep, voffA); PG8_STAGE(PG8_SB(1, 1), cB + hstep + kstep, voffB);
        PG8_WAIT_V(6); PG8_BAR;
    } else {
        PG8_STAGE(PG8_SB(0, 0), cB, voffB); PG8_STAGE(PG8_SA(0, 0), cA, voffA); PG8_STAGE(PG8_SB(0, 1), cB + hstep, voffB); PG8_STAGE(PG8_SA(0, 1), cA + hstep, voffA);
        if (wr == 1) PG8_BAR;
        PG8_WAIT_V(4); PG8_BAR;
        PG8_STAGE(PG8_SB(1, 0), cB + kstep, voffB); PG8_STAGE(PG8_SA(1, 0), cA + kstep, voffA); PG8_STAGE(PG8_SB(1, 1), cB + hstep + kstep, voffB);
        PG8_WAIT_V(6); PG8_BAR;
    }
    for (;;) {
        const bool has_next = S.next(ui + 1, nxt);
        const char* nA = has_next ? (const char*)g.A + (size_t)nxt.pm * tstep : cA; const char* nB = has_next ? (const char*)g.Bt + (size_t)nxt.pn * tstep : cB;
        for (int t = 0; t < nt; t += 2) {
            const bool last = (t == nt - 2);
            const char* a1 = cA + (size_t)(t + 1) * kstep;
            const char* a2 = last ? nA : cA + (size_t)(t + 2) * kstep; const char* b2 = last ? nB : cB + (size_t)(t + 2) * kstep;
            const char* a3 = a2 + kstep; const char* b3 = b2 + kstep;
            if (last && has_next) S.a_ready(nxt);
            if constexpr (SP2) {
            PG8_LDB(B0, 0, 0); PG8_LDB(B1, 0, 1); PG8_SCHED; PG8_LDA(At, 0, 0); PG8_STAGE(PG8_SA(1, 1), a1 + hstep, voffA);
            PG8_WAIT_V(8); PG8_WAIT_L(0); PG8_BAR; PG8_MMA(0, 0, At, B0); PG8_MMA(0, 1, At, B1); PG8_BAR; PG8_SCHED;
            PG8_LDA(At, 0, 1); PG8_STAGE(PG8_SB(0, 0), b2, voffB); PG8_STAGE(PG8_SB(0, 1), b2 + hstep, voffB); PG8_STAGE(PG8_SA(0, 0), a2, voffA);
            PG8_WAIT_V(8); PG8_WAIT_L(0); PG8_BAR; PG8_MMA(1, 0, At, B0); PG8_MMA(1, 1, At, B1); PG8_BAR; PG8_SCHED;
            PG8_LDB(B0, 1, 0); PG8_LDB(B1, 1, 1); PG8_SCHED; PG8_LDA(At, 1, 0); PG8_STAGE(PG8_SA(0, 1), a2 + hstep, voffA);
            PG8_WAIT_V(8); PG8_WAIT_L(0); PG8_BAR; PG8_MMA(0, 0, At, B0); PG8_MMA(0, 1, At, B1); PG8_BAR; PG8_SCHED;
            PG8_LDA(At, 1, 1); PG8_STAGE(PG8_SB(1, 0), b3, voffB); PG8_STAGE(PG8_SB(1, 1), b3 + hstep, voffB); PG8_STAGE(PG8_SA(1, 0), a3, voffA);
            PG8_WAIT_V(8); PG8_WAIT_L(0); PG8_BAR; PG8_MMA(1, 0, At, B0); PG8_MMA(1, 1, At, B1); PG8_BAR; PG8_SCHED;
            } else {
            PG8_LDB(B0, 0, 0); PG8_SCHED; PG8_LDA(At, 0, 0); PG8_STAGE(PG8_SA(1, 1), a1 + hstep, voffA);
            PG8_WAIT_L(8); PG8_BAR; PG8_WAIT_L(0); PG8_MMA(0, 0, At, B0); PG8_BAR; PG8_SCHED;
            PG8_LDB(B1, 0, 1); PG8_STAGE(PG8_SB(0, 0), b2, voffB);
            PG8_BAR; PG8_WAIT_L(0); PG8_MMA(0, 1, At, B1); PG8_BAR;
            PG8_LDA(At, 0, 1); PG8_STAGE(PG8_SA(0, 0), a2, voffA);
            PG8_BAR; PG8_WAIT_L(0); PG8_MMA(1, 0, At, B0); PG8_BAR; PG8_SCHED;
            PG8_STAGE(PG8_SB(0, 1), b2 + hstep, voffB);
            PG8_WAIT_V(6); PG8_BAR; PG8_MMA(1, 1, At, B1); PG8_BAR;
            PG8_LDB(B0, 1, 0); PG8_SCHED; PG8_LDA(At, 1, 0); PG8_STAGE(PG8_SA(0, 1), a2 + hstep, voffA);
            PG8_WAIT_L(8); PG8_BAR; PG8_WAIT_L(0); PG8_MMA(0, 0, At, B0); PG8_BAR; PG8_SCHED;
            PG8_LDB(B1, 1, 1); PG8_STAGE(PG8_SB(1, 0), b3, voffB);
            PG8_BAR; PG8_WAIT_L(0); PG8_MMA(0, 1, At, B1); PG8_BAR;
            PG8_LDA(At, 1, 1); PG8_STAGE(PG8_SA(1, 0), a3, voffA);
            PG8_BAR; PG8_WAIT_L(0); PG8_MMA(1, 0, At, B0); PG8_BAR; PG8_SCHED;
            PG8_STAGE(PG8_SB(1, 1), b3 + hstep, voffB);
            PG8_WAIT_V(6); PG8_BAR; PG8_MMA(1, 1, At, B1); PG8_BAR;
            }
        }
        if constexpr (ALIGN_EPI) { if (wr == 0) PG8_BAR; }
        if constexpr (!Epi::AFTER_DRAIN) { E(acc, cur, wr, wc, fr, fq); S.done(cur); }
        if (!has_next) break;
#pragma unroll
        for (int a = 0; a < 2; ++a)
#pragma unroll
            for (int b = 0; b < 2; ++b)
#pragma unroll
                for (int m = 0; m < 4; ++m)
#pragma unroll
                    for (int n = 0; n < 2; ++n) acc[a][b][m][n] = (f32x4){0.f, 0.f, 0.f, 0.f};
        cur = nxt; cA = nA; cB = nB; ++ui;
        if constexpr (ALIGN_EPI) { if (wr == 1) PG8_BAR; }
    }
    PG8_WAIT_V(0);
    if constexpr (!ALIGN_EPI) { if (wr == 0) PG8_BAR; }
    PG8_BAR;
    if constexpr (Epi::AFTER_DRAIN) { E.fused(acc, cur, wr, wc, fr, fq, lds, wid, lane); S.done(cur); }
#undef PG8_SA
#undef PG8_SB
#undef PG8_STAGE
#undef PG8_LDA
#undef PG8_LDB
#undef PG8_MMA
#undef PG8_WAIT_V
#undef PG8_WAIT_L
#undef PG8_BAR
#undef PG8_SCHED
}
}

#define GAS __attribute__((address_space(1)))
#define LAS __attribute__((address_space(3)))
typedef unsigned short bf16;
typedef unsigned v4u __attribute__((ext_vector_type(4)));
typedef float f32x4 __attribute__((ext_vector_type(4)));
typedef short bf16x8 __attribute__((ext_vector_type(8)));
typedef GAS unsigned gu32;
typedef GAS unsigned long long gu64;
#define RLX_AGENT __ATOMIC_RELAXED, __HIP_MEMORY_SCOPE_AGENT
#define LDS_WAIT() asm volatile("s_waitcnt lgkmcnt(0)" ::: "memory")
#define VM_WAIT() asm volatile("s_waitcnt vmcnt(0)" ::: "memory")
__device__ __forceinline__ unsigned long long rt() { return __builtin_amdgcn_s_memrealtime(); }
__device__ __forceinline__ unsigned f2bf(float f) { unsigned u = __builtin_bit_cast(unsigned, f); return (u + 0x7fffu + ((u >> 16) & 1u)) >> 16; }
__device__ __forceinline__ unsigned pk2(float lo, float hi) { return f2bf(lo) | (f2bf(hi) << 16); }

#define XB_TMO      128
#define XB_XCNT(j)  (256  + 64 * (j))
#define XB_XSUB(j)  (1280 + 64 * (j))
#define XB_XGEN(j)  (2304 + 64 * (j))
#define XB_TOP      3328
#define XB_TOPGEN   3392
#define XCD_BAR_WORDS 3456
#define XB_SPIN_CAP (1u << 18)

__device__ __forceinline__ unsigned xb_ld(unsigned* p)              { return __hip_atomic_load(p, __ATOMIC_RELAXED, __HIP_MEMORY_SCOPE_AGENT); }
__device__ __forceinline__ unsigned xb_add(unsigned* p, unsigned v) { return __hip_atomic_fetch_add(p, v, __ATOMIC_RELAXED, __HIP_MEMORY_SCOPE_AGENT); }
__device__ __forceinline__ unsigned xb_xcc_id() { return (unsigned)__builtin_amdgcn_s_getreg((3 << 11) | 20) & 0xFu; }
#define XB_SPIN(cond, bar) do { unsigned _sp = 0; while (cond) { __builtin_amdgcn_s_sleep(1); \
    if ((++_sp & 255u) == 0u) { if (xb_ld(&(bar)[XB_TMO])) break; if (_sp > XB_SPIN_CAP) { atomicAdd(&(bar)[XB_TMO], 1u); break; } } } } while (0)

struct XcdBarrier {
    unsigned* bar; unsigned x;
    volatile LAS unsigned* st;
};

__device__ __forceinline__ XcdBarrier xcd_barrier_post(unsigned* bar, volatile LAS unsigned* st) {
    XcdBarrier b; b.bar = bar; b.x = xb_xcc_id(); b.st = st;
    if (threadIdx.x == 0) { const unsigned rk = xb_add(&bar[XB_XCNT(b.x)], 1u); st[2] = rk; st[3] = b.x; }
    return b;
}
__device__ __forceinline__ void xcd_barrier_complete(unsigned* bar, unsigned x, unsigned& nloc, unsigned& nx) {
    const unsigned G = gridDim.x * gridDim.y * gridDim.z;
    unsigned sum, cnt, mine, sp = 0u;
    for (;;) {
        sum = 0u; cnt = 0u; mine = 0u;
#pragma unroll
        for (unsigned j = 0; j < 16; ++j) { const unsigned c = xb_ld(&bar[XB_XCNT(j)]); sum += c; cnt += (c > 0u) ? 1u : 0u; mine = (j == x) ? c : mine; }
        if (sum == G) break;
        __builtin_amdgcn_s_sleep(1);
        if ((++sp & 255u) == 0u) { if (xb_ld(&bar[XB_TMO])) break; if (sp > XB_SPIN_CAP) { atomicAdd(&bar[XB_TMO], 1u); break; } }
    }
    nloc = mine > 0u ? mine : 1u; nx = cnt > 0u ? cnt : 1u;
}

__device__ __forceinline__ void xcd_barrier(const XcdBarrier& b) {
    asm volatile("s_waitcnt vmcnt(0)" ::: "memory");
    __syncthreads();
    if (threadIdx.x == 0) {
        unsigned* bar = b.bar;
        __builtin_amdgcn_s_waitcnt(0);
        unsigned nloc = b.st[0], nx = b.st[1];
        if (nloc == 0u) { xcd_barrier_complete(bar, b.x, nloc, nx); b.st[0] = nloc; b.st[1] = nx; }
        const unsigned old = xb_add(&bar[XB_XSUB(b.x)], 1u);
        const unsigned gen = old / nloc;
        if (old + 1u == (gen + 1u) * nloc) {
            __builtin_amdgcn_fence(__ATOMIC_RELEASE, "agent");
            asm volatile("s_waitcnt vmcnt(0)" ::: "memory");
            const unsigned og = xb_add(&bar[XB_TOP], 1u);
            const unsigned tg = og / nx;
            if (og + 1u == (tg + 1u) * nx) xb_add(&bar[XB_TOPGEN], 1u);
            else XB_SPIN(xb_ld(&bar[XB_TOPGEN]) == tg, bar);
            __builtin_amdgcn_fence(__ATOMIC_ACQUIRE, "agent");
            xb_add(&bar[XB_XGEN(b.x)], 1u);
            asm volatile("s_waitcnt vmcnt(0)" ::: "memory");
        } else {
            XB_SPIN(xb_ld(&bar[XB_XGEN(b.x)]) == gen, bar);
            __builtin_amdgcn_fence(__ATOMIC_ACQUIRE, "agent");
            asm volatile("s_waitcnt vmcnt(0)" ::: "memory");
        }
    }
    __syncthreads();
}

constexpr int BATCH = 4, SEQ = 2048, DM = 2048, NH = 16, HD = 128, FF = 5632, DEPTH = 4;
constexpr int M = BATCH * SEQ;
constexpr float RMS_EPS = 1e-6f;
constexpr int NWAVES = 8;

constexpr size_t MiB = 1u << 20;
constexpr size_t WS_CTL = 0, CTL_ZERO_BYTES = 1 * MiB;
constexpr size_t WS_SSQ = 1 * MiB;
constexpr size_t WS_H = 2 * MiB;
constexpr size_t WS_HB = 66 * MiB;
constexpr size_t WS_Q = 98 * MiB, WS_K = 130 * MiB, WS_V = 162 * MiB;
constexpr size_t WS_MIX = 194 * MiB;
constexpr size_t WS_ACT = 226 * MiB;
constexpr size_t WS_W = 320 * MiB;
constexpr size_t W_FFN_STRIDE = 66 * MiB, W_FFN_DOWN = 44 * MiB;
constexpr size_t WS_WATT = WS_W + 8 * W_FFN_STRIDE;
constexpr size_t WS_END = WS_WATT + 112 * MiB;
constexpr int CW_BAR = 4096;

constexpr int RING_OFF = 0;
constexpr int SCALE_OFF = 135168;
constexpr int LDSCTL_OFF = 139264;
constexpr int LDS_BYTES = 147456;

namespace att {
using bf16x8 = __attribute__((ext_vector_type(8))) short;
using s16x4  = __attribute__((ext_vector_type(4))) short;
using f32x16 = __attribute__((ext_vector_type(16))) float;
using u32x4  = __attribute__((ext_vector_type(4))) unsigned;
constexpr int D = 128, QBLK = 32, KVBLK = 64, PITCH = 2048;
constexpr float SCALE = 0.088388347648318440f, LOG2E = 1.4426950408889634f;
constexpr int SHM_V = KVBLK * D * 2, SHM_K = KVBLK * D * 2;
constexpr int OST_ROW = 272, OST_WAVE = 32 * OST_ROW;
constexpr int OFF_V = 0, OFF_K = 2 * SHM_V, OFF_WS = NWAVES * OST_WAVE, OFF_BIAS = OFF_WS + NWAVES * 256;
static_assert(OFF_WS >= 2 * SHM_V + 2 * SHM_K && OFF_BIAS + (513 + 64) * 4 <= 131072, "attention LDS map");
#define KSWZ(row, colB) ((row) * 256 + ((colB) ^ (((row) & 7) << 4)))
#define SBAR() __builtin_amdgcn_sched_barrier(0)
__device__ __forceinline__ int crow(int r, int hi) { return (r & 3) + 8 * (r >> 2) + 4 * hi; }
__device__ __forceinline__ unsigned cvtpk(float lo, float hi) { unsigned r; asm volatile("v_cvt_pk_bf16_f32 %0, %1, %2" : "=v"(r) : "v"(lo), "v"(hi)); return r; }
__device__ __forceinline__ void qkt(f32x16& p0, f32x16& p1, const char* Ks, const bf16x8* qr, int r32, int hi) {
  p0 = f32x16{}; p1 = f32x16{};
  bf16x8 ka[4], kb[4];
#pragma unroll
  for (int hb = 0; hb < 2; ++hb) {
#pragma unroll
    for (int d = 0; d < 4; ++d) { const int cb = ((hb * 4 + d) * 16 + hi * 8) * 2;
      ka[d] = *reinterpret_cast<const bf16x8*>(Ks + KSWZ(r32, cb)); kb[d] = *reinterpret_cast<const bf16x8*>(Ks + KSWZ(32 + r32, cb)); }
    SBAR();
#pragma unroll
    for (int d = 0; d < 4; ++d) {
      p0 = __builtin_amdgcn_mfma_f32_32x32x16_bf16(ka[d], qr[hb * 4 + d], p0, 0, 0, 0);
      p1 = __builtin_amdgcn_mfma_f32_32x32x16_bf16(kb[d], qr[hb * 4 + d], p1, 0, 0, 0); }
    SBAR();
  }
}
__device__ __forceinline__ int v_st(int k, int c) { const int kk = (k & ~0xC) | ((k & 4) << 1) | ((k & 8) >> 1); return ((kk >> 3) * 4 + (c >> 5)) * 512 + ((kk & 7) * 32 + (c & 31)) * 2; }
__device__ __forceinline__ int v_rd_base(int lane) { return ((lane & 3) << 3) | (((lane >> 2) & 3) << 6) | (((lane >> 4) & 1) << 5) | (((lane >> 5) & 1) << 8); }
constexpr int v_rd_off(int d0, int ks, int half) { return d0 * 512 + ks * 4096 + half * 2048; }
template <int OFF> __device__ __forceinline__ s16x4 tr_read(int vb) {
  s16x4 r; asm volatile("ds_read_b64_tr_b16 %0, %1 offset:%2" : "=&v"(r) : "v"(vb), "i"(OFF) : "memory"); return r;
}
struct VFrag { s16x4 l0, h0, l1, h1, l2, h2, l3, h3; };
template <int D0> __device__ __forceinline__ void v_reads(VFrag& f, int vb) {
  f.l0 = tr_read<v_rd_off(D0, 0, 0)>(vb); f.h0 = tr_read<v_rd_off(D0, 0, 1)>(vb); f.l1 = tr_read<v_rd_off(D0, 1, 0)>(vb); f.h1 = tr_read<v_rd_off(D0, 1, 1)>(vb);
  f.l2 = tr_read<v_rd_off(D0, 2, 0)>(vb); f.h2 = tr_read<v_rd_off(D0, 2, 1)>(vb); f.l3 = tr_read<v_rd_off(D0, 3, 0)>(vb); f.h3 = tr_read<v_rd_off(D0, 3, 1)>(vb);
}
__device__ __forceinline__ void pv_mma(f32x16& od, const VFrag& f, bf16x8 pa0, bf16x8 pa1, bf16x8 pa2, bf16x8 pa3) {
#define PK(L, H) (bf16x8){L[0], L[1], L[2], L[3], H[0], H[1], H[2], H[3]}
  od = __builtin_amdgcn_mfma_f32_32x32x16_bf16(pa0, PK(f.l0, f.h0), od, 0, 0, 0);
  od = __builtin_amdgcn_mfma_f32_32x32x16_bf16(pa1, PK(f.l1, f.h1), od, 0, 0, 0);
  od = __builtin_amdgcn_mfma_f32_32x32x16_bf16(pa2, PK(f.l2, f.h2), od, 0, 0, 0);
  od = __builtin_amdgcn_mfma_f32_32x32x16_bf16(pa3, PK(f.l3, f.h3), od, 0, 0, 0);
#undef PK
}
__device__ __forceinline__ void pv_d0(f32x16* o, int vb, bf16x8 pa0, bf16x8 pa1, bf16x8 pa2, bf16x8 pa3) {
  VFrag fa, fb;
  v_reads<0>(fa, vb); v_reads<1>(fb, vb);
  asm volatile("s_waitcnt lgkmcnt(8)" ::: "memory"); SBAR(); pv_mma(o[0], fa, pa0, pa1, pa2, pa3); SBAR();
  v_reads<2>(fa, vb);
  asm volatile("s_waitcnt lgkmcnt(8)" ::: "memory"); SBAR(); pv_mma(o[1], fb, pa0, pa1, pa2, pa3); SBAR();
  v_reads<3>(fb, vb);
  asm volatile("s_waitcnt lgkmcnt(8)" ::: "memory"); SBAR(); pv_mma(o[2], fa, pa0, pa1, pa2, pa3); SBAR();
  asm volatile("s_waitcnt lgkmcnt(0)" ::: "memory"); SBAR(); pv_mma(o[3], fb, pa0, pa1, pa2, pa3);
}
__device__ __forceinline__ void pack_p(const f32x16& p0, const f32x16& p1, bf16x8& pa0, bf16x8& pa1, bf16x8& pa2, bf16x8& pa3) {
#define PK4(P, BASE, OUT) do { unsigned a0 = cvtpk(P[BASE + 0], P[BASE + 1]), a1 = cvtpk(P[BASE + 2], P[BASE + 3]);   \
    unsigned b0 = cvtpk(P[BASE + 4], P[BASE + 5]), b1 = cvtpk(P[BASE + 6], P[BASE + 7]);                              \
    auto r0 = __builtin_amdgcn_permlane32_swap(a0, b0, false, false); auto r1 = __builtin_amdgcn_permlane32_swap(a1, b1, false, false); \
    u32x4 w = {r0[0], r1[0], r0[1], r1[1]}; OUT = *reinterpret_cast<bf16x8*>(&w); } while (0)
  PK4(p0, 0, pa0); PK4(p0, 8, pa1); PK4(p1, 0, pa2); PK4(p1, 8, pa3);
#undef PK4
}
__device__ __forceinline__ void swap2(float x, float& lo, float& hi) {
  auto rr = __builtin_amdgcn_permlane32_swap(__float_as_uint(x), __float_as_uint(x), false, false); lo = __uint_as_float(rr[0]); hi = __uint_as_float(rr[1]);
}
__device__ __forceinline__ unsigned short f2bf1(float f) { return (unsigned short)(cvtpk(f, 0.f) & 0xffffu); }

struct Stg { bf16x8 vs0, vs1, ks0, ks1; };
__device__ __forceinline__ void sload(Stg& s, const unsigned short* Kh, const unsigned short* Vh, int k0, int sr, int sc) {
  s.vs0 = *reinterpret_cast<const bf16x8*>(Vh + (size_t)(k0 + sr) * PITCH + sc); s.vs1 = *reinterpret_cast<const bf16x8*>(Vh + (size_t)(k0 + 32 + sr) * PITCH + sc);
  s.ks0 = *reinterpret_cast<const bf16x8*>(Kh + (size_t)(k0 + sr) * PITCH + sc); s.ks1 = *reinterpret_cast<const bf16x8*>(Kh + (size_t)(k0 + 32 + sr) * PITCH + sc);
}
__device__ __forceinline__ void swrite(const Stg& s, char* lds, int buf, int sr, int sc, int vst0, int vst1) {
  *(bf16x8*)(lds + OFF_V + buf * SHM_V + vst0) = s.vs0; *(bf16x8*)(lds + OFF_V + buf * SHM_V + vst1) = s.vs1; const int kc = sc * 2;
  *(bf16x8*)(lds + OFF_K + buf * SHM_K + KSWZ(sr, kc)) = s.ks0; *(bf16x8*)(lds + OFF_K + buf * SHM_K + KSWZ(32 + sr, kc)) = s.ks1;
}
__device__ __forceinline__ void store_o(const f32x16* o, const float* rs, unsigned short* Ow, int r32, int hi, char* lds, int wid, int lane) {
  char* stg = lds + wid * OST_WAVE;
#pragma unroll
  for (int r = 0; r < 16; ++r) { const int orow = crow(r, hi);
#pragma unroll
    for (int d0 = 0; d0 < 4; ++d0) *(unsigned short*)(stg + orow * OST_ROW + (d0 * 32 + r32) * 2) = f2bf1(o[d0][r] * rs[r]); }
  asm volatile("s_waitcnt lgkmcnt(0)" ::: "memory");
#pragma unroll
  for (int j = 0; j < 8; ++j) { const int row = (lane >> 4) + 4 * j; const u32x4 v = *(const u32x4*)(stg + row * OST_ROW + (lane & 15) * 16);
    *(u32x4*)(Ow + (size_t)row * PITCH + (lane & 15) * 8) = v; }
}

template <bool MASK> __device__ __forceinline__ void stick_tile(f32x16& p0, f32x16& p1, float& Rm, int& Re, int tkh, int hi) {
  constexpr float C2 = SCALE * LOG2E;
  float x0[16], x1[16];
#pragma unroll
  for (int r = 0; r < 16; ++r) {
    { const float y = fmaxf(p0[r] * C2, -126.f); const float e = __builtin_amdgcn_exp2f(-y); const float sg = __builtin_amdgcn_rcpf(1.0f + e); const float om = e * sg;
      p0[r] = sg; x0[r] = (!MASK || ((r & 3) + 8 * (r >> 2)) < tkh) ? om : 1.0f; }
    { const float y = fmaxf(p1[r] * C2, -126.f); const float e = __builtin_amdgcn_exp2f(-y); const float sg = __builtin_amdgcn_rcpf(1.0f + e); const float om = e * sg;
      p1[r] = sg; x1[r] = (!MASK || (32 + (r & 3) + 8 * (r >> 2)) < tkh) ? om : 1.0f; }
  }
  float G[16];
#pragma unroll
  for (int c = 0; c < 4; ++c) {
    swap2((x0[4 * c] * x0[4 * c + 1]) * (x0[4 * c + 2] * x0[4 * c + 3]), G[2 * c], G[2 * c + 1]); swap2((x1[4 * c] * x1[4 * c + 1]) * (x1[4 * c + 2] * x1[4 * c + 3]), G[8 + 2 * c], G[8 + 2 * c + 1]);
  }
  float SG[16]; SG[15] = 1.0f;
#pragma unroll
  for (int g = 14; g >= 0; --g) SG[g] = SG[g + 1] * G[g + 1];
  const float total = SG[0] * G[0];
  const float Rs = ldexpf(Rm, Re);
#pragma unroll
  for (int c = 0; c < 4; ++c) {
    const float b0 = Rs * (hi ? SG[2 * c + 1] : SG[2 * c]), b1 = Rs * (hi ? SG[8 + 2 * c + 1] : SG[8 + 2 * c]);
    float e0[4], e1[4];
    e0[3] = b0; e0[2] = e0[3] * x0[4 * c + 3]; e0[1] = e0[2] * x0[4 * c + 2]; e0[0] = e0[1] * x0[4 * c + 1];
    e1[3] = b1; e1[2] = e1[3] * x1[4 * c + 3]; e1[1] = e1[2] * x1[4 * c + 2]; e1[0] = e1[1] * x1[4 * c + 1];
#pragma unroll
    for (int i = 0; i < 4; ++i) { const int r = 4 * c + i;
      const float a0 = p0[r] * e0[i], a1 = p1[r] * e1[i];
      p0[r] = (!MASK || ((r & 3) + 8 * (r >> 2)) < tkh) ? a0 : 0.f; p1[r] = (!MASK || (32 + (r & 3) + 8 * (r >> 2)) < tkh) ? a1 : 0.f; }
  }
  Rm *= total;
#pragma unroll
  for (int k = 0; k < 2; ++k) { const bool sm = Rm < 5.421010862427522e-20f; Rm = sm ? Rm * 18446744073709551616.0f : Rm; Re = sm ? Re - 64 : Re; }
}

__device__ __forceinline__ void stick_unit(const unsigned short* Q, const unsigned short* K, const unsigned short* V, unsigned short* O, int b, int h, int qb, char* lds, const int tid) {
  const int wid = __builtin_amdgcn_readfirstlane(tid >> 6), lane = tid & 63, r32 = lane & 31, hi = lane >> 5;
  const int t = 256 * qb + 32 * wid + r32;
  const int tmaxw = 256 * qb + 32 * wid + 31, tminw = 256 * qb + 32 * wid;
  const size_t rowb = (size_t)b * SEQ;
  bf16x8 qr[8];
  { const unsigned short* Qw = Q + (rowb + t) * PITCH + h * HD + hi * 8;
#pragma unroll
    for (int d0 = 0; d0 < 8; ++d0) qr[d0] = *reinterpret_cast<const bf16x8*>(Qw + d0 * 16); }
  const unsigned short* Kh = K + rowb * PITCH + h * HD; const unsigned short* Vh = V + rowb * PITCH + h * HD;
  const int sr = tid >> 4, sc = (tid & 15) * 8, vst0 = v_st(sr, sc), vst1 = v_st(32 + sr, sc);
  const int vb0 = (int)(uintptr_t)(lds + OFF_V) + v_rd_base(lane);
  f32x16 o[4] = {}; float Rm = 1.0f; int Re = 0;
  const int NT = 4 * qb + 4; int buf = 0;
  Stg st;
  volatile __attribute__((address_space(3))) int* flags = (volatile __attribute__((address_space(3))) int*)(lds + OFF_WS);
  bool wdone = false;
  __syncthreads();
  if (lane < 2) flags[lane * 8 + wid] = 0;
  sload(st, Kh, Vh, (NT - 1) * KVBLK, sr, sc); asm volatile("s_waitcnt vmcnt(0)" ::: "memory"); swrite(st, lds, 0, sr, sc, vst0, vst1); __syncthreads();
  for (int kt = NT - 1; kt >= 0; --kt) {
    if (kt > 0) sload(st, Kh, Vh, (kt - 1) * KVBLK, sr, sc);
    const int k0 = kt * KVBLK;
    if (k0 < tmaxw && !wdone) {
      f32x16 p0, p1;
      qkt(p0, p1, lds + OFF_K + buf * SHM_K, qr, r32, hi);
      const int tkh = t - k0 - 4 * hi;
      if (k0 + 63 < tminw) stick_tile<false>(p0, p1, Rm, Re, tkh, hi); else stick_tile<true>(p0, p1, Rm, Re, tkh, hi);
      bf16x8 pa0, pa1, pa2, pa3; pack_p(p0, p1, pa0, pa1, pa2, pa3);
      pv_d0(o, vb0 + buf * SHM_V, pa0, pa1, pa2, pa3);
      wdone = __all(Re <= -192 || Rm == 0.f);
    }
    if (lane == 0) flags[(kt & 1) * 8 + wid] = wdone ? 1 : 0;
    if (kt > 0) { asm volatile("s_waitcnt vmcnt(0)" ::: "memory"); swrite(st, lds, buf ^ 1, sr, sc, vst0, vst1); }
    __syncthreads();
    buf ^= 1;
    { const int fl = flags[(kt & 1) * 8 + (lane & 7)]; if (__all(fl != 0)) break; }
  }
  float rs[16];
#pragma unroll
  for (int r = 0; r < 16; ++r) rs[r] = 1.0f;
  store_o(o, rs, O + (rowb + 256 * qb + 32 * wid) * PITCH + h * HD, r32, hi, lds, wid, lane);
  if (PROBE_DUP == 10) { asm volatile("s_waitcnt vmcnt(0)" ::: "memory"); store_o(o, rs, O + (rowb + 256 * qb + 32 * wid) * PITCH + h * HD, r32, hi, lds, wid, lane); }
}

__device__ __forceinline__ void band_unit(const unsigned short* Q, const unsigned short* K, const unsigned short* V, unsigned short* O, const float* bias  , int b, int h, int qb, char* lds, const int tid) {
  const int wid = __builtin_amdgcn_readfirstlane(tid >> 6), lane = tid & 63, r32 = lane & 31, hi = lane >> 5;
  const int t = 256 * qb + 32 * wid + r32;
  const int cq = 4 * qb + (wid >> 1);
  const size_t rowb = (size_t)b * SEQ;
  bf16x8 qr[8];
  { const unsigned short* Qw = Q + (rowb + t) * PITCH + h * HD + hi * 8;
#pragma unroll
    for (int d0 = 0; d0 < 8; ++d0) qr[d0] = *reinterpret_cast<const bf16x8*>(Qw + d0 * 16); }
  const unsigned short* Kh = K + rowb * PITCH + h * HD; const unsigned short* Vh = V + rowb * PITCH + h * HD;
  const int sr = tid >> 4, sc = (tid & 15) * 8, vst0 = v_st(sr, sc), vst1 = v_st(32 + sr, sc);
  const int vb0 = (int)(uintptr_t)(lds + OFF_V) + v_rd_base(lane);
  float* wsf = (float*)(lds + OFF_WS) + wid * 64; float* al_l = wsf + 32;
  float* bias_l = (float*)(lds + OFF_BIAS);
  f32x16 o[4] = {}; f32x16 lacc = {}; float m_reg = -1e30f;
  const int kc_lo = (4 * qb - 8) > 0 ? (4 * qb - 8) : 0, kc_hi = 4 * qb + 3; int buf = 0;
  Stg st;
  const bf16x8 ones = {0x3F80, 0x3F80, 0x3F80, 0x3F80, 0x3F80, 0x3F80, 0x3F80, 0x3F80};
  constexpr float THR2 = 8.0f * LOG2E;
  __syncthreads();
  for (int i = tid; i < 513 + 64; i += NWAVES * 64) bias_l[i] = bias[i < 512 ? i : 512] * LOG2E;
  sload(st, Kh, Vh, kc_lo * KVBLK, sr, sc); asm volatile("s_waitcnt vmcnt(0)" ::: "memory"); swrite(st, lds, 0, sr, sc, vst0, vst1); __syncthreads();
  for (int kc = kc_lo; kc <= kc_hi; ++kc) {
    if (kc < kc_hi) sload(st, Kh, Vh, (kc + 1) * KVBLK, sr, sc);
    if (kc >= cq - 8 && kc <= cq) {
      f32x16 p0, p1;
      qkt(p0, p1, lds + OFF_K + buf * SHM_K, qr, r32, hi);
      constexpr float C2 = SCALE * LOG2E;
      float pmax = -1e30f;
      if (kc <= cq - 5) {
        const float bfar = bias_l[512];
#pragma unroll
        for (int r = 0; r < 16; ++r) { p0[r] = p0[r] * C2 + bfar; p1[r] = p1[r] * C2 + bfar; pmax = fmaxf(pmax, fmaxf(p0[r], p1[r])); }
      } else {
        const float* bp = bias_l + (t - kc * KVBLK - 4 * hi + 256);
        float bv0[16], bv1[16];
#pragma unroll
        for (int r = 0; r < 16; ++r) { bv0[r] = bp[-((r & 3) + 8 * (r >> 2))]; bv1[r] = bp[-(32 + (r & 3) + 8 * (r >> 2))]; }
        SBAR();
#pragma unroll
        for (int r = 0; r < 16; ++r) { p0[r] = p0[r] * C2 + bv0[r]; p1[r] = p1[r] * C2 + bv1[r]; pmax = fmaxf(pmax, fmaxf(p0[r], p1[r])); }
      }
      { float lo, hh; swap2(pmax, lo, hh); pmax = fmaxf(lo, hh); }
      float mn, alpha;
      if (__all(pmax - m_reg <= THR2)) { mn = m_reg; alpha = 1.f; } else { mn = fmaxf(m_reg, pmax); alpha = __builtin_amdgcn_exp2f(m_reg - mn); m_reg = mn; }
#pragma unroll
      for (int r = 0; r < 16; ++r) { p0[r] = __builtin_amdgcn_exp2f(p0[r] - mn); p1[r] = __builtin_amdgcn_exp2f(p1[r] - mn); }
      if (__any(alpha < 1.f)) { if (hi == 0) al_l[r32] = alpha; asm volatile("s_waitcnt lgkmcnt(0)" ::: "memory");
#pragma unroll
        for (int r = 0; r < 16; ++r) { const float a = al_l[crow(r, hi)]; lacc[r] *= a;
#pragma unroll
          for (int d = 0; d < 4; ++d) o[d][r] *= a; } }
      bf16x8 pa0, pa1, pa2, pa3; pack_p(p0, p1, pa0, pa1, pa2, pa3);
      lacc = __builtin_amdgcn_mfma_f32_32x32x16_bf16(pa0, ones, lacc, 0, 0, 0); lacc = __builtin_amdgcn_mfma_f32_32x32x16_bf16(pa1, ones, lacc, 0, 0, 0);
      lacc = __builtin_amdgcn_mfma_f32_32x32x16_bf16(pa2, ones, lacc, 0, 0, 0); lacc = __builtin_amdgcn_mfma_f32_32x32x16_bf16(pa3, ones, lacc, 0, 0, 0);
      pv_d0(o, vb0 + buf * SHM_V, pa0, pa1, pa2, pa3);
    }
    if (kc < kc_hi) { asm volatile("s_waitcnt vmcnt(0)" ::: "memory"); swrite(st, lds, buf ^ 1, sr, sc, vst0, vst1); }
    __syncthreads();
    buf ^= 1;
  }
  float rs[16];
#pragma unroll
  for (int r = 0; r < 16; ++r) rs[r] = __builtin_amdgcn_rcpf(lacc[r]);
  store_o(o, rs, O + (rowb + 256 * qb + 32 * wid) * PITCH + h * HD, r32, hi, lds, wid, lane);
  if (PROBE_DUP == 10) { asm volatile("s_waitcnt vmcnt(0)" ::: "memory"); store_o(o, rs, O + (rowb + 256 * qb + 32 * wid) * PITCH + h * HD, r32, hi, lds, wid, lane); }
}
#undef KSWZ
#undef SBAR
}

struct Frame {
    LAS unsigned char* lds;
    volatile LAS unsigned* MISC;
    gu32* ctl;
    int tid, lane, wave;
    int vcu, G;
};
__device__ __forceinline__ float wave_sum(float v) {
#pragma unroll
    for (int o = 1; o < 64; o <<= 1) v += __shfl_xor(v, o);
    return v;
}
struct ConvItem { const float* src; const float* gain; bf16* dst; int N, Kd; };
__device__ __forceinline__ void tr_load(const ConvItem& c, f32x4 (&v)[16], int lane) {
    const float* src = c.src + (size_t)(lane >> 4) * c.N + (lane & 15) * 4;
#pragma unroll
    for (int j = 0; j < 16; ++j) v[j] = __builtin_nontemporal_load((const f32x4*)(src + (size_t)(4 * j) * c.N));
}
__device__ __forceinline__ void tr_lds_write(const f32x4 (&v)[16], LAS float* scr, int lane) {
    LAS float* d = scr + (lane >> 4) * 65 + (lane & 15) * 4;
#pragma unroll
    for (int j = 0; j < 16; ++j) { d[(4 * j) * 65 + 0] = v[j][0]; d[(4 * j) * 65 + 1] = v[j][1]; d[(4 * j) * 65 + 2] = v[j][2]; d[(4 * j) * 65 + 3] = v[j][3]; }
}
__device__ __forceinline__ void tr_store(const ConvItem& it, LAS float* scr, int lane) {
    const int c = lane & 7;
    float gk[8];
#pragma unroll
    for (int i = 0; i < 8; ++i) gk[i] = it.gain ? it.gain[8 * c + i] : 1.0f;
    LDS_WAIT(); asm volatile("" ::: "memory");
#pragma unroll
    for (int j = 0; j < 8; ++j) { const int n = (lane >> 3) + 8 * j; const LAS float* s = scr + (8 * c) * 65 + n;
        v4u o; o.x = pk2(s[0 * 65] * gk[0], s[1 * 65] * gk[1]); o.y = pk2(s[2 * 65] * gk[2], s[3 * 65] * gk[3]); o.z = pk2(s[4 * 65] * gk[4], s[5 * 65] * gk[5]); o.w = pk2(s[6 * 65] * gk[6], s[7 * 65] * gk[7]);
        __builtin_nontemporal_store(o, (GAS v4u*)(it.dst + (size_t)n * it.Kd + 8 * c)); }
    LDS_WAIT(); asm volatile("" ::: "memory");
}

struct Args { const float* in[14]; float* out; unsigned char* ws; int ph_lo, ph_hi; };

__device__ __forceinline__ bf16* w_gu(unsigned char* ws, int f) { return (bf16*)(ws + WS_W + (size_t)f * W_FFN_STRIDE); }
__device__ __forceinline__ bf16* w_dn(unsigned char* ws, int f) { return (bf16*)(ws + WS_W + (size_t)f * W_FFN_STRIDE + W_FFN_DOWN); }
__device__ __forceinline__ bf16* w_mix1(unsigned char* ws, int layer) { return (bf16*)(ws + WS_WATT + (size_t)layer * 32 * MiB); }
__device__ __forceinline__ bf16* w_mixo(unsigned char* ws, int layer) { return (bf16*)(ws + WS_WATT + (size_t)layer * 32 * MiB + (layer < 3 ? 24 : 8) * MiB); }

constexpr int CONV_TOTAL = 81920;
#ifndef CONV_CAP
#define CONV_CAP 8192
#endif
constexpr int conv_need(int k) { return k == 0 ? 5632 : k == 1 ? 18176 : k == 2 ? 26624 : k == 3 ? 39168 : k == 4 ? 47616 : k == 5 ? 60160 : k == 6 ? 68608 : k == 7 ? 79104 : 81920; }
constexpr int conv_up() { int u = 0; for (int k = 0; k <= 8; ++k) { const int d = conv_need(k) - k * CONV_CAP; if (d > u) u = d; } return u; }
constexpr int CONV_UP = (CONV_CAP > 0) ? conv_up() : CONV_TOTAL;
static_assert(CONV_UP + 8 * (CONV_CAP > 0 ? CONV_CAP : 0) >= CONV_TOTAL || CONV_UP == CONV_TOTAL, "conversion schedule covers every item");
__device__ __forceinline__ void conv_items(Frame& F, const Args& a, int it_lo, int it_hi, int rank, int nranks) {
    unsigned char* ws = a.ws;
    LAS float* scr = (LAS float*)(F.lds + RING_OFF + F.wave * 16640);
    const float *g_ffn = a.in[1], *wg = a.in[2], *wu = a.in[3], *wd = a.in[4], *g_mix = a.in[5], *wqkv = a.in[6], *woa = a.in[7], *g_kv = a.in[8], *wkv = a.in[9], *wqb = a.in[10], *wob = a.in[11];
    auto decode = [&](int it, ConvItem& ci) {
        const float* W; const float* gain = nullptr; bf16* WT; int N, Kd, kb, nb, drow_add = 0; bool ilv = false; int mat = 0;
        int L = it / 20992; if (L > 3) L = 3; int r = it - L * 20992;
        const int msz = L < 3 ? 4096 : 2048;
        int f = 2 * L; bool ffn = true;
        if (r >= 8448) { r -= 8448; if (r < msz) ffn = false; else { r -= msz; f = 2 * L + 1; } }
        if (ffn) { mat = r / 2816; r -= mat * 2816;
            if (mat < 2) { N = FF; Kd = DM; W = (mat == 0 ? wg : wu) + (size_t)f * DM * FF; gain = g_ffn + (size_t)f * DM; WT = w_gu(ws, f); kb = r / 88; nb = r - kb * 88; ilv = true; }
            else { N = DM; Kd = FF; W = wd + (size_t)f * FF * DM; WT = w_dn(ws, f); kb = r / 32; nb = r - kb * 32; }
        } else if (L < 2) {
            if (r < 3072) { N = 3 * DM; Kd = DM; W = wqkv + (size_t)L * DM * 3 * DM; gain = g_mix + (size_t)L * DM; WT = w_mix1(ws, L); kb = r / 96; nb = r - kb * 96; }
            else { r -= 3072; N = DM; Kd = DM; W = woa + (size_t)L * DM * DM; WT = w_mixo(ws, L); kb = r / 32; nb = r - kb * 32; }
        } else if (L == 2) {
            if (r < 1024) { N = DM; Kd = DM; W = wqb; gain = g_mix + 2 * DM; WT = w_mix1(ws, 2); kb = r / 32; nb = r - kb * 32; }
            else if (r < 3072) { r -= 1024; N = 2 * DM; Kd = DM; W = wkv; gain = g_kv; WT = w_mix1(ws, 2); kb = r / 64; nb = r - kb * 64; drow_add = DM; }
            else { r -= 3072; N = DM; Kd = DM; W = wob; WT = w_mixo(ws, 2); kb = r / 32; nb = r - kb * 32; }
        } else {
            if (r < 1024) { N = DM; Kd = DM; W = wqb + (size_t)DM * DM; gain = g_mix + 3 * DM; WT = w_mix1(ws, 3); kb = r / 32; nb = r - kb * 32; }
            else { r -= 1024; N = DM; Kd = DM; W = wob + (size_t)DM * DM; WT = w_mixo(ws, 3); kb = r / 32; nb = r - kb * 32; }
        }
        const int n0 = nb * 64, k0 = kb * 64; const int drow = ilv ? (256 * (n0 >> 7) + (n0 & 127) + 128 * mat) : (n0 + drow_add);
        ci.src = W + (size_t)k0 * N + n0; ci.gain = gain ? gain + k0 : nullptr; ci.dst = WT + (size_t)drow * Kd + k0; ci.N = N; ci.Kd = Kd;
    };
    const int stride = nranks * NWAVES; int it = it_lo + rank * NWAVES + F.wave;
    int lane_ = threadIdx.x; asm volatile("" : "+v"(lane_)); lane_ &= 63;
    ConvItem cA, cB; f32x4 vA[16], vB[16];
    if (it < it_hi) { decode(it, cA); tr_load(cA, vA, lane_); }
    if (it + stride < it_hi) { decode(it + stride, cB); tr_load(cB, vB, lane_); }
    while (it < it_hi) {
        tr_lds_write(vA, scr, lane_);
        { const ConvItem cur = cA; const int itn = it + 2 * stride; if (itn < it_hi) { decode(itn, cA); tr_load(cA, vA, lane_); } tr_store(cur, scr, lane_); }
        it += stride; if (it >= it_hi) break;
        tr_lds_write(vB, scr, lane_);
        { const ConvItem cur = cB; const int itn = it + 2 * stride; if (itn < it_hi) { decode(itn, cB); tr_load(cB, vB, lane_); } tr_store(cur, scr, lane_); }
        it += stride;
    }
}
__device__ __forceinline__ int lo_perm(int c) { return (c & ~255) | (((c >> 5) & 3) << 6) | (((c >> 3) & 3) << 4) | (((c >> 7) & 1) << 3) | (c & 7); }
__device__ __forceinline__ void p0_prologue(Frame& F, const Args& a) {
    unsigned char* ws = a.ws;
    const int gw = F.vcu * NWAVES + F.wave, NGW = F.G * NWAVES;
    conv_items(F, a, 0, CONV_UP, F.vcu, F.G);
    const float* x = a.in[0]; bf16* hb = (bf16*)(ws + WS_HB); bf16* hl = (bf16*)(ws + WS_H); float* ssq = (float*)(ws + WS_SSQ);
    int lane_ = threadIdx.x; asm volatile("" : "+v"(lane_)); lane_ &= 63;
    for (int m = gw; m < M; m += NGW) {
        const GAS f32x4* xr = (const GAS f32x4*)(x + (size_t)m * DM) + lane_; f32x4 v[8]; float s = 0.f;
#pragma unroll
        for (int j = 0; j < 8; ++j) { v[j] = xr[64 * j]; s += (v[j].x * v[j].x + v[j].y * v[j].y) + (v[j].z * v[j].z + v[j].w * v[j].w); }
        s = wave_sum(s);
        GAS unsigned long long* o8 = (GAS unsigned long long*)(hb + (size_t)m * DM) + lane_; GAS unsigned long long* l8 = (GAS unsigned long long*)(hl + (size_t)m * DM) + lane_;
#pragma unroll
        for (int j = 0; j < 8; ++j) { const unsigned h0 = pk2(v[j].x, v[j].y), h1 = pk2(v[j].z, v[j].w);
            o8[64 * j] = (unsigned long long)h0 | ((unsigned long long)h1 << 32);
            if (RESID_LO == 1) l8[64 * j] = (unsigned long long)pk2(v[j].x - pg8::bf_lo(h0), v[j].y - pg8::bf_hi(h0)) | ((unsigned long long)pk2(v[j].z - pg8::bf_lo(h1), v[j].w - pg8::bf_hi(h1)) << 32);
            if (RESID_LO == 2) { int w = __builtin_amdgcn_cvt_pk_fp8_f32((v[j].x - pg8::bf_lo(h0)) * 512.0f, (v[j].y - pg8::bf_hi(h0)) * 512.0f, 0, false);
                w = __builtin_amdgcn_cvt_pk_fp8_f32((v[j].z - pg8::bf_lo(h1)) * 512.0f, (v[j].w - pg8::bf_hi(h1)) * 512.0f, w, true);
                *(GAS unsigned*)((unsigned char*)hl + (size_t)m * DM + lo_perm(4 * (lane_ + 64 * j))) = (unsigned)w; } }
        if (lane_ < 32) ssq[(size_t)m * 32 + lane_] = lane_ == 0 ? s : 0.f;
    }
}
__device__ __forceinline__ void final_norm(Frame& F, const Args& a) {
    const int gw = F.vcu * NWAVES + F.wave, NGW = F.G * NWAVES;
    const bf16* hb = (const bf16*)(a.ws + WS_HB); const bf16* hl = (const bf16*)(a.ws + WS_H); const float* ssq = (const float*)(a.ws + WS_SSQ); const float* g = a.in[13];
    int lane_ = threadIdx.x; asm volatile("" : "+v"(lane_)); lane_ &= 63;
    f32x4 gv[8];
#pragma unroll
    for (int j = 0; j < 8; ++j) gv[j] = ((const GAS f32x4*)g)[lane_ + 64 * j];
    for (int m = gw; m < M; m += NGW) {
        float s = lane_ < 32 ? ssq[(size_t)m * 32 + lane_] : 0.f; s = wave_sum(s);
        const float rs = __builtin_amdgcn_rsqf(s * (1.0f / DM) + RMS_EPS);
        const GAS unsigned long long* hr = (const GAS unsigned long long*)(hb + (size_t)m * DM) + lane_; const GAS unsigned long long* lr = (const GAS unsigned long long*)(hl + (size_t)m * DM) + lane_;
        GAS f32x4* orow = (GAS f32x4*)(a.out + (size_t)m * DM) + lane_;
#pragma unroll
        for (int j = 0; j < 8; ++j) { const unsigned long long hw = hr[64 * j]; const unsigned h0 = (unsigned)hw, h1 = (unsigned)(hw >> 32);
            f32x4 hv = {pg8::bf_lo(h0), pg8::bf_hi(h0), pg8::bf_lo(h1), pg8::bf_hi(h1)};
            if (RESID_LO == 1) { const unsigned long long lw = lr[64 * j]; const unsigned l0 = (unsigned)lw, l1 = (unsigned)(lw >> 32); hv += (f32x4){pg8::bf_lo(l0), pg8::bf_hi(l0), pg8::bf_lo(l1), pg8::bf_hi(l1)}; }
            if (RESID_LO == 2) { typedef float f32x2v __attribute__((ext_vector_type(2))); const int w = (int)*(const GAS unsigned*)((const unsigned char*)hl + (size_t)m * DM + lo_perm(4 * (lane_ + 64 * j)));
                const f32x2v a = __builtin_amdgcn_cvt_pk_f32_fp8(w, false), b = __builtin_amdgcn_cvt_pk_f32_fp8(w, true); hv += (f32x4){a.x, a.y, b.x, b.y} * (1.0f / 512.0f); }
            orow[64 * j] = hv * rs * gv[j]; }
    }
}

#ifndef KN_ALIGN
#define KN_ALIGN true
#endif
#ifndef KN_SP2
#define KN_SP2 true
#endif
#ifndef MK_PER_PHASE
#define MK_PER_PHASE 0
#endif
constexpr size_t WS_DUMMY = 960 * MiB;
constexpr int N_PHASES = 38;
__global__ void __launch_bounds__(NWAVES * 64, 2) mega_fwd(Args args) {
    extern __shared__ __attribute__((aligned(16))) unsigned char lds[];
    Frame F;
    F.lds = (LAS unsigned char*)lds;
    F.MISC = (volatile LAS unsigned*)(F.lds + LDSCTL_OFF);
    F.tid = threadIdx.x; F.lane = F.tid & 63; F.wave = __builtin_amdgcn_readfirstlane(F.tid >> 6);
    F.G = gridDim.x; { const int bx = blockIdx.x; F.vcu = (F.G % 8 == 0) ? (bx % 8) * (F.G / 8) + bx / 8 : bx; }
    unsigned char* ws = args.ws;
    F.ctl = (gu32*)(ws + WS_CTL);
    for (int u = F.tid; u < 256; u += NWAVES * 64) ((LAS unsigned*)(F.lds + LDSCTL_OFF))[u] = 0u;
    __syncthreads();
#if MK_PER_PHASE
#define GRID_BAR() do { } while (0)
#else
    XcdBarrier bar = xcd_barrier_post((unsigned*)(F.ctl + CW_BAR), F.MISC + 8);
    int bar_cls = 0;
#ifndef PROBE_BLK
#define PROBE_BLK 0
#endif
#ifndef PROBE_CLS
#define PROBE_CLS -1
#endif
#define GRID_BAR() do { unsigned long long t0_ = 0; if (PROBE_DUP == 13 && blockIdx.x == PROBE_BLK && F.tid == 0) t0_ = __builtin_amdgcn_s_memrealtime(); xcd_barrier(bar); if (PROBE_DUP == 12) xcd_barrier(bar); \
    if (PROBE_DUP == 13 && blockIdx.x == PROBE_BLK && F.tid == 0 && (PROBE_CLS < 0 || PROBE_CLS == bar_cls)) { volatile unsigned long long* pw = (volatile unsigned long long*)(ws + WS_CTL + 8192); *pw = *pw + (__builtin_amdgcn_s_memrealtime() - t0_); } } while (0)
#endif
    const int lo = args.ph_lo, hi = args.ph_hi;
#define IN(k) (lo <= (k) && (k) < hi)
#define BOTH(k) (IN(k) && (k) + 1 < hi)

    bf16* HL = (bf16*)(ws + WS_H); bf16* HB = (bf16*)(ws + WS_HB); float* SSQ = (float*)(ws + WS_SSQ);
    bf16* QB = (bf16*)(ws + WS_Q); bf16* KB = (bf16*)(ws + WS_K); bf16* VB = (bf16*)(ws + WS_V); bf16* MIX = (bf16*)(ws + WS_MIX); bf16* ACT = (bf16*)(ws + WS_ACT);

    if (IN(0)) { p0_prologue(F, args); if (PROBE_DUP == 1) { GRID_BAR(); p0_prologue(F, args); } if (BOTH(0)) GRID_BAR(); }
    int cid = (int)blockIdx.x;
#if !MK_PER_PHASE
    if (lo == 0 && hi > 1) {
        if (F.tid == 0) { bool ok = (F.G % 8) == 0;
            for (unsigned j = 0; j < 16; ++j) { const unsigned cnt = xb_ld((unsigned*)(F.ctl + CW_BAR) + XB_XCNT(j)); ok = ok && (cnt == (j < 8 ? (unsigned)F.G / 8u : 0u)); }
            F.MISC[12] = ok ? (F.MISC[10] * 8u + F.MISC[11]) : (unsigned)blockIdx.x; }
        __syncthreads();
        cid = __builtin_amdgcn_readfirstlane((int)F.MISC[12]);
    }
#endif
    const int vcid = (F.G % 8 == 0) ? (cid % 8) * (F.G / 8) + cid / 8 : cid;

#pragma unroll 1
    for (int s = 0; s < 12; ++s) {
        const int layer = s / 3, kind = s - 3 * layer, pb = 1 + 3 * s;
        int ltid = threadIdx.x; asm volatile("" : "+v"(ltid));
        unsigned long long pc0 = 0, pr0 = 0;
        if (PROBE_DUP == 11 && s == 3 && blockIdx.x == 0 && F.tid == 0) { pc0 = __builtin_amdgcn_s_memtime(); pr0 = __builtin_amdgcn_s_memrealtime(); }
        if (IN(pb)) {
          for (int rep = 0; rep < (((PROBE_DUP == 4 && kind != 1) || (PROBE_DUP == 6 && kind == 1)) ? 2 : 1); ++rep) {
            if (rep) GRID_BAR();
            asm volatile("" : "+v"(ltid));
            int pm0 = -1; const PG8_LAS float* stab = (const PG8_LAS float*)(F.lds + SCALE_OFF);
            { pg8::StaticOrder S0; S0.init(M, kind != 1 ? 2 * FF : (layer < 3 ? 3 * DM : DM), F.G, cid); pg8::Unit u0;
              if (S0.next(0, u0)) { pm0 = u0.pm;
                if (ltid < 256) { const f32x4* p = (const f32x4*)(SSQ + (size_t)(pm0 * 256 + ltid) * 32); float a = 0.f;
#pragma unroll
                    for (int q = 0; q < 8; ++q) { const f32x4 v = p[q]; a += (v[0] + v[1]) + (v[2] + v[3]); }
                    ((PG8_LAS float*)(F.lds + SCALE_OFF))[ltid] = __builtin_amdgcn_rsqf(a * (1.0f / DM) + RMS_EPS); } }
              __syncthreads(); }
            if (kind != 1) {
                const int f = 2 * layer + (kind >> 1);
                pg8::Gemm g{HB, w_gu(ws, f), M, 2 * FF, DM}; pg8::StaticOrder S; S.init(M, 2 * FF, F.G, cid);
                pg8::EpiSwiglu E{ACT, FF, SSQ, stab, pm0};
                const int nu = (M / 256) * (2 * FF / 256), rem = nu % F.G, c = cid;
                const int lo_it = CONV_UP + f * CONV_CAP, hi_it = (lo_it + CONV_CAP) < CONV_TOTAL ? (lo_it + CONV_CAP) : CONV_TOTAL;
                const bool cv = CONV_CAP > 0 && lo_it < hi_it && (rem == 0 || c >= rem); const int crank = rem == 0 ? c : c - rem, cn = rem == 0 ? F.G : F.G - rem;
                pg8::gemm_phase<pg8::EpiSwiglu, pg8::StaticOrder, KN_ALIGN, KN_SP2>(F.lds + RING_OFF, g, S, E, ltid);
                if (cv) conv_items(F, args, lo_it, hi_it, crank, cn);
            } else {
                const int N = layer < 3 ? 3 * DM : DM;
                pg8::Gemm g{HB, w_mix1(ws, layer), M, N, DM}; pg8::StaticOrder S; S.init(M, N, F.G, cid);
                pg8::EpiScaleBf16 E{QB, (size_t)(WS_K - WS_Q) / 2, SSQ, stab, pm0};
                pg8::gemm_phase<pg8::EpiScaleBf16, pg8::StaticOrder, KN_ALIGN, KN_SP2>(F.lds + RING_OFF, g, S, E, ltid);
            }
          }
            if (PROBE_DUP == 11 && s == 3 && blockIdx.x == 0 && F.tid == 0) {
                const unsigned long long cyc = __builtin_amdgcn_s_memtime() - pc0, rt = __builtin_amdgcn_s_memrealtime() - pr0;
                const unsigned long long delay = cyc * 10000ull / (rt ? rt : 1ull);
                const unsigned long long t0 = __builtin_amdgcn_s_memrealtime(); while (__builtin_amdgcn_s_memrealtime() - t0 < delay) __builtin_amdgcn_s_sleep(8);
            }
            bar_cls = kind != 1 ? 1 : 3; if (BOTH(pb)) GRID_BAR();
        }
        if (kind == 1 && IN(pb + 1)) {
          for (int rep = 0; rep < (((PROBE_DUP == 2 && layer < 2) || (PROBE_DUP == 3 && layer >= 2)) ? 2 : 1); ++rep) {
            if (rep) GRID_BAR();
            for (int p = vcid; p < 256; p += F.G) {
                const int bh = p >> 2, j = p & 3, b = bh >> 4, h = bh & 15;
                if (layer < 2) {
#pragma unroll 1
                    for (int uu = 0; uu < 2; ++uu) { asm volatile("" : "+v"(ltid)); att::stick_unit(QB, KB, VB, MIX, b, h, uu == 0 ? 7 - j : j, (char*)lds + RING_OFF, ltid); }
                } else { const float* bias = args.in[12] + ((size_t)(layer - 2) * NH + h) * 513;
#pragma unroll 1
                    for (int uu = 0; uu < 2; ++uu) { asm volatile("" : "+v"(ltid)); att::band_unit(QB, KB, VB, MIX, bias, b, h, uu == 0 ? 7 - j : j, (char*)lds + RING_OFF, ltid); }
                }
            }
          }
            bar_cls = 4; if (BOTH(pb + 1)) GRID_BAR();
        }
        if (IN(pb + 2)) {
            const bool ffn = kind != 1; const int f = 2 * layer + (kind >> 1);
            pg8::Gemm g{ffn ? ACT : MIX, ffn ? w_dn(ws, f) : w_mixo(ws, layer), M, DM, ffn ? FF : DM}; pg8::StaticOrder S; S.init(M, DM, F.G, cid);
          for (int rep = (((PROBE_DUP == 5 && ffn) || (PROBE_DUP == 7 && !ffn)) ? 0 : 1); rep < 2; ++rep) {
            const bool dummy = rep == 0;
            asm volatile("" : "+v"(ltid));
            pg8::EpiResid E{HB, HL, dummy ? (bf16*)(ws + WS_DUMMY + 64 * MiB) : HB, dummy ? (bf16*)(ws + WS_DUMMY) : HL, dummy ? (float*)(ws + WS_DUMMY + 96 * MiB) : SSQ, ffn ? 0.5f : 1.0f};
#if PROBE_DUP == 9
            pg8::EpiResid Ed{HB, HL, (bf16*)(ws + WS_DUMMY + 64 * MiB), (bf16*)(ws + WS_DUMMY), (float*)(ws + WS_DUMMY + 96 * MiB), ffn ? 0.5f : 1.0f};
            pg8::EpiTwice<pg8::EpiResid> E2{Ed, E};
            pg8::gemm_phase<pg8::EpiTwice<pg8::EpiResid>, pg8::StaticOrder, KN_ALIGN, KN_SP2>(F.lds + RING_OFF, g, S, E2, ltid);
#else
            pg8::gemm_phase<pg8::EpiResid, pg8::StaticOrder, KN_ALIGN, KN_SP2>(F.lds + RING_OFF, g, S, E, ltid);
#endif
            if (dummy) GRID_BAR();
          }
            bar_cls = ffn ? 2 : 5; if (BOTH(pb + 2)) GRID_BAR();
        }
    }
    if (PROBE_DUP == 13 && blockIdx.x == PROBE_BLK && F.tid == 0) { const unsigned long long bw_acc = *(volatile unsigned long long*)(ws + WS_CTL + 8192); const unsigned long long t0 = __builtin_amdgcn_s_memrealtime(); while (__builtin_amdgcn_s_memrealtime() - t0 < bw_acc) __builtin_amdgcn_s_sleep(8); }
    if (IN(37)) { final_norm(F, args); if (PROBE_DUP == 8) { GRID_BAR(); final_norm(F, args); } }
#undef IN
#undef BOTH
}

extern "C" void kernel_launch(void* const* d_in, const int* in_sizes, int n_in, void* d_out, int out_size, void* d_ws, size_t ws_size, hipStream_t stream) {
    static int grid = 0;
    if (grid == 0) {
        if (n_in != 14 || in_sizes[0] != M * DM || out_size != M * DM || ws_size < WS_END) { fprintf(stderr, "kernel_launch: shape mismatch: n_in %d in0 %d out %d ws %zu (need %zu)\n", n_in, n_in > 0 ? in_sizes[0] : -1, out_size, ws_size, (size_t)WS_END); grid = -1; return; }
        int dev = 0, cus = 0, per_cu = 0;
        if (hipGetDevice(&dev) != hipSuccess || hipDeviceGetAttribute(&cus, hipDeviceAttributeMultiprocessorCount, dev) != hipSuccess) { fprintf(stderr, "kernel_launch: device query failed\n"); grid = -1; return; }
        if (hipFuncSetAttribute((const void*)mega_fwd, hipFuncAttributeMaxDynamicSharedMemorySize, LDS_BYTES) != hipSuccess) { fprintf(stderr, "kernel_launch: hipFuncSetAttribute failed\n"); grid = -1; return; }
        if (hipOccupancyMaxActiveBlocksPerMultiprocessor(&per_cu, (const void*)mega_fwd, NWAVES * 64, LDS_BYTES) != hipSuccess || per_cu < 1) { fprintf(stderr, "kernel_launch: occupancy query reports %d workgroups per CU\n", per_cu); (void)hipGetLastError(); grid = -1; return; }
        grid = cus;
    }
    if (grid < 0) return;
    if (hipMemsetAsync((char*)d_ws + WS_CTL, 0, CTL_ZERO_BYTES, stream) != hipSuccess) { fprintf(stderr, "kernel_launch: hipMemsetAsync failed\n"); return; }
    Args a{};
    for (int i = 0; i < 14; ++i) a.in[i] = (const float*)d_in[i];
    a.out = (float*)d_out; a.ws = (unsigned char*)d_ws;
#if MK_PER_PHASE
    for (int ph = 0; ph < N_PHASES; ++ph) {
        if (ph >= 1 && ph <= 36) { const int s = (ph - 1) / 3, j = (ph - 1) % 3; if (j == 1 && (s % 3) != 1) continue; }
        a.ph_lo = ph; a.ph_hi = ph + 1;
        hipLaunchKernelGGL(mega_fwd, dim3(grid), dim3(NWAVES * 64), LDS_BYTES, stream, a);
    }
#else
    a.ph_lo = 0; a.ph_hi = N_PHASES;
    hipLaunchKernelGGL(mega_fwd, dim3(grid), dim3(NWAVES * 64), LDS_BYTES, stream, a);
#endif
    const hipError_t le = hipPeekAtLastError();
    if (le != hipSuccess) fprintf(stderr, "kernel_launch: launch failed: %s (grid %d)\n", hipGetErrorName(le), grid);
}
```

```cpp
#include <hip/hip_runtime.h>
#include <cstdio>
#include <cstdint>
#ifndef PROBE_DUP
#define PROBE_DUP 0
#endif
namespace pg8 {
#define PG8_LAS __attribute__((address_space(3)))
typedef unsigned short bf16_t;
typedef short bf16x8 __attribute__((ext_vector_type(8)));
typedef float f32x4 __attribute__((ext_vector_type(4)));
typedef unsigned u32x4 __attribute__((ext_vector_type(4)));
constexpr int BM = 256, BK = 64, HALF = 128, HTB = HALF * BK * 2  , STAGE_BYTES = 8 * HTB, NXCD = 8, WGM = 8;

__host__ __device__ __forceinline__ int lds_byte(int r, int c) { const int st = (r >> 4) * 2 + (c >> 5), rr = r & 15, cc = c & 31, ob = rr * 64 + cc * 2; return st * 1024 + (ob ^ (((ob >> 9) & 1) << 5)); }
__host__ __device__ __forceinline__ void stage_rc(int b, int& R, int& C) { const int st = b / 1024, sb = b % 1024, swz = sb ^ (((sb >> 9) & 1) << 5); R = (st >> 1) * 16 + swz / 64; C = (st & 1) * 32 + (swz % 64) / 2; }
__host__ __device__ __forceinline__ int perm32(int rho) { const int n = rho >> 4, i = rho & 15; return 8 * (i >> 2) + 4 * n + (i & 3); }

struct Unit { int pm, pn; };
struct Gemm { const bf16_t* A; const bf16_t* Bt; int M, N, K; };

struct StaticOrder {
    int nM, nN, nwg, G, c;
    __host__ __device__ void init(int M, int N, int G_, int c_) { nM = M / BM; nN = N / BM; nwg = nM * nN; G = G_; c = c_; }
    __host__ __device__ bool next(int i, Unit& u) const {
        const long L = (long)i * G + c; if (L >= nwg) return false;
        int wgid = (int)L; { const int q = nwg / NXCD, r = nwg % NXCD, xcd = wgid % NXCD, off = wgid / NXCD; wgid = (xcd < r ? xcd * (q + 1) : r * (q + 1) + (xcd - r) * q) + off; }
        const int nig = WGM * nN, gid = wgid / nig, fm = gid * WGM, gsz = (nM - fm) < WGM ? (nM - fm) : WGM;
        u.pm = fm + ((wgid % nig) % gsz); u.pn = (wgid % nig) / gsz; return true;
    }
    __device__ __forceinline__ void a_ready(const Unit&) const {}
    __device__ __forceinline__ void done(const Unit&) const {}
};

typedef float f32x2c __attribute__((ext_vector_type(2))); typedef __bf16 bf16x2c __attribute__((ext_vector_type(2)));
__device__ __forceinline__ unsigned cvt_pk_bf16(float lo, float hi) { const f32x2c v = {lo, hi}; const bf16x2c b = __builtin_convertvector(v, bf16x2c); return __builtin_bit_cast(unsigned, b); }
typedef float f32x2 __attribute__((ext_vector_type(2)));
__device__ __forceinline__ float row_scale(const float* ssq, int row, int fq) {
    const f32x4* p = (const f32x4*)(ssq + (size_t)row * 32 + fq * 8);
    const f32x4 a = p[0], b = p[1];
    float s = ((a[0] + a[1]) + (a[2] + a[3])) + ((b[0] + b[1]) + (b[2] + b[3]));
    s += __shfl_xor(s, 16); s += __shfl_xor(s, 32);
    return __builtin_amdgcn_rsqf(s * (1.0f / 2048.0f) + 1e-6f);
}
struct EpiSwiglu {
    static constexpr bool PERM = true, AFTER_DRAIN = false;
    bf16_t* O; int ldc; const float* ssq; const PG8_LAS float* tab; int pm0;
    __device__ __forceinline__ void operator()(const f32x4 (&acc)[2][2][4][2], const Unit& u, int wr, int wc, int fr, int fq) const {
        const int row0 = u.pm * BM + wr * 64 + fr, col0 = u.pn * HALF + wc * 32 + 8 * fq;
        float sc[8];
        if (u.pm == pm0) {
#pragma unroll
            for (int q = 0; q < 8; ++q) sc[q] = tab[wr * 64 + fr + (q >> 2) * HALF + (q & 3) * 16];
        } else {
#pragma unroll
            for (int q = 0; q < 8; ++q) sc[q] = row_scale(ssq, row0 + (q >> 2) * HALF + (q & 3) * 16, fq);
        }
#pragma unroll
        for (int ai = 0; ai < 2; ++ai)
#pragma unroll
            for (int m = 0; m < 4; ++m) {
                const int row = row0 + ai * HALF + m * 16; const float s = sc[ai * 4 + m];
                const float k = s * -1.4426950408889634f, s2 = s * s;
                float o[8];
#pragma unroll
                for (int n = 0; n < 2; ++n)
#pragma unroll
                    for (int i = 0; i < 4; ++i) { const float g = acc[ai][0][m][n][i], up = acc[ai][1][m][n][i];
                        const float r = __builtin_amdgcn_rcpf(1.0f + __builtin_amdgcn_exp2f(g * k));
                        o[n * 4 + i] = (g * up) * (r * s2); }
                u32x4 w; w.x = cvt_pk_bf16(o[0], o[1]); w.y = cvt_pk_bf16(o[2], o[3]); w.z = cvt_pk_bf16(o[4], o[5]); w.w = cvt_pk_bf16(o[6], o[7]);
                *(u32x4*)(O + (size_t)row * ldc + col0) = w; }
    }
};
struct EpiScaleBf16 {
    static constexpr bool PERM = true, AFTER_DRAIN = false;
    bf16_t* O; size_t split_stride; const float* ssq; const PG8_LAS float* tab; int pm0;
    __device__ __forceinline__ void operator()(const f32x4 (&acc)[2][2][4][2], const Unit& u, int wr, int wc, int fr, int fq) const {
        const int row0 = u.pm * BM + wr * 64 + fr; const int t = u.pn >> 3;
        float sc[8];
        if (u.pm == pm0) {
#pragma unroll
            for (int q = 0; q < 8; ++q) sc[q] = tab[wr * 64 + fr + (q >> 2) * HALF + (q & 3) * 16];
        } else {
#pragma unroll
            for (int q = 0; q < 8; ++q) sc[q] = row_scale(ssq, row0 + (q >> 2) * HALF + (q & 3) * 16, fq);
        } bf16_t* base = O + (size_t)t * split_stride;
        const int col0 = (u.pn & 7) * BM + wc * 32 + 8 * fq;
#pragma unroll
        for (int ai = 0; ai < 2; ++ai)
#pragma unroll
            for (int m = 0; m < 4; ++m) {
                const int row = row0 + ai * HALF + m * 16; const float s = sc[ai * 4 + m];
                bf16_t* rowp = base + (size_t)row * 2048 + col0;
#pragma unroll
                for (int bj = 0; bj < 2; ++bj) { const f32x4 v0 = acc[ai][bj][m][0] * s, v1 = acc[ai][bj][m][1] * s;
                    u32x4 w; w.x = cvt_pk_bf16(v0[0], v0[1]); w.y = cvt_pk_bf16(v0[2], v0[3]); w.z = cvt_pk_bf16(v1[0], v1[1]); w.w = cvt_pk_bf16(v1[2], v1[3]);
                    *(u32x4*)(rowp + bj * HALF) = w; } }
    }
};
#ifndef RESID_LO
#define RESID_LO 2
#endif
__device__ __forceinline__ float bf_lo(unsigned w) { return __uint_as_float(w << 16); }
__device__ __forceinline__ float bf_hi(unsigned w) { return __uint_as_float(w & 0xffff0000u); }
struct EpiResid {
    static constexpr bool PERM = true, AFTER_DRAIN = false;
    const bf16_t* bhi; const void* blo; bf16_t* ohi; void* olo; float* ssq; float coef;
    __device__ __forceinline__ void operator()(const f32x4 (&acc)[2][2][4][2], const Unit& u, int wr, int wc, int fr, int fq) const {
        typedef unsigned u32x2v __attribute__((ext_vector_type(2))); typedef float f32x2v __attribute__((ext_vector_type(2)));
        const int row0 = u.pm * BM + wr * 64 + fr, col0 = u.pn * BM + wc * 32 + 8 * fq;
        float ssr[8];
#if RESID_LO == 2
        const char* hb = (const char*)bhi; const char* lb = (const char*)blo; char* ho = (char*)ohi; char* lo_ = (char*)olo;
        const unsigned hoff0 = ((unsigned)row0 * 2048u + (unsigned)col0) * 2u, loff0 = (unsigned)row0 * 2048u + (unsigned)(u.pn * BM + wc * 64 + fq * 16);
        const float c512 = 512.0f, i512 = 1.0f / 512.0f;
#pragma unroll
        for (int ai = 0; ai < 2; ++ai)
#pragma unroll
            for (int m = 0; m < 4; ++m) {
                const unsigned rofs = (unsigned)(ai * HALF + m * 16) * 2048u;
                const u32x4 h0 = *(const u32x4*)(hb + hoff0 + rofs * 2u), h1 = *(const u32x4*)(hb + hoff0 + rofs * 2u + HALF * 2), l16 = *(const u32x4*)(lb + loff0 + rofs);
                unsigned wh[8], wl[4] = {0u, 0u, 0u, 0u}; float ss = 0.f;
#pragma unroll
                for (int bj = 0; bj < 2; ++bj)
#pragma unroll
                    for (int j = 0; j < 4; ++j) { const unsigned hw = bj ? h1[j] : h0[j]; const unsigned lw = l16[2 * bj + (j >> 1)];
                        const f32x2v lf = (j & 1) ? __builtin_amdgcn_cvt_pk_f32_fp8((int)lw, true) : __builtin_amdgcn_cvt_pk_f32_fp8((int)lw, false);
                        const float a0 = acc[ai][bj][m][j >> 1][(2 * j) & 3], a1 = acc[ai][bj][m][j >> 1][(2 * j + 1) & 3];
                        const float o0 = __builtin_fmaf(a0, coef, __builtin_fmaf(lf.x, i512, bf_lo(hw))), o1 = __builtin_fmaf(a1, coef, __builtin_fmaf(lf.y, i512, bf_hi(hw)));
                        const unsigned nh = cvt_pk_bf16(o0, o1); wh[4 * bj + j] = nh;
                        const float r0 = (o0 - bf_lo(nh)) * c512, r1 = (o1 - bf_hi(nh)) * c512;
                        wl[2 * bj + (j >> 1)] = (j & 1) ? (unsigned)__builtin_amdgcn_cvt_pk_fp8_f32(r0, r1, (int)wl[2 * bj + (j >> 1)], true) : (unsigned)__builtin_amdgcn_cvt_pk_fp8_f32(r0, r1, (int)wl[2 * bj + (j >> 1)], false);
                        ss = __builtin_fmaf(o0, o0, ss); ss = __builtin_fmaf(o1, o1, ss); }
                *(u32x4*)(ho + hoff0 + rofs * 2u) = (u32x4){wh[0], wh[1], wh[2], wh[3]}; *(u32x4*)(ho + hoff0 + rofs * 2u + HALF * 2) = (u32x4){wh[4], wh[5], wh[6], wh[7]};
                *(u32x4*)(lo_ + loff0 + rofs) = (u32x4){wl[0], wl[1], wl[2], wl[3]};
                ss += __shfl_xor(ss, 16); ss += __shfl_xor(ss, 32); ssr[ai * 4 + m] = ss;
                if (m == 3) asm volatile("" ::: "memory");
            }
#else
#pragma unroll
        for (int ai = 0; ai < 2; ++ai)
#pragma unroll
            for (int m = 0; m < 4; ++m) {
                const int q = ai * 4 + m; const int row = row0 + ai * HALF + m * 16; const size_t off = (size_t)row * 2048 + col0; float ss = 0.f;
                u32x4 hvq[2], lvq[2]; u32x2v l8q[2];
#pragma unroll
                for (int bj = 0; bj < 2; ++bj) { hvq[bj] = *(const u32x4*)(bhi + off + bj * HALF);
                    if (RESID_LO == 1) lvq[bj] = *(const u32x4*)((const bf16_t*)blo + off + bj * HALF);
                }
                if (RESID_LO == 2) { const u32x4 l16 = *(const u32x4*)((const unsigned char*)blo + (size_t)row * 2048 + u.pn * BM + wc * 64 + fq * 16);
                    l8q[0] = (u32x2v){l16[0], l16[1]}; l8q[1] = (u32x2v){l16[2], l16[3]}; }
                u32x4 w16 = {0u, 0u, 0u, 0u};
#pragma unroll
                for (int bj = 0; bj < 2; ++bj) { float o[8]; u32x4 wh, wl; u32x2v w8 = {0u, 0u};
#pragma unroll
                    for (int j = 0; j < 4; ++j) { const unsigned hw = hvq[bj][j]; float b0 = bf_lo(hw), b1 = bf_hi(hw);
                        if (RESID_LO == 1) { const unsigned lw = lvq[bj][j]; b0 += bf_lo(lw); b1 += bf_hi(lw); }
                        if (RESID_LO == 2) { const f32x2v lf = (j & 1) ? __builtin_amdgcn_cvt_pk_f32_fp8((int)l8q[bj][j >> 1], true) : __builtin_amdgcn_cvt_pk_f32_fp8((int)l8q[bj][j >> 1], false);
                            b0 += lf.x * (1.0f / 512.0f); b1 += lf.y * (1.0f / 512.0f); }
                        o[2 * j] = b0 + acc[ai][bj][m][j >> 1][(2 * j) & 3] * coef; o[2 * j + 1] = b1 + acc[ai][bj][m][j >> 1][(2 * j + 1) & 3] * coef;
                        const unsigned nh = cvt_pk_bf16(o[2 * j], o[2 * j + 1]); wh[j] = nh;
                        if (RESID_LO == 1) wl[j] = cvt_pk_bf16(o[2 * j] - bf_lo(nh), o[2 * j + 1] - bf_hi(nh));
                        if (RESID_LO == 2) { const float r0 = (o[2 * j] - bf_lo(nh)) * 512.0f, r1 = (o[2 * j + 1] - bf_hi(nh)) * 512.0f;
                            w8[j >> 1] = (j & 1) ? (unsigned)__builtin_amdgcn_cvt_pk_fp8_f32(r0, r1, (int)w8[j >> 1], true) : (unsigned)__builtin_amdgcn_cvt_pk_fp8_f32(r0, r1, (int)w8[j >> 1], false); }
                        ss += o[2 * j] * o[2 * j] + o[2 * j + 1] * o[2 * j + 1]; }
                    *(u32x4*)(ohi + off + bj * HALF) = wh;
                    if (RESID_LO == 1) *(u32x4*)((bf16_t*)olo + off + bj * HALF) = wl;
                    if (RESID_LO == 2) { w16[2 * bj] = w8[0]; w16[2 * bj + 1] = w8[1]; } }
                if (RESID_LO == 2) *(u32x4*)((unsigned char*)olo + (size_t)row * 2048 + u.pn * BM + wc * 64 + fq * 16) = w16;
                ss += __shfl_xor(ss, 16); ss += __shfl_xor(ss, 32); ssr[q] = ss;
                if (m == 3) asm volatile("" ::: "memory");
            }
#endif
        { const float v0 = fq == 0 ? ssr[0] : fq == 1 ? ssr[2] : fq == 2 ? ssr[4] : ssr[6], v1 = fq == 0 ? ssr[1] : fq == 1 ? ssr[3] : fq == 2 ? ssr[5] : ssr[7];
          float* p = ssq + (size_t)(row0 + (fq >> 1) * HALF + (fq & 1) * 32) * 32 + u.pn * 4 + wc; p[0] = v0; p[16 * 32] = v1; }
    }
};

template <class E1> struct EpiTwice {
    static constexpr bool PERM = E1::PERM, AFTER_DRAIN = false;
    E1 a, b;
    __device__ __forceinline__ void operator()(const f32x4 (&acc)[2][2][4][2], const Unit& u, int wr, int wc, int fr, int fq) const { a(acc, u, wr, wc, fr, fq); asm volatile("" ::: "memory"); b(acc, u, wr, wc, fr, fq); }
};
template <class Epi, class Sched, bool ALIGN_EPI = false, bool SP2 = false>
__device__ __forceinline__ void gemm_phase(PG8_LAS unsigned char* lds, const Gemm g, const Sched& S, const Epi& E, const int tid) {
    const int wid = __builtin_amdgcn_readfirstlane(tid >> 6), lane = tid & 63, wr = wid >> 2, wc = wid & 3, fr = lane & 15, fq = lane >> 4;
    const int K = g.K, nt = K / BK;
    unsigned voffA[2], voffB[2];
#pragma unroll
    for (int i = 0; i < 2; ++i) { int R, C; stage_rc(tid * 16 + i * 8192, R, C); const int Rb = Epi::PERM ? ((R & ~31) + perm32(R & 31)) : R;
        voffA[i] = (unsigned)(R * K + C) * 2u; voffB[i] = (unsigned)(Rb * K + C) * 2u; }
    const size_t kstep = (size_t)(BK * 2);
    const size_t hstep = (size_t)HALF * K * 2;
    const size_t tstep = 2 * hstep;
    const unsigned ldsw = (unsigned)wid * 1024u;
    const int aoff = lds_byte(wr * 64 + fr, fq * 8), boff = lds_byte(wc * 32 + fr, fq * 8);
#define PG8_SA(b, h) (((b) * 2 + (h)) * HTB)
#define PG8_SB(b, h) ((4 + (b) * 2 + (h)) * HTB)
#define PG8_STAGE(bufoff, gbase, voff) do { _Pragma("unroll") for (int _i = 0; _i < 2; ++_i) \
        __builtin_amdgcn_global_load_lds((const unsigned*)((const char*)(gbase) + (voff)[_i]), (PG8_LAS unsigned*)(lds + (bufoff) + ldsw + _i * 8192), 16, 0, 0); } while (0)
#define PG8_LDA(dst, b, h) do { _Pragma("unroll") for (int m = 0; m < 4; ++m) _Pragma("unroll") for (int k = 0; k < 2; ++k) dst[m][k] = *(const PG8_LAS bf16x8*)(lds + PG8_SA(b, h) + aoff + m * 2048 + k * 1024); } while (0)
#define PG8_LDB(dst, b, h) do { _Pragma("unroll") for (int n = 0; n < 2; ++n) _Pragma("unroll") for (int k = 0; k < 2; ++k) dst[n][k] = *(const PG8_LAS bf16x8*)(lds + PG8_SB(b, h) + boff + n * 2048 + k * 1024); } while (0)
#define PG8_MMA(ai, bj, At, Bt) do { __builtin_amdgcn_s_setprio(1); _Pragma("unroll") for (int m = 0; m < 4; ++m) _Pragma("unroll") for (int n = 0; n < 2; ++n) _Pragma("unroll") for (int k = 0; k < 2; ++k) \
        acc[ai][bj][m][n] = __builtin_amdgcn_mfma_f32_16x16x32_bf16(Bt[n][k], At[m][k], acc[ai][bj][m][n], 0, 0, 0); __builtin_amdgcn_s_setprio(0); } while (0)
#define PG8_WAIT_V(n) asm volatile("s_waitcnt vmcnt(" #n ")" ::: "memory")
#define PG8_WAIT_L(n) asm volatile("s_waitcnt lgkmcnt(" #n ")" ::: "memory")
#define PG8_BAR __builtin_amdgcn_s_barrier()
#define PG8_SCHED __builtin_amdgcn_sched_barrier(0)
    Unit cur, nxt; int ui = 0;
    if (!S.next(0, cur)) return;
    f32x4 acc[2][2][4][2];
#pragma unroll
    for (int a = 0; a < 2; ++a)
#pragma unroll
        for (int b = 0; b < 2; ++b)
#pragma unroll
            for (int m = 0; m < 4; ++m)
#pragma unroll
                for (int n = 0; n < 2; ++n) acc[a][b][m][n] = (f32x4){0.f, 0.f, 0.f, 0.f};
    bf16x8 At[4][2], B0[2][2], B1[2][2];
    const char* cA = (const char*)g.A + (size_t)cur.pm * tstep; const char* cB = (const char*)g.Bt + (size_t)cur.pn * tstep;
    S.a_ready(cur);
    if constexpr (SP2) {
        PG8_STAGE(PG8_SB(0, 0), cB, voffB); PG8_STAGE(PG8_SB(0, 1), cB + hstep, voffB); PG8_STAGE(PG8_SA(0, 0), cA, voffA); PG8_STAGE(PG8_SA(0, 1), cA + hstep, voffA);
        if (wr == 1) PG8_BAR;
        PG8_WAIT_V(2); PG8_BAR;
        PG8_STAGE(PG8_SB(1, 0), cB + kstep, voffB); PG8_STAGE(PG8_SA(1, 0), cA + kstep, voffA); PG8_STAGE(PG8_SB(1, 1), cB + hstep + kstep, voffB);
        PG8_WAIT_V(6); PG8_BAR;
    } else {
        PG8_STAGE(PG8_SB(0, 0), cB, voffB); PG8_STAGE(PG8_SA(0, 0), cA, voffA); PG8_STAGE(PG8_SB(0, 1), cB + hstep, voffB); PG8_STAGE(PG8_SA(0, 1), cA + hstep, voffA);
        if (wr == 1) PG8_BAR;
        PG8_WAIT_V(4); PG8_BAR;
        PG8_STAGE(PG8_SB(1, 0), cB + kstep, voffB); PG8_STAGE(PG8_SA(1, 0), cA + kstep, voffA); PG8_STAGE(PG8_SB(1, 1), cB + hstep + kstep, voffB);
        PG8_WAIT_V(6); PG8_BAR;
    }
    for (;;) {
        const bool has_next = S.next(ui + 1, nxt);
        const char* nA = has_next ? (const char*)g.A + (size_t)nxt.pm * tstep : cA; const char* nB = has_next ? (const char*)g.Bt + (size_t)nxt.pn * tstep : cB;
        for (int t = 0; t < nt; t += 2) {
            const bool last = (t == nt - 2);
            const char* a1 = cA + (size_t)(t + 1) * kstep;
            const char* a2 = last ? nA : cA + (size_t)(t + 2) * kstep; const char* b2 = last ? nB : cB + (size_t)(t + 2) * kstep;
            const char* a3 = a2 + kstep; const char* b3 = b2 + kstep;
            if (last && has_next) S.a_ready(nxt);
            if constexpr (SP2) {
            PG8_LDB(B0, 0, 0); PG8_LDB(B1, 0, 1); PG8_SCHED; PG8_LDA(At, 0, 0); PG8_STAGE(PG8_SA(1, 1), a1 + hstep, voffA);
            PG8_WAIT_V(8); PG8_WAIT_L(0); PG8_BAR; PG8_MMA(0, 0, At, B0); PG8_MMA(0, 1, At, B1); PG8_BAR; PG8_SCHED;
            PG8_LDA(At, 0, 1); PG8_STAGE(PG8_SB(0, 0), b2, voffB); PG8_STAGE(PG8_SB(0, 1), b2 + hstep, voffB); PG8_STAGE(PG8_SA(0, 0), a2, voffA);
            PG8_WAIT_V(8); PG8_WAIT_L(0); PG8_BAR; PG8_MMA(1, 0, At, B0); PG8_MMA(1, 1, At, B1); PG8_BAR; PG8_SCHED;
            PG8_LDB(B0, 1, 0); PG8_LDB(B1, 1, 1); PG8_SCHED; PG8_LDA(At, 1, 0); PG8_STAGE(PG8_SA(0, 1), a2 + hstep, voffA);
            PG8_WAIT_V(8); PG8_WAIT_L(0); PG8_BAR; PG8_MMA(0, 0, At, B0); PG8_MMA(0, 1, At, B1); PG8_BAR; PG8_SCHED;
            PG8_LDA(At, 1, 1); PG8_STAGE(PG8_SB(1, 0), b3, voffB); PG8_STAGE(PG8_SB(1, 1), b3 + hstep, voffB); PG8_STAGE(PG8_SA(1, 0), a3, voffA);
            PG8_WAIT_V(8); PG8_WAIT_L(0); PG8_BAR; PG8_MMA(1, 0, At, B0); PG8_MMA(1, 1, At, B1); PG8_BAR; PG8_SCHED;
            } else {
            PG8_LDB(B0, 0, 0); PG8_SCHED; PG8_LDA(At, 0, 0); PG8_STAGE(PG8_SA(1, 1), a1 + hstep, voffA);
            PG8_WAIT_L(8); PG8_BAR; PG8_WAIT_L(0); PG8_MMA(0, 0, At, B0); PG8_BAR; PG8_SCHED;
            PG8_LDB(B1, 0, 1); PG8_STAGE(PG8_SB(0, 0), b2, voffB);
            PG8_BAR; PG8_WAIT_L(0); PG8_MMA(0, 1, At, B1); PG8_BAR;
            PG8_LDA(At, 0, 1); PG8_STAGE(PG8_SA(0, 0), a2, voffA);
            PG8_BAR; PG8_WAIT_L(0); PG8_MMA(1, 0, At, B0); PG8_BAR; PG8_SCHED;
            PG8_STAGE(PG8_SB(0, 1), b2 + hstep, voffB);
            PG8_WAIT_V(6); PG8_BAR; PG8_MMA(1, 1, At, B1); PG8_BAR;
            PG8_LDB(B0, 1, 0); PG8_SCHED; PG8_LDA(At, 1, 0); PG8_STAGE(PG8_SA(0, 1), a2 + hstep, voffA);
            PG8_WAIT_L(8); PG8_BAR; PG8_WAIT_L(0); PG8_MMA(0, 0, At, B0); PG8_BAR; PG8_SCHED;
            PG8_LDB(B1, 1, 1); PG8_STAGE(PG8_SB(1, 0), b3, voffB);
            PG8_BAR; PG8_WAIT_L(0); PG8_MMA(0, 1, At, B1); PG8_BAR;
            PG8_LDA(At, 1, 1); PG8_STAGE(PG8_SA(1, 0), a3, voffA);
            PG8_BAR; PG8_WAIT_L(0); PG8_MMA(1, 0, At, B0); PG8_BAR; PG8_SCHED;
            PG8_STAGE(PG8_SB(1, 1), b3 + hstep, voffB);
            PG8_WAIT_V(6); PG8_BAR; PG8_MMA(1, 1, At, B1); PG8_BAR;
            }
        }
        if constexpr (ALIGN_EPI) { if (wr == 0) PG8_BAR; }
        if constexpr (!Epi::AFTER_DRAIN) { E(acc, cur, wr, wc, fr, fq); S.done(cur); }
        if (!has_next) break;
#pragma unroll
        for (int a = 0; a < 2; ++a)
#pragma unroll
            for (int b = 0; b < 2; ++b)
#pragma unroll
                for (int m = 0; m < 4; ++m)
#pragma unroll
                    for (int n = 0; n < 2; ++n) acc[a][b][m][n] = (f32x4){0.f, 0.f, 0.f, 0.f};
        cur = nxt; cA = nA; cB = nB; ++ui;
        if constexpr (ALIGN_EPI) { if (wr == 1) PG8_BAR; }
    }
    PG8_WAIT_V(0);
    if constexpr (!ALIGN_EPI) { if (wr == 0) PG8_BAR; }
    PG8_BAR;
    if constexpr (Epi::AFTER_DRAIN) { E.fused(acc, cur, wr, wc, fr, fq, lds, wid, lane); S.done(cur); }
#undef PG8_SA
#undef PG8_SB
#undef PG8_STAGE
#undef PG8_LDA
#undef PG8_LDB
#undef PG8_MMA
#undef PG8_WAIT_V
#undef PG8_WAIT_L
#undef PG8_BAR
#undef PG8_SCHED
}
}

#define GAS __attribute__((address_space(1)))
#define LAS __attribute__((address_space(3)))
typedef unsigned short bf16;
typedef unsigned v4u __attribute__((ext_vector_type(4)));
typedef float f32x4 __attribute__((ext_vector_type(4)));
typedef short bf16x8 __attribute__((ext_vector_type(8)));
typedef GAS unsigned gu32;
typedef GAS unsigned long long gu64;
#define RLX_AGENT __ATOMIC_RELAXED, __HIP_MEMORY_SCOPE_AGENT
#define LDS_WAIT() asm volatile("s_waitcnt lgkmcnt(0)" ::: "memory")
#define VM_WAIT() asm volatile("s_waitcnt vmcnt(0)" ::: "memory")
__device__ __forceinline__ unsigned long long rt() { return __builtin_amdgcn_s_memrealtime(); }
__device__ __forceinline__ unsigned f2bf(float f) { unsigned u = __builtin_bit_cast(unsigned, f); return (u + 0x7fffu + ((u >> 16) & 1u)) >> 16; }
__device__ __forceinline__ unsigned pk2(float lo, float hi) { return f2bf(lo) | (f2bf(hi) << 16); }

#define XB_TMO      128
#define XB_XCNT(j)  (256  + 64 * (j))
#define XB_XSUB(j)  (1280 + 64 * (j))
#define XB_XGEN(j)  (2304 + 64 * (j))
#define XB_TOP      3328
#define XB_TOPGEN   3392
#define XCD_BAR_WORDS 3456
#define XB_SPIN_CAP (1u << 18)

__device__ __forceinline__ unsigned xb_ld(unsigned* p)              { return __hip_atomic_load(p, __ATOMIC_RELAXED, __HIP_MEMORY_SCOPE_AGENT); }
__device__ __forceinline__ unsigned xb_add(unsigned* p, unsigned v) { return __hip_atomic_fetch_add(p, v, __ATOMIC_RELAXED, __HIP_MEMORY_SCOPE_AGENT); }
__device__ __forceinline__ unsigned xb_xcc_id() { return (unsigned)__builtin_amdgcn_s_getreg((3 << 11) | 20) & 0xFu; }
#define XB_SPIN(cond, bar) do { unsigned _sp = 0; while (cond) { __builtin_amdgcn_s_sleep(1); \
    if ((++_sp & 255u) == 0u) { if (xb_ld(&(bar)[XB_TMO])) break; if (_sp > XB_SPIN_CAP) { atomicAdd(&(bar)[XB_TMO], 1u); break; } } } } while (0)

struct XcdBarrier {
    unsigned* bar; unsigned x;
    volatile LAS unsigned* st;
};

__device__ __forceinline__ XcdBarrier xcd_barrier_post(unsigned* bar, volatile LAS unsigned* st) {
    XcdBarrier b; b.bar = bar; b.x = xb_xcc_id(); b.st = st;
    if (threadIdx.x == 0) { const unsigned rk = xb_add(&bar[XB_XCNT(b.x)], 1u); st[2] = rk; st[3] = b.x; }
    return b;
}
__device__ __forceinline__ void xcd_barrier_complete(unsigned* bar, unsigned x, unsigned& nloc, unsigned& nx) {
    const unsigned G = gridDim.x * gridDim.y * gridDim.z;
    unsigned sum, cnt, mine, sp = 0u;
    for (;;) {
        sum = 0u; cnt = 0u; mine = 0u;
#pragma unroll
        for (unsigned j = 0; j < 16; ++j) { const unsigned c = xb_ld(&bar[XB_XCNT(j)]); sum += c; cnt += (c > 0u) ? 1u : 0u; mine = (j == x) ? c : mine; }
        if (sum == G) break;
        __builtin_amdgcn_s_sleep(1);
        if ((++sp & 255u) == 0u) { if (xb_ld(&bar[XB_TMO])) break; if (sp > XB_SPIN_CAP) { atomicAdd(&bar[XB_TMO], 1u); break; } }
    }
    nloc = mine > 0u ? mine : 1u; nx = cnt > 0u ? cnt : 1u;
}

__device__ __forceinline__ void xcd_barrier_t0(const XcdBarrier& b) {
        unsigned* bar = b.bar;
        __builtin_amdgcn_s_waitcnt(0);
        unsigned nloc = b.st[0], nx = b.st[1];
        if (nloc == 0u) { xcd_barrier_complete(bar, b.x, nloc, nx); b.st[0] = nloc; b.st[1] = nx; }
        const unsigned old = xb_add(&bar[XB_XSUB(b.x)], 1u);
        const unsigned gen = old / nloc;
        if (old + 1u == (gen + 1u) * nloc) {
            __builtin_amdgcn_fence(__ATOMIC_RELEASE, "agent");
            asm volatile("s_waitcnt vmcnt(0)" ::: "memory");
            const unsigned og = xb_add(&bar[XB_TOP], 1u);
            const unsigned tg = og / nx;
            if (og + 1u == (tg + 1u) * nx) xb_add(&bar[XB_TOPGEN], 1u);
            else XB_SPIN(xb_ld(&bar[XB_TOPGEN]) == tg, bar);
            __builtin_amdgcn_fence(__ATOMIC_ACQUIRE, "agent");
            xb_add(&bar[XB_XGEN(b.x)], 1u);
            asm volatile("s_waitcnt vmcnt(0)" ::: "memory");
        } else {
            XB_SPIN(xb_ld(&bar[XB_XGEN(b.x)]) == gen, bar);
            __builtin_amdgcn_fence(__ATOMIC_ACQUIRE, "agent");
            asm volatile("s_waitcnt vmcnt(0)" ::: "memory");
        }
}
__device__ __forceinline__ void xcd_barrier(const XcdBarrier& b) {
    asm volatile("s_waitcnt vmcnt(0)" ::: "memory");
    __syncthreads();
    if (threadIdx.x == 0) xcd_barrier_t0(b);
    __syncthreads();
}
template <class Fn> __device__ __forceinline__ void xcd_barrier_side(const XcdBarrier& b, int wave, const Fn& side) {
    asm volatile("s_waitcnt vmcnt(0)" ::: "memory");
    __syncthreads();
    if (wave == 0) { if (threadIdx.x == 0) xcd_barrier_t0(b); }
    else side();
    __syncthreads();
}

constexpr int BATCH = 4, SEQ = 2048, DM = 2048, NH = 16, HD = 128, FF = 5632, DEPTH = 4;
constexpr int M = BATCH * SEQ;
constexpr float RMS_EPS = 1e-6f;
constexpr int NWAVES = 8;

constexpr size_t MiB = 1u << 20;
constexpr size_t WS_CTL = 0, CTL_ZERO_BYTES = 1 * MiB;
constexpr size_t WS_SSQ = 1 * MiB;
constexpr size_t WS_H = 2 * MiB;
constexpr size_t WS_HB = 66 * MiB;
constexpr size_t WS_Q = 98 * MiB, WS_K = 130 * MiB, WS_V = 162 * MiB;
constexpr size_t WS_MIX = 194 * MiB;
constexpr size_t WS_ACT = 226 * MiB;
constexpr size_t WS_W = 320 * MiB;
constexpr size_t W_FFN_STRIDE = 66 * MiB, W_FFN_DOWN = 44 * MiB;
constexpr size_t WS_WATT = WS_W + 8 * W_FFN_STRIDE;
constexpr size_t WS_END = WS_WATT + 112 * MiB;
constexpr int CW_BAR = 4096;

constexpr int RING_OFF = 0;
constexpr int SCALE_OFF = 135168;
constexpr int LDSCTL_OFF = 139264;
constexpr int LDS_BYTES = 147456;

namespace att {
using bf16x8 = __attribute__((ext_vector_type(8))) short;
using s16x4  = __attribute__((ext_vector_type(4))) short;
using f32x16 = __attribute__((ext_vector_type(16))) float;
using u32x4  = __attribute__((ext_vector_type(4))) unsigned;
constexpr int D = 128, QBLK = 32, KVBLK = 64, PITCH = 2048;
constexpr float SCALE = 0.088388347648318440f, LOG2E = 1.4426950408889634f;
constexpr int SHM_V = KVBLK * D * 2, SHM_K = KVBLK * D * 2;
constexpr int OST_ROW = 272, OST_WAVE = 32 * OST_ROW;
constexpr int OFF_V = 0, OFF_K = 2 * SHM_V, OFF_WS = NWAVES * OST_WAVE, OFF_BIAS = OFF_WS + NWAVES * 256;
static_assert(OFF_WS >= 2 * SHM_V + 2 * SHM_K && OFF_BIAS + (513 + 64) * 4 <= 131072, "attention LDS map");
#define KSWZ(row, colB) ((row) * 256 + ((colB) ^ (((row) & 7) << 4)))
#define SBAR() __builtin_amdgcn_sched_barrier(0)
__device__ __forceinline__ int crow(int r, int hi) { return (r & 3) + 8 * (r >> 2) + 4 * hi; }
__device__ __forceinline__ unsigned cvtpk(float lo, float hi) { unsigned r; asm volatile("v_cvt_pk_bf16_f32 %0, %1, %2" : "=v"(r) : "v"(lo), "v"(hi)); return r; }
__device__ __forceinline__ void qkt(f32x16& p0, f32x16& p1, const char* Ks, const bf16x8* qr, int r32, int hi) {
  p0 = f32x16{}; p1 = f32x16{};
  bf16x8 ka[4], kb[4];
#pragma unroll
  for (int hb = 0; hb < 2; ++hb) {
#pragma unroll
    for (int d = 0; d < 4; ++d) { const int cb = ((hb * 4 + d) * 16 + hi * 8) * 2;
      ka[d] = *reinterpret_cast<const bf16x8*>(Ks + KSWZ(r32, cb)); kb[d] = *reinterpret_cast<const bf16x8*>(Ks + KSWZ(32 + r32, cb)); }
    SBAR();
#pragma unroll
    for (int d = 0; d < 4; ++d) {
      p0 = __builtin_amdgcn_mfma_f32_32x32x16_bf16(ka[d], qr[hb * 4 + d], p0, 0, 0, 0);
      p1 = __builtin_amdgcn_mfma_f32_32x32x16_bf16(kb[d], qr[hb * 4 + d], p1, 0, 0, 0); }
    SBAR();
  }
}
__device__ __forceinline__ int v_st(int k, int c) { const int kk = (k & ~0xC) | ((k & 4) << 1) | ((k & 8) >> 1); return ((kk >> 3) * 4 + (c >> 5)) * 512 + ((kk & 7) * 32 + (c & 31)) * 2; }
__device__ __forceinline__ int v_rd_base(int lane) { return ((lane & 3) << 3) | (((lane >> 2) & 3) << 6) | (((lane >> 4) & 1) << 5) | (((lane >> 5) & 1) << 8); }
constexpr int v_rd_off(int d0, int ks, int half) { return d0 * 512 + ks * 4096 + half * 2048; }
template <int OFF> __device__ __forceinline__ s16x4 tr_read(int vb) {
  s16x4 r; asm volatile("ds_read_b64_tr_b16 %0, %1 offset:%2" : "=&v"(r) : "v"(vb), "i"(OFF) : "memory"); return r;
}
struct VFrag { s16x4 l0, h0, l1, h1, l2, h2, l3, h3; };
template <int D0> __device__ __forceinline__ void v_reads(VFrag& f, int vb) {
  f.l0 = tr_read<v_rd_off(D0, 0, 0)>(vb); f.h0 = tr_read<v_rd_off(D0, 0, 1)>(vb); f.l1 = tr_read<v_rd_off(D0, 1, 0)>(vb); f.h1 = tr_read<v_rd_off(D0, 1, 1)>(vb);
  f.l2 = tr_read<v_rd_off(D0, 2, 0)>(vb); f.h2 = tr_read<v_rd_off(D0, 2, 1)>(vb); f.l3 = tr_read<v_rd_off(D0, 3, 0)>(vb); f.h3 = tr_read<v_rd_off(D0, 3, 1)>(vb);
}
__device__ __forceinline__ void pv_mma(f32x16& od, const VFrag& f, bf16x8 pa0, bf16x8 pa1, bf16x8 pa2, bf16x8 pa3) {
#define PK(L, H) (bf16x8){L[0], L[1], L[2], L[3], H[0], H[1], H[2], H[3]}
  od = __builtin_amdgcn_mfma_f32_32x32x16_bf16(pa0, PK(f.l0, f.h0), od, 0, 0, 0);
  od = __builtin_amdgcn_mfma_f32_32x32x16_bf16(pa1, PK(f.l1, f.h1), od, 0, 0, 0);
  od = __builtin_amdgcn_mfma_f32_32x32x16_bf16(pa2, PK(f.l2, f.h2), od, 0, 0, 0);
  od = __builtin_amdgcn_mfma_f32_32x32x16_bf16(pa3, PK(f.l3, f.h3), od, 0, 0, 0);
#undef PK
}
__device__ __forceinline__ void pv_d0(f32x16* o, int vb, bf16x8 pa0, bf16x8 pa1, bf16x8 pa2, bf16x8 pa3) {
  VFrag fa, fb;
  v_reads<0>(fa, vb); v_reads<1>(fb, vb);
  asm volatile("s_waitcnt lgkmcnt(8)" ::: "memory"); SBAR(); pv_mma(o[0], fa, pa0, pa1, pa2, pa3); SBAR();
  v_reads<2>(fa, vb);
  asm volatile("s_waitcnt lgkmcnt(8)" ::: "memory"); SBAR(); pv_mma(o[1], fb, pa0, pa1, pa2, pa3); SBAR();
  v_reads<3>(fb, vb);
  asm volatile("s_waitcnt lgkmcnt(8)" ::: "memory"); SBAR(); pv_mma(o[2], fa, pa0, pa1, pa2, pa3); SBAR();
  asm volatile("s_waitcnt lgkmcnt(0)" ::: "memory"); SBAR(); pv_mma(o[3], fb, pa0, pa1, pa2, pa3);
}
__device__ __forceinline__ void pack_p(const f32x16& p0, const f32x16& p1, bf16x8& pa0, bf16x8& pa1, bf16x8& pa2, bf16x8& pa3) {
#define PK4(P, BASE, OUT) do { unsigned a0 = cvtpk(P[BASE + 0], P[BASE + 1]), a1 = cvtpk(P[BASE + 2], P[BASE + 3]);   \
    unsigned b0 = cvtpk(P[BASE + 4], P[BASE + 5]), b1 = cvtpk(P[BASE + 6], P[BASE + 7]);                              \
    auto r0 = __builtin_amdgcn_permlane32_swap(a0, b0, false, false); auto r1 = __builtin_amdgcn_permlane32_swap(a1, b1, false, false); \
    u32x4 w = {r0[0], r1[0], r0[1], r1[1]}; OUT = *reinterpret_cast<bf16x8*>(&w); } while (0)
  PK4(p0, 0, pa0); PK4(p0, 8, pa1); PK4(p1, 0, pa2); PK4(p1, 8, pa3);
#undef PK4
}
__device__ __forceinline__ void swap2(float x, float& lo, float& hi) {
  auto rr = __builtin_amdgcn_permlane32_swap(__float_as_uint(x), __float_as_uint(x), false, false); lo = __uint_as_float(rr[0]); hi = __uint_as_float(rr[1]);
}
__device__ __forceinline__ unsigned short f2bf1(float f) { return (unsigned short)(cvtpk(f, 0.f) & 0xffffu); }

struct Stg { bf16x8 vs0, vs1, ks0, ks1; };
__device__ __forceinline__ void sload(Stg& s, const unsigned short* Kh, const unsigned short* Vh, int k0, int sr, int sc) {
  s.vs0 = *reinterpret_cast<const bf16x8*>(Vh + (size_t)(k0 + sr) * PITCH + sc); s.vs1 = *reinterpret_cast<const bf16x8*>(Vh + (size_t)(k0 + 32 + sr) * PITCH + sc);
  s.ks0 = *reinterpret_cast<const bf16x8*>(Kh + (size_t)(k0 + sr) * PITCH + sc); s.ks1 = *reinterpret_cast<const bf16x8*>(Kh + (size_t)(k0 + 32 + sr) * PITCH + sc);
}
__device__ __forceinline__ void swrite(const Stg& s, char* lds, int buf, int sr, int sc, int vst0, int vst1) {
  *(bf16x8*)(lds + OFF_V + buf * SHM_V + vst0) = s.vs0; *(bf16x8*)(lds + OFF_V + buf * SHM_V + vst1) = s.vs1; const int kc = sc * 2;
  *(bf16x8*)(lds + OFF_K + buf * SHM_K + KSWZ(sr, kc)) = s.ks0; *(bf16x8*)(lds + OFF_K + buf * SHM_K + KSWZ(32 + sr, kc)) = s.ks1;
}
__device__ __forceinline__ void store_o(const f32x16* o, const float* rs, unsigned short* Ow, int r32, int hi, char* lds, int wid, int lane) {
  char* stg = lds + wid * OST_WAVE;
#pragma unroll
  for (int r = 0; r < 16; ++r) { const int orow = crow(r, hi);
#pragma unroll
    for (int d0 = 0; d0 < 4; ++d0) *(unsigned short*)(stg + orow * OST_ROW + (d0 * 32 + r32) * 2) = f2bf1(o[d0][r] * rs[r]); }
  asm volatile("s_waitcnt lgkmcnt(0)" ::: "memory");
#pragma unroll
  for (int j = 0; j < 8; ++j) { const int row = (lane >> 4) + 4 * j; const u32x4 v = *(const u32x4*)(stg + row * OST_ROW + (lane & 15) * 16);
    *(u32x4*)(Ow + (size_t)row * PITCH + (lane & 15) * 8) = v; }
}

template <bool MASK> __device__ __forceinline__ void stick_tile(f32x16& p0, f32x16& p1, float& Rm, int& Re, int tkh, int hi) {
  constexpr float C2 = SCALE * LOG2E;
  float x0[16], x1[16];
#pragma unroll
  for (int r = 0; r < 16; ++r) {
    { const float y = fmaxf(p0[r] * C2, -126.f); const float e = __builtin_amdgcn_exp2f(-y); const float sg = __builtin_amdgcn_rcpf(1.0f + e); const float om = e * sg;
      p0[r] = sg; x0[r] = (!MASK || ((r & 3) + 8 * (r >> 2)) < tkh) ? om : 1.0f; }
    { const float y = fmaxf(p1[r] * C2, -126.f); const float e = __builtin_amdgcn_exp2f(-y); const float sg = __builtin_amdgcn_rcpf(1.0f + e); const float om = e * sg;
      p1[r] = sg; x1[r] = (!MASK || (32 + (r & 3) + 8 * (r >> 2)) < tkh) ? om : 1.0f; }
  }
  float G[16];
#pragma unroll
  for (int c = 0; c < 4; ++c) {
    swap2((x0[4 * c] * x0[4 * c + 1]) * (x0[4 * c + 2] * x0[4 * c + 3]), G[2 * c], G[2 * c + 1]); swap2((x1[4 * c] * x1[4 * c + 1]) * (x1[4 * c + 2] * x1[4 * c + 3]), G[8 + 2 * c], G[8 + 2 * c + 1]);
  }
  float SG[16]; SG[15] = 1.0f;
#pragma unroll
  for (int g = 14; g >= 0; --g) SG[g] = SG[g + 1] * G[g + 1];
  const float total = SG[0] * G[0];
  const float Rs = ldexpf(Rm, Re);
#pragma unroll
  for (int c = 0; c < 4; ++c) {
    const float b0 = Rs * (hi ? SG[2 * c + 1] : SG[2 * c]), b1 = Rs * (hi ? SG[8 + 2 * c + 1] : SG[8 + 2 * c]);
    float e0[4], e1[4];
    e0[3] = b0; e0[2] = e0[3] * x0[4 * c + 3]; e0[1] = e0[2] * x0[4 * c + 2]; e0[0] = e0[1] * x0[4 * c + 1];
    e1[3] = b1; e1[2] = e1[3] * x1[4 * c + 3]; e1[1] = e1[2] * x1[4 * c + 2]; e1[0] = e1[1] * x1[4 * c + 1];
#pragma unroll
    for (int i = 0; i < 4; ++i) { const int r = 4 * c + i;
      const float a0 = p0[r] * e0[i], a1 = p1[r] * e1[i];
      p0[r] = (!MASK || ((r & 3) + 8 * (r >> 2)) < tkh) ? a0 : 0.f; p1[r] = (!MASK || (32 + (r & 3) + 8 * (r >> 2)) < tkh) ? a1 : 0.f; }
  }
  Rm *= total;
#pragma unroll
  for (int k = 0; k < 2; ++k) { const bool sm = Rm < 5.421010862427522e-20f; Rm = sm ? Rm * 18446744073709551616.0f : Rm; Re = sm ? Re - 64 : Re; }
}

__device__ __forceinline__ void stick_unit(const unsigned short* Q, const unsigned short* K, const unsigned short* V, unsigned short* O, int b, int h, int qb, char* lds, const int tid) {
  const int wid = __builtin_amdgcn_readfirstlane(tid >> 6), lane = tid & 63, r32 = lane & 31, hi = lane >> 5;
  const int t = 256 * qb + 32 * wid + r32;
  const int tmaxw = 256 * qb + 32 * wid + 31, tminw = 256 * qb + 32 * wid;
  const size_t rowb = (size_t)b * SEQ;
  bf16x8 qr[8];
  { const unsigned short* Qw = Q + (rowb + t) * PITCH + h * HD + hi * 8;
#pragma unroll
    for (int d0 = 0; d0 < 8; ++d0) qr[d0] = *reinterpret_cast<const bf16x8*>(Qw + d0 * 16); }
  const unsigned short* Kh = K + rowb * PITCH + h * HD; const unsigned short* Vh = V + rowb * PITCH + h * HD;
  const int sr = tid >> 4, sc = (tid & 15) * 8, vst0 = v_st(sr, sc), vst1 = v_st(32 + sr, sc);
  const int vb0 = (int)(uintptr_t)(lds + OFF_V) + v_rd_base(lane);
  f32x16 o[4] = {}; float Rm = 1.0f; int Re = 0;
  const int NT = 4 * qb + 4; int buf = 0;
  Stg st;
  volatile __attribute__((address_space(3))) int* flags = (volatile __attribute__((address_space(3))) int*)(lds + OFF_WS);
  bool wdone = false;
  __syncthreads();
  if (lane < 2) flags[lane * 8 + wid] = 0;
  sload(st, Kh, Vh, (NT - 1) * KVBLK, sr, sc); asm volatile("s_waitcnt vmcnt(0)" ::: "memory"); swrite(st, lds, 0, sr, sc, vst0, vst1); __syncthreads();
  for (int kt = NT - 1; kt >= 0; --kt) {
    if (kt > 0) sload(st, Kh, Vh, (kt - 1) * KVBLK, sr, sc);
    const int k0 = kt * KVBLK;
    if (k0 < tmaxw && !wdone) {
      f32x16 p0, p1;
      qkt(p0, p1, lds + OFF_K + buf * SHM_K, qr, r32, hi);
      const int tkh = t - k0 - 4 * hi;
      if (k0 + 63 < tminw) stick_tile<false>(p0, p1, Rm, Re, tkh, hi); else stick_tile<true>(p0, p1, Rm, Re, tkh, hi);
      bf16x8 pa0, pa1, pa2, pa3; pack_p(p0, p1, pa0, pa1, pa2, pa3);
      pv_d0(o, vb0 + buf * SHM_V, pa0, pa1, pa2, pa3);
      wdone = __all(Re <= -192 || Rm == 0.f);
    }
    if (lane == 0) flags[(kt & 1) * 8 + wid] = wdone ? 1 : 0;
    if (kt > 0) { asm volatile("s_waitcnt vmcnt(0)" ::: "memory"); swrite(st, lds, buf ^ 1, sr, sc, vst0, vst1); }
    __syncthreads();
    buf ^= 1;
    { const int fl = flags[(kt & 1) * 8 + (lane & 7)]; if (__all(fl != 0)) break; }
  }
  float rs[16];
#pragma unroll
  for (int r = 0; r < 16; ++r) rs[r] = 1.0f;
  store_o(o, rs, O + (rowb + 256 * qb + 32 * wid) * PITCH + h * HD, r32, hi, lds, wid, lane);
  if (PROBE_DUP == 10) { asm volatile("s_waitcnt vmcnt(0)" ::: "memory"); store_o(o, rs, O + (rowb + 256 * qb + 32 * wid) * PITCH + h * HD, r32, hi, lds, wid, lane); }
}

__device__ __forceinline__ void band_unit(const unsigned short* Q, const unsigned short* K, const unsigned short* V, unsigned short* O, const float* bias  , int b, int h, int qb, char* lds, const int tid) {
  const int wid = __builtin_amdgcn_readfirstlane(tid >> 6), lane = tid & 63, r32 = lane & 31, hi = lane >> 5;
  const int t = 256 * qb + 32 * wid + r32;
  const int cq = 4 * qb + (wid >> 1);
  const size_t rowb = (size_t)b * SEQ;
  bf16x8 qr[8];
  { const unsigned short* Qw = Q + (rowb + t) * PITCH + h * HD + hi * 8;
#pragma unroll
    for (int d0 = 0; d0 < 8; ++d0) qr[d0] = *reinterpret_cast<const bf16x8*>(Qw + d0 * 16); }
  const unsigned short* Kh = K + rowb * PITCH + h * HD; const unsigned short* Vh = V + rowb * PITCH + h * HD;
  const int sr = tid >> 4, sc = (tid & 15) * 8, vst0 = v_st(sr, sc), vst1 = v_st(32 + sr, sc);
  const int vb0 = (int)(uintptr_t)(lds + OFF_V) + v_rd_base(lane);
  float* wsf = (float*)(lds + OFF_WS) + wid * 64; float* al_l = wsf + 32;
  float* bias_l = (float*)(lds + OFF_BIAS);
  f32x16 o[4] = {}; f32x16 lacc = {}; float m_reg = -1e30f;
  const int kc_lo = (4 * qb - 8) > 0 ? (4 * qb - 8) : 0, kc_hi = 4 * qb + 3; int buf = 0;
  Stg st;
  const bf16x8 ones = {0x3F80, 0x3F80, 0x3F80, 0x3F80, 0x3F80, 0x3F80, 0x3F80, 0x3F80};
  constexpr float THR2 = 8.0f * LOG2E;
  __syncthreads();
  for (int i = tid; i < 513 + 64; i += NWAVES * 64) bias_l[i] = bias[i < 512 ? i : 512] * LOG2E;
  sload(st, Kh, Vh, kc_lo * KVBLK, sr, sc); asm volatile("s_waitcnt vmcnt(0)" ::: "memory"); swrite(st, lds, 0, sr, sc, vst0, vst1); __syncthreads();
  for (int kc = kc_lo; kc <= kc_hi; ++kc) {
    if (kc < kc_hi) sload(st, Kh, Vh, (kc + 1) * KVBLK, sr, sc);
    if (kc >= cq - 8 && kc <= cq) {
      f32x16 p0, p1;
      qkt(p0, p1, lds + OFF_K + buf * SHM_K, qr, r32, hi);
      constexpr float C2 = SCALE * LOG2E;
      float pmax = -1e30f;
      if (kc <= cq - 5) {
        const float bfar = bias_l[512];
#pragma unroll
        for (int r = 0; r < 16; ++r) { p0[r] = p0[r] * C2 + bfar; p1[r] = p1[r] * C2 + bfar; pmax = fmaxf(pmax, fmaxf(p0[r], p1[r])); }
      } else {
        const float* bp = bias_l + (t - kc * KVBLK - 4 * hi + 256);
        float bv0[16], bv1[16];
#pragma unroll
        for (int r = 0; r < 16; ++r) { bv0[r] = bp[-((r & 3) + 8 * (r >> 2))]; bv1[r] = bp[-(32 + (r & 3) + 8 * (r >> 2))]; }
        SBAR();
#pragma unroll
        for (int r = 0; r < 16; ++r) { p0[r] = p0[r] * C2 + bv0[r]; p1[r] = p1[r] * C2 + bv1[r]; pmax = fmaxf(pmax, fmaxf(p0[r], p1[r])); }
      }
      { float lo, hh; swap2(pmax, lo, hh); pmax = fmaxf(lo, hh); }
      float mn, alpha;
      if (__all(pmax - m_reg <= THR2)) { mn = m_reg; alpha = 1.f; } else { mn = fmaxf(m_reg, pmax); alpha = __builtin_amdgcn_exp2f(m_reg - mn); m_reg = mn; }
#pragma unroll
      for (int r = 0; r < 16; ++r) { p0[r] = __builtin_amdgcn_exp2f(p0[r] - mn); p1[r] = __builtin_amdgcn_exp2f(p1[r] - mn); }
      if (__any(alpha < 1.f)) { if (hi == 0) al_l[r32] = alpha; asm volatile("s_waitcnt lgkmcnt(0)" ::: "memory");
#pragma unroll
        for (int r = 0; r < 16; ++r) { const float a = al_l[crow(r, hi)]; lacc[r] *= a;
#pragma unroll
          for (int d = 0; d < 4; ++d) o[d][r] *= a; } }
      bf16x8 pa0, pa1, pa2, pa3; pack_p(p0, p1, pa0, pa1, pa2, pa3);
      lacc = __builtin_amdgcn_mfma_f32_32x32x16_bf16(pa0, ones, lacc, 0, 0, 0); lacc = __builtin_amdgcn_mfma_f32_32x32x16_bf16(pa1, ones, lacc, 0, 0, 0);
      lacc = __builtin_amdgcn_mfma_f32_32x32x16_bf16(pa2, ones, lacc, 0, 0, 0); lacc = __builtin_amdgcn_mfma_f32_32x32x16_bf16(pa3, ones, lacc, 0, 0, 0);
      pv_d0(o, vb0 + buf * SHM_V, pa0, pa1, pa2, pa3);
    }
    if (kc < kc_hi) { asm volatile("s_waitcnt vmcnt(0)" ::: "memory"); swrite(st, lds, buf ^ 1, sr, sc, vst0, vst1); }
    __syncthreads();
    buf ^= 1;
  }
  float rs[16];
#pragma unroll
  for (int r = 0; r < 16; ++r) rs[r] = __builtin_amdgcn_rcpf(lacc[r]);
  store_o(o, rs, O + (rowb + 256 * qb + 32 * wid) * PITCH + h * HD, r32, hi, lds, wid, lane);
  if (PROBE_DUP == 10) { asm volatile("s_waitcnt vmcnt(0)" ::: "memory"); store_o(o, rs, O + (rowb + 256 * qb + 32 * wid) * PITCH + h * HD, r32, hi, lds, wid, lane); }
}
#undef KSWZ
#undef SBAR
}

struct Frame {
    LAS unsigned char* lds;
    volatile LAS unsigned* MISC;
    gu32* ctl;
    int tid, lane, wave;
    int vcu, G;
};
__device__ __forceinline__ float wave_sum(float v) {
#pragma unroll
    for (int o = 1; o < 64; o <<= 1) v += __shfl_xor(v, o);
    return v;
}
struct ConvItem { const float* src; const float* gain; bf16* dst; int N, Kd; };
__device__ __forceinline__ void tr_load(const ConvItem& c, f32x4 (&v)[16], int lane) {
    const float* src = c.src + (size_t)(lane >> 4) * c.N + (lane & 15) * 4;
#pragma unroll
    for (int j = 0; j < 16; ++j) v[j] = __builtin_nontemporal_load((const f32x4*)(src + (size_t)(4 * j) * c.N));
}
__device__ __forceinline__ void tr_lds_write(const f32x4 (&v)[16], LAS float* scr, int lane) {
    LAS float* d = scr + (lane >> 4) * 65 + (lane & 15) * 4;
#pragma unroll
    for (int j = 0; j < 16; ++j) { d[(4 * j) * 65 + 0] = v[j][0]; d[(4 * j) * 65 + 1] = v[j][1]; d[(4 * j) * 65 + 2] = v[j][2]; d[(4 * j) * 65 + 3] = v[j][3]; }
}
__device__ __forceinline__ void tr_store(const ConvItem& it, LAS float* scr, int lane) {
    const int c = lane & 7;
    float gk[8];
#pragma unroll
    for (int i = 0; i < 8; ++i) gk[i] = it.gain ? it.gain[8 * c + i] : 1.0f;
    LDS_WAIT(); asm volatile("" ::: "memory");
#pragma unroll
    for (int j = 0; j < 8; ++j) { const int n = (lane >> 3) + 8 * j; const LAS float* s = scr + (8 * c) * 65 + n;
        v4u o; o.x = pk2(s[0 * 65] * gk[0], s[1 * 65] * gk[1]); o.y = pk2(s[2 * 65] * gk[2], s[3 * 65] * gk[3]); o.z = pk2(s[4 * 65] * gk[4], s[5 * 65] * gk[5]); o.w = pk2(s[6 * 65] * gk[6], s[7 * 65] * gk[7]);
        __builtin_nontemporal_store(o, (GAS v4u*)(it.dst + (size_t)n * it.Kd + 8 * c)); }
    LDS_WAIT(); asm volatile("" ::: "memory");
}

struct Args { const float* in[14]; float* out; unsigned char* ws; int ph_lo, ph_hi; };

__device__ __forceinline__ bf16* w_gu(unsigned char* ws, int f) { return (bf16*)(ws + WS_W + (size_t)f * W_FFN_STRIDE); }
__device__ __forceinline__ bf16* w_dn(unsigned char* ws, int f) { return (bf16*)(ws + WS_W + (size_t)f * W_FFN_STRIDE + W_FFN_DOWN); }
__device__ __forceinline__ bf16* w_mix1(unsigned char* ws, int layer) { return (bf16*)(ws + WS_WATT + (size_t)layer * 32 * MiB); }
__device__ __forceinline__ bf16* w_mixo(unsigned char* ws, int layer) { return (bf16*)(ws + WS_WATT + (size_t)layer * 32 * MiB + (layer < 3 ? 24 : 8) * MiB); }

constexpr int CONV_TOTAL = 81920;
#ifndef CONV_CAP
#define CONV_CAP 8192
#endif
#ifndef CONV_NBW
#define CONV_NBW 4
#endif
constexpr int CONV_NB = CONV_NBW * 256;
constexpr int bar_off(int b) { if (b <= 0) return 0; const int L = (b - 1) / 7, j = (b - 1) % 7 + 1; return CONV_NB + L * (7 * CONV_NB + 2 * CONV_CAP) + CONV_CAP + (j - 1) * CONV_NB + (j >= 6 ? CONV_CAP : 0); }
constexpr int slot_off(int k) { return CONV_NB + (k / 2) * (7 * CONV_NB + 2 * CONV_CAP) + ((k & 1) ? CONV_CAP + 5 * CONV_NB : 0); }
constexpr int conv_up() { int u = 0;
    for (int L = 0; L < 4; ++L) { const int base = L * 20992, msz = L < 3 ? 4096 : 2048, q = L < 3 ? 3072 : 1024;
        const int need[6] = {base + 5632, base + 8448, base + 8448 + q, base + 8448 + msz, base + 8448 + msz + 5632, base + 8448 + msz + 8448};
        const int at[6] = {7 * L, 7 * L + 1, 7 * L + 2, 7 * L + 4, 7 * L + 5, 7 * L + 6};
        for (int i = 0; i < 6; ++i) { const int d = need[i] - bar_off(at[i]); if (d > u) u = d; } }
    return u < CONV_TOTAL ? u : CONV_TOTAL; }
constexpr int CONV_UP = (CONV_CAP > 0 || CONV_NBW > 0) ? conv_up() : CONV_TOTAL;
static_assert(CONV_UP + bar_off(27) >= CONV_TOTAL, "conversion schedule covers every item");
static_assert(CONV_NBW >= 0 && CONV_NBW <= 7, "waves 1..7 only");
__device__ __forceinline__ void conv_decode(const Args& a, int it, ConvItem& ci) {
    unsigned char* ws = a.ws;
    const float *g_ffn = a.in[1], *wg = a.in[2], *wu = a.in[3], *wd = a.in[4], *g_mix = a.in[5], *wqkv = a.in[6], *woa = a.in[7], *g_kv = a.in[8], *wkv = a.in[9], *wqb = a.in[10], *wob = a.in[11];
        const float* W; const float* gain = nullptr; bf16* WT; int N, Kd, kb, nb, drow_add = 0; bool ilv = false; int mat = 0;
        int L = it / 20992; if (L > 3) L = 3; int r = it - L * 20992;
        const int msz = L < 3 ? 4096 : 2048;
        int f = 2 * L; bool ffn = true;
        if (r >= 8448) { r -= 8448; if (r < msz) ffn = false; else { r -= msz; f = 2 * L + 1; } }
        if (ffn) { mat = r / 2816; r -= mat * 2816;
            if (mat < 2) { N = FF; Kd = DM; W = (mat == 0 ? wg : wu) + (size_t)f * DM * FF; gain = g_ffn + (size_t)f * DM; WT = w_gu(ws, f); kb = r / 88; nb = r - kb * 88; ilv = true; }
            else { N = DM; Kd = FF; W = wd + (size_t)f * FF * DM; WT = w_dn(ws, f); kb = r / 32; nb = r - kb * 32; }
        } else if (L < 2) {
            if (r < 3072) { N = 3 * DM; Kd = DM; W = wqkv + (size_t)L * DM * 3 * DM; gain = g_mix + (size_t)L * DM; WT = w_mix1(ws, L); kb = r / 96; nb = r - kb * 96; }
            else { r -= 3072; N = DM; Kd = DM; W = woa + (size_t)L * DM * DM; WT = w_mixo(ws, L); kb = r / 32; nb = r - kb * 32; }
        } else if (L == 2) {
            if (r < 1024) { N = DM; Kd = DM; W = wqb; gain = g_mix + 2 * DM; WT = w_mix1(ws, 2); kb = r / 32; nb = r - kb * 32; }
            else if (r < 3072) { r -= 1024; N = 2 * DM; Kd = DM; W = wkv; gain = g_kv; WT = w_mix1(ws, 2); kb = r / 64; nb = r - kb * 64; drow_add = DM; }
            else { r -= 3072; N = DM; Kd = DM; W = wob; WT = w_mixo(ws, 2); kb = r / 32; nb = r - kb * 32; }
        } else {
            if (r < 1024) { N = DM; Kd = DM; W = wqb + (size_t)DM * DM; gain = g_mix + 3 * DM; WT = w_mix1(ws, 3); kb = r / 32; nb = r - kb * 32; }
            else { r -= 1024; N = DM; Kd = DM; W = wob + (size_t)DM * DM; WT = w_mixo(ws, 3); kb = r / 32; nb = r - kb * 32; }
        }
        const int n0 = nb * 64, k0 = kb * 64; const int drow = ilv ? (256 * (n0 >> 7) + (n0 & 127) + 128 * mat) : (n0 + drow_add);
        ci.src = W + (size_t)k0 * N + n0; ci.gain = gain ? gain + k0 : nullptr; ci.dst = WT + (size_t)drow * Kd + k0; ci.N = N; ci.Kd = Kd;
}
__device__ __forceinline__ void conv_one(Frame& F, const Args& a, int it) {
    LAS float* scr = (LAS float*)(F.lds + RING_OFF + F.wave * 16640);
    int lane_ = threadIdx.x; asm volatile("" : "+v"(lane_)); lane_ &= 63;
    ConvItem c; f32x4 v[16]; conv_decode(a, it, c); tr_load(c, v, lane_); tr_lds_write(v, scr, lane_); tr_store(c, scr, lane_);
}
__device__ __forceinline__ void conv_items(Frame& F, const Args& a, int it_lo, int it_hi, int rank, int nranks) {
    LAS float* scr = (LAS float*)(F.lds + RING_OFF + F.wave * 16640);
    auto decode = [&](int it, ConvItem& ci) { conv_decode(a, it, ci); };
    const int stride = nranks * NWAVES; int it = it_lo + rank * NWAVES + F.wave;
    int lane_ = threadIdx.x; asm volatile("" : "+v"(lane_)); lane_ &= 63;
    ConvItem cA, cB; f32x4 vA[16], vB[16];
    if (it < it_hi) { decode(it, cA); tr_load(cA, vA, lane_); }
    if (it + stride < it_hi) { decode(it + stride, cB); tr_load(cB, vB, lane_); }
    while (it < it_hi) {
        tr_lds_write(vA, scr, lane_);
        { const ConvItem cur = cA; const int itn = it + 2 * stride; if (itn < it_hi) { decode(itn, cA); tr_load(cA, vA, lane_); } tr_store(cur, scr, lane_); }
        it += stride; if (it >= it_hi) break;
        tr_lds_write(vB, scr, lane_);
        { const ConvItem cur = cB; const int itn = it + 2 * stride; if (itn < it_hi) { decode(itn, cB); tr_load(cB, vB, lane_); } tr_store(cur, scr, lane_); }
        it += stride;
    }
}
__device__ __forceinline__ int lo_perm(int c) { return (c & ~255) | (((c >> 5) & 3) << 6) | (((c >> 3) & 3) << 4) | (((c >> 7) & 1) << 3) | (c & 7); }
__device__ __forceinline__ void p0_prologue(Frame& F, const Args& a) {
    unsigned char* ws = a.ws;
    const int gw = F.vcu * NWAVES + F.wave, NGW = F.G * NWAVES;
    conv_items(F, a, 0, CONV_UP, F.vcu, F.G);
    const float* x = a.in[0]; bf16* hb = (bf16*)(ws + WS_HB); bf16* hl = (bf16*)(ws + WS_H); float* ssq = (float*)(ws + WS_SSQ);
    int lane_ = threadIdx.x; asm volatile("" : "+v"(lane_)); lane_ &= 63;
    for (int m = gw; m < M; m += NGW) {
        const GAS f32x4* xr = (const GAS f32x4*)(x + (size_t)m * DM) + lane_; f32x4 v[8]; float s = 0.f;
#pragma unroll
        for (int j = 0; j < 8; ++j) { v[j] = xr[64 * j]; s += (v[j].x * v[j].x + v[j].y * v[j].y) + (v[j].z * v[j].z + v[j].w * v[j].w); }
        s = wave_sum(s);
        GAS unsigned long long* o8 = (GAS unsigned long long*)(hb + (size_t)m * DM) + lane_; GAS unsigned long long* l8 = (GAS unsigned long long*)(hl + (size_t)m * DM) + lane_;
#pragma unroll
        for (int j = 0; j < 8; ++j) { const unsigned h0 = pk2(v[j].x, v[j].y), h1 = pk2(v[j].z, v[j].w);
            o8[64 * j] = (unsigned long long)h0 | ((unsigned long long)h1 << 32);
            if (RESID_LO == 1) l8[64 * j] = (unsigned long long)pk2(v[j].x - pg8::bf_lo(h0), v[j].y - pg8::bf_hi(h0)) | ((unsigned long long)pk2(v[j].z - pg8::bf_lo(h1), v[j].w - pg8::bf_hi(h1)) << 32);
            if (RESID_LO == 2) { int w = __builtin_amdgcn_cvt_pk_fp8_f32((v[j].x - pg8::bf_lo(h0)) * 512.0f, (v[j].y - pg8::bf_hi(h0)) * 512.0f, 0, false);
                w = __builtin_amdgcn_cvt_pk_fp8_f32((v[j].z - pg8::bf_lo(h1)) * 512.0f, (v[j].w - pg8::bf_hi(h1)) * 512.0f, w, true);
                *(GAS unsigned*)((unsigned char*)hl + (size_t)m * DM + lo_perm(4 * (lane_ + 64 * j))) = (unsigned)w; } }
        if (lane_ < 32) ssq[(size_t)m * 32 + lane_] = lane_ == 0 ? s : 0.f;
    }
}
__device__ __forceinline__ void final_norm(Frame& F, const Args& a) {
    const int gw = F.vcu * NWAVES + F.wave, NGW = F.G * NWAVES;
    const bf16* hb = (const bf16*)(a.ws + WS_HB); const bf16* hl = (const bf16*)(a.ws + WS_H); const float* ssq = (const float*)(a.ws + WS_SSQ); const float* g = a.in[13];
    int lane_ = threadIdx.x; asm volatile("" : "+v"(lane_)); lane_ &= 63;
    f32x4 gv[8];
#pragma unroll
    for (int j = 0; j < 8; ++j) gv[j] = ((const GAS f32x4*)g)[lane_ + 64 * j];
    for (int m = gw; m < M; m += NGW) {
        float s = lane_ < 32 ? ssq[(size_t)m * 32 + lane_] : 0.f; s = wave_sum(s);
        const float rs = __builtin_amdgcn_rsqf(s * (1.0f / DM) + RMS_EPS);
        const GAS unsigned long long* hr = (const GAS unsigned long long*)(hb + (size_t)m * DM) + lane_; const GAS unsigned long long* lr = (const GAS unsigned long long*)(hl + (size_t)m * DM) + lane_;
        GAS f32x4* orow = (GAS f32x4*)(a.out + (size_t)m * DM) + lane_;
#pragma unroll
        for (int j = 0; j < 8; ++j) { const unsigned long long hw = hr[64 * j]; const unsigned h0 = (unsigned)hw, h1 = (unsigned)(hw >> 32);
            f32x4 hv = {pg8::bf_lo(h0), pg8::bf_hi(h0), pg8::bf_lo(h1), pg8::bf_hi(h1)};
            if (RESID_LO == 1) { const unsigned long long lw = lr[64 * j]; const unsigned l0 = (unsigned)lw, l1 = (unsigned)(lw >> 32); hv += (f32x4){pg8::bf_lo(l0), pg8::bf_hi(l0), pg8::bf_lo(l1), pg8::bf_hi(l1)}; }
            if (RESID_LO == 2) { typedef float f32x2v __attribute__((ext_vector_type(2))); const int w = (int)*(const GAS unsigned*)((const unsigned char*)hl + (size_t)m * DM + lo_perm(4 * (lane_ + 64 * j)));
                const f32x2v a = __builtin_amdgcn_cvt_pk_f32_fp8(w, false), b = __builtin_amdgcn_cvt_pk_f32_fp8(w, true); hv += (f32x4){a.x, a.y, b.x, b.y} * (1.0f / 512.0f); }
            orow[64 * j] = hv * rs * gv[j]; }
    }
}

#ifndef KN_ALIGN
#define KN_ALIGN true
#endif
#ifndef KN_SP2
#define KN_SP2 true
#endif
#ifndef MK_PER_PHASE
#define MK_PER_PHASE 0
#endif
constexpr size_t WS_DUMMY = 960 * MiB;
constexpr int N_PHASES = 38;
__global__ void __launch_bounds__(NWAVES * 64, 2) mega_fwd(Args args) {
    extern __shared__ __attribute__((aligned(16))) unsigned char lds[];
    Frame F;
    F.lds = (LAS unsigned char*)lds;
    F.MISC = (volatile LAS unsigned*)(F.lds + LDSCTL_OFF);
    F.tid = threadIdx.x; F.lane = F.tid & 63; F.wave = __builtin_amdgcn_readfirstlane(F.tid >> 6);
    F.G = gridDim.x; { const int bx = blockIdx.x; F.vcu = (F.G % 8 == 0) ? (bx % 8) * (F.G / 8) + bx / 8 : bx; }
    unsigned char* ws = args.ws;
    F.ctl = (gu32*)(ws + WS_CTL);
    for (int u = F.tid; u < 256; u += NWAVES * 64) ((LAS unsigned*)(F.lds + LDSCTL_OFF))[u] = 0u;
    __syncthreads();
#if MK_PER_PHASE
#define GRID_BAR() do { } while (0)
#else
    XcdBarrier bar = xcd_barrier_post((unsigned*)(F.ctl + CW_BAR), F.MISC + 8);
    int bar_cls = 0;
#ifndef PROBE_BLK
#define PROBE_BLK 0
#endif
#ifndef PROBE_CLS
#define PROBE_CLS -1
#endif
#define GRID_BAR() do { unsigned long long t0_ = 0; if (PROBE_DUP == 13 && blockIdx.x == PROBE_BLK && F.tid == 0) t0_ = __builtin_amdgcn_s_memrealtime(); xcd_barrier(bar); if (PROBE_DUP == 12) xcd_barrier(bar); \
    if (PROBE_DUP == 13 && blockIdx.x == PROBE_BLK && F.tid == 0 && (PROBE_CLS < 0 || PROBE_CLS == bar_cls)) { volatile unsigned long long* pw = (volatile unsigned long long*)(ws + WS_CTL + 8192); *pw = *pw + (__builtin_amdgcn_s_memrealtime() - t0_); } } while (0)
#endif
#if MK_PER_PHASE || CONV_NBW == 0
#define GRID_BARC() GRID_BAR()
#else
    int bidx = 0;
#define GRID_BARC() do { const int bo_ = CONV_UP + bar_off(bidx); ++bidx; \
    xcd_barrier_side(bar, F.wave, [&]() { if (F.wave <= CONV_NBW) for (int j_ = F.vcu * CONV_NBW + F.wave - 1; j_ < CONV_NB; j_ += F.G * CONV_NBW) { const int it_ = bo_ + j_; if (it_ < CONV_TOTAL) conv_one(F, args, it_); } }); } while (0)
#endif
    const int lo = args.ph_lo, hi = args.ph_hi;
#define IN(k) (lo <= (k) && (k) < hi)
#define BOTH(k) (IN(k) && (k) + 1 < hi)

    bf16* HL = (bf16*)(ws + WS_H); bf16* HB = (bf16*)(ws + WS_HB); float* SSQ = (float*)(ws + WS_SSQ);
    bf16* QB = (bf16*)(ws + WS_Q); bf16* KB = (bf16*)(ws + WS_K); bf16* VB = (bf16*)(ws + WS_V); bf16* MIX = (bf16*)(ws + WS_MIX); bf16* ACT = (bf16*)(ws + WS_ACT);

    if (IN(0)) { p0_prologue(F, args); if (PROBE_DUP == 1) { GRID_BAR(); p0_prologue(F, args); } if (BOTH(0)) GRID_BARC(); }
    int cid = (int)blockIdx.x;
#if !MK_PER_PHASE
    if (lo == 0 && hi > 1) {
        if (F.tid == 0) { bool ok = (F.G % 8) == 0;
            for (unsigned j = 0; j < 16; ++j) { const unsigned cnt = xb_ld((unsigned*)(F.ctl + CW_BAR) + XB_XCNT(j)); ok = ok && (cnt == (j < 8 ? (unsigned)F.G / 8u : 0u)); }
            F.MISC[12] = ok ? (F.MISC[10] * 8u + F.MISC[11]) : (unsigned)blockIdx.x; }
        __syncthreads();
        cid = __builtin_amdgcn_readfirstlane((int)F.MISC[12]);
    }
#endif
    const int vcid = (F.G % 8 == 0) ? (cid % 8) * (F.G / 8) + cid / 8 : cid;

#pragma unroll 1
    for (int s = 0; s < 12; ++s) {
        const int layer = s / 3, kind = s - 3 * layer, pb = 1 + 3 * s;
        int ltid = threadIdx.x; asm volatile("" : "+v"(ltid));
        unsigned long long pc0 = 0, pr0 = 0;
        if (PROBE_DUP == 11 && s == 3 && blockIdx.x == 0 && F.tid == 0) { pc0 = __builtin_amdgcn_s_memtime(); pr0 = __builtin_amdgcn_s_memrealtime(); }
        if (IN(pb)) {
          for (int rep = 0; rep < (((PROBE_DUP == 4 && kind != 1) || (PROBE_DUP == 6 && kind == 1)) ? 2 : 1); ++rep) {
            if (rep) GRID_BAR();
            asm volatile("" : "+v"(ltid));
            int pm0 = -1; const PG8_LAS float* stab = (const PG8_LAS float*)(F.lds + SCALE_OFF);
            { pg8::StaticOrder S0; S0.init(M, kind != 1 ? 2 * FF : (layer < 3 ? 3 * DM : DM), F.G, cid); pg8::Unit u0;
              if (S0.next(0, u0)) { pm0 = u0.pm;
                if (ltid < 256) { const f32x4* p = (const f32x4*)(SSQ + (size_t)(pm0 * 256 + ltid) * 32); float a = 0.f;
#pragma unroll
                    for (int q = 0; q < 8; ++q) { const f32x4 v = p[q]; a += (v[0] + v[1]) + (v[2] + v[3]); }
                    ((PG8_LAS float*)(F.lds + SCALE_OFF))[ltid] = __builtin_amdgcn_rsqf(a * (1.0f / DM) + RMS_EPS); } }
              __syncthreads(); }
            if (kind != 1) {
                const int f = 2 * layer + (kind >> 1);
                pg8::Gemm g{HB, w_gu(ws, f), M, 2 * FF, DM}; pg8::StaticOrder S; S.init(M, 2 * FF, F.G, cid);
                pg8::EpiSwiglu E{ACT, FF, SSQ, stab, pm0};
                const int nu = (M / 256) * (2 * FF / 256), rem = nu % F.G, c = cid;
                const int lo_it = CONV_UP + (CONV_NB + (f >> 1) * (7 * CONV_NB + 2 * CONV_CAP) + ((f & 1) ? CONV_CAP + 5 * CONV_NB : 0)), hi_it = (lo_it + CONV_CAP) < CONV_TOTAL ? (lo_it + CONV_CAP) : CONV_TOTAL;
                const bool cv = CONV_CAP > 0 && lo_it < hi_it && (rem == 0 || c >= rem); const int crank = rem == 0 ? c : c - rem, cn = rem == 0 ? F.G : F.G - rem;
                pg8::gemm_phase<pg8::EpiSwiglu, pg8::StaticOrder, KN_ALIGN, KN_SP2>(F.lds + RING_OFF, g, S, E, ltid);
                if (cv) conv_items(F, args, lo_it, hi_it, crank, cn);
            } else {
                const int N = layer < 3 ? 3 * DM : DM;
                pg8::Gemm g{HB, w_mix1(ws, layer), M, N, DM}; pg8::StaticOrder S; S.init(M, N, F.G, cid);
                pg8::EpiScaleBf16 E{QB, (size_t)(WS_K - WS_Q) / 2, SSQ, stab, pm0};
                pg8::gemm_phase<pg8::EpiScaleBf16, pg8::StaticOrder, KN_ALIGN, KN_SP2>(F.lds + RING_OFF, g, S, E, ltid);
            }
          }
            if (PROBE_DUP == 11 && s == 3 && blockIdx.x == 0 && F.tid == 0) {
                const unsigned long long cyc = __builtin_amdgcn_s_memtime() - pc0, rt = __builtin_amdgcn_s_memrealtime() - pr0;
                const unsigned long long delay = cyc * 10000ull / (rt ? rt : 1ull);
                const unsigned long long t0 = __builtin_amdgcn_s_memrealtime(); while (__builtin_amdgcn_s_memrealtime() - t0 < delay) __builtin_amdgcn_s_sleep(8);
            }
            bar_cls = kind != 1 ? 1 : 3; if (BOTH(pb)) GRID_BARC();
        }
        if (kind == 1 && IN(pb + 1)) {
          for (int rep = 0; rep < (((PROBE_DUP == 2 && layer < 2) || (PROBE_DUP == 3 && layer >= 2)) ? 2 : 1); ++rep) {
            if (rep) GRID_BAR();
            for (int p = vcid; p < 256; p += F.G) {
                const int bh = p >> 2, j = p & 3, b = bh >> 4, h = bh & 15;
                if (layer < 2) {
#pragma unroll 1
                    for (int uu = 0; uu < 2; ++uu) { asm volatile("" : "+v"(ltid)); att::stick_unit(QB, KB, VB, MIX, b, h, uu == 0 ? 7 - j : j, (char*)lds + RING_OFF, ltid); }
                } else { const float* bias = args.in[12] + ((size_t)(layer - 2) * NH + h) * 513;
#pragma unroll 1
                    for (int uu = 0; uu < 2; ++uu) { asm volatile("" : "+v"(ltid)); att::band_unit(QB, KB, VB, MIX, bias, b, h, uu == 0 ? 7 - j : j, (char*)lds + RING_OFF, ltid); }
                }
            }
          }
            bar_cls = 4; if (BOTH(pb + 1)) GRID_BARC();
        }
        if (IN(pb + 2)) {
            const bool ffn = kind != 1; const int f = 2 * layer + (kind >> 1);
            pg8::Gemm g{ffn ? ACT : MIX, ffn ? w_dn(ws, f) : w_mixo(ws, layer), M, DM, ffn ? FF : DM}; pg8::StaticOrder S; S.init(M, DM, F.G, cid);
          for (int rep = (((PROBE_DUP == 5 && ffn) || (PROBE_DUP == 7 && !ffn)) ? 0 : 1); rep < 2; ++rep) {
            const bool dummy = rep == 0;
            asm volatile("" : "+v"(ltid));
            pg8::EpiResid E{HB, HL, dummy ? (bf16*)(ws + WS_DUMMY + 64 * MiB) : HB, dummy ? (bf16*)(ws + WS_DUMMY) : HL, dummy ? (float*)(ws + WS_DUMMY + 96 * MiB) : SSQ, ffn ? 0.5f : 1.0f};
#if PROBE_DUP == 9
            pg8::EpiResid Ed{HB, HL, (bf16*)(ws + WS_DUMMY + 64 * MiB), (bf16*)(ws + WS_DUMMY), (float*)(ws + WS_DUMMY + 96 * MiB), ffn ? 0.5f : 1.0f};
            pg8::EpiTwice<pg8::EpiResid> E2{Ed, E};
            pg8::gemm_phase<pg8::EpiTwice<pg8::EpiResid>, pg8::StaticOrder, KN_ALIGN, KN_SP2>(F.lds + RING_OFF, g, S, E2, ltid);
#else
            pg8::gemm_phase<pg8::EpiResid, pg8::StaticOrder, KN_ALIGN, KN_SP2>(F.lds + RING_OFF, g, S, E, ltid);
#endif
            if (dummy) GRID_BAR();
          }
            bar_cls = ffn ? 2 : 5; if (BOTH(pb + 2)) GRID_BARC();
        }
    }
    if (PROBE_DUP == 13 && blockIdx.x == PROBE_BLK && F.tid == 0) { const unsigned long long bw_acc = *(volatile unsigned long long*)(ws + WS_CTL + 8192); const unsigned long long t0 = __builtin_amdgcn_s_memrealtime(); while (__builtin_amdgcn_s_memrealtime() - t0 < bw_acc) __builtin_amdgcn_s_sleep(8); }
    if (IN(37)) { final_norm(F, args); if (PROBE_DUP == 8) { GRID_BAR(); final_norm(F, args); } }
#undef IN
#undef BOTH
}

extern "C" void kernel_launch(void* const* d_in, const int* in_sizes, int n_in, void* d_out, int out_size, void* d_ws, size_t ws_size, hipStream_t stream) {
    static int grid = 0;
    if (grid == 0) {
        if (n_in != 14 || in_sizes[0] != M * DM || out_size != M * DM || ws_size < WS_END) { fprintf(stderr, "kernel_launch: shape mismatch: n_in %d in0 %d out %d ws %zu (need %zu)\n", n_in, n_in > 0 ? in_sizes[0] : -1, out_size, ws_size, (size_t)WS_END); grid = -1; return; }
        int dev = 0, cus = 0, per_cu = 0;
        if (hipGetDevice(&dev) != hipSuccess || hipDeviceGetAttribute(&cus, hipDeviceAttributeMultiprocessorCount, dev) != hipSuccess) { fprintf(stderr, "kernel_launch: device query failed\n"); grid = -1; return; }
        if (hipFuncSetAttribute((const void*)mega_fwd, hipFuncAttributeMaxDynamicSharedMemorySize, LDS_BYTES) != hipSuccess) { fprintf(stderr, "kernel_launch: hipFuncSetAttribute failed\n"); grid = -1; return; }
        if (hipOccupancyMaxActiveBlocksPerMultiprocessor(&per_cu, (const void*)mega_fwd, NWAVES * 64, LDS_BYTES) != hipSuccess || per_cu < 1) { fprintf(stderr, "kernel_launch: occupancy query reports %d workgroups per CU\n", per_cu); (void)hipGetLastError(); grid = -1; return; }
        grid = cus;
    }
    if (grid < 0) return;
    if (hipMemsetAsync((char*)d_ws + WS_CTL, 0, CTL_ZERO_BYTES, stream) != hipSuccess) { fprintf(stderr, "kernel_launch: hipMemsetAsync failed\n"); return; }
    Args a{};
    for (int i = 0; i < 14; ++i) a.in[i] = (const float*)d_in[i];
    a.out = (float*)d_out; a.ws = (unsigned char*)d_ws;
#if MK_PER_PHASE
    for (int ph = 0; ph < N_PHASES; ++ph) {
        if (ph >= 1 && ph <= 36) { const int s = (ph - 1) / 3, j = (ph - 1) % 3; if (j == 1 && (s % 3) != 1) continue; }
        a.ph_lo = ph; a.ph_hi = ph + 1;
        hipLaunchKernelGGL(mega_fwd, dim3(grid), dim3(NWAVES * 64), LDS_BYTES, stream, a);
    }
#else
    a.ph_lo = 0; a.ph_hi = N_PHASES;
    hipLaunchKernelGGL(mega_fwd, dim3(grid), dim3(NWAVES * 64), LDS_BYTES, stream, a);
#endif
    const hipError_t le = hipPeekAtLastError();
    if (le != hipSuccess) fprintf(stderr, "kernel_launch: launch failed: %s (grid %d)\n", hipGetErrorName(le), grid);
}
```

```cpp
#include <hip/hip_runtime.h>
#include <cstdio>
#include <cstdint>
#ifndef PROBE_DUP
#define PROBE_DUP 0
#endif
namespace pg8 {
#define PG8_LAS __attribute__((address_space(3)))
typedef unsigned short bf16_t;
typedef short bf16x8 __attribute__((ext_vector_type(8)));
typedef float f32x4 __attribute__((ext_vector_type(4)));
typedef unsigned u32x4 __attribute__((ext_vector_type(4)));
constexpr int BM = 256, BK = 64, HALF = 128, HTB = HALF * BK * 2  , STAGE_BYTES = 8 * HTB, NXCD = 8, WGM = 8;

__host__ __device__ __forceinline__ int lds_byte(int r, int c) { const int st = (r >> 4) * 2 + (c >> 5), rr = r & 15, cc = c & 31, ob = rr * 64 + cc * 2; return st * 1024 + (ob ^ (((ob >> 9) & 1) << 5)); }
__host__ __device__ __forceinline__ void stage_rc(int b, int& R, int& C) { const int st = b / 1024, sb = b % 1024, swz = sb ^ (((sb >> 9) & 1) << 5); R = (st >> 1) * 16 + swz / 64; C = (st & 1) * 32 + (swz % 64) / 2; }
__host__ __device__ __forceinline__ int perm32(int rho) { const int n = rho >> 4, i = rho & 15; return 8 * (i >> 2) + 4 * n + (i & 3); }

struct Unit { int pm, pn; };
struct Gemm { const bf16_t* A; const bf16_t* Bt; int M, N, K; };

struct StaticOrder {
    int nM, nN, nwg, G, c;
    __host__ __device__ void init(int M, int N, int G_, int c_) { nM = M / BM; nN = N / BM; nwg = nM * nN; G = G_; c = c_; }
    __host__ __device__ bool next(int i, Unit& u) const {
        const long L = (long)i * G + c; if (L >= nwg) return false;
        int wgid = (int)L; { const int q = nwg / NXCD, r = nwg % NXCD, xcd = wgid % NXCD, off = wgid / NXCD; wgid = (xcd < r ? xcd * (q + 1) : r * (q + 1) + (xcd - r) * q) + off; }
        const int nig = WGM * nN, gid = wgid / nig, fm = gid * WGM, gsz = (nM - fm) < WGM ? (nM - fm) : WGM;
        u.pm = fm + ((wgid % nig) % gsz); u.pn = (wgid % nig) / gsz; return true;
    }
    __device__ __forceinline__ void a_ready(const Unit&) const {}
    __device__ __forceinline__ void done(const Unit&) const {}
};

typedef float f32x2c __attribute__((ext_vector_type(2))); typedef __bf16 bf16x2c __attribute__((ext_vector_type(2)));
__device__ __forceinline__ unsigned cvt_pk_bf16(float lo, float hi) { const f32x2c v = {lo, hi}; const bf16x2c b = __builtin_convertvector(v, bf16x2c); return __builtin_bit_cast(unsigned, b); }
typedef float f32x2 __attribute__((ext_vector_type(2)));
__device__ __forceinline__ float row_scale(const float* ssq, int row, int fq) {
    const f32x4* p = (const f32x4*)(ssq + (size_t)row * 32 + fq * 8);
    const f32x4 a = p[0], b = p[1];
    float s = ((a[0] + a[1]) + (a[2] + a[3])) + ((b[0] + b[1]) + (b[2] + b[3]));
    s += __shfl_xor(s, 16); s += __shfl_xor(s, 32);
    return __builtin_amdgcn_rsqf(s * (1.0f / 2048.0f) + 1e-6f);
}
struct EpiSwiglu {
    static constexpr bool PERM = true, AFTER_DRAIN = false;
    bf16_t* O; int ldc; const float* ssq; const PG8_LAS float* tab; int pm0;
    __device__ __forceinline__ void operator()(const f32x4 (&acc)[2][2][4][2], const Unit& u, int wr, int wc, int fr, int fq) const {
        const int row0 = u.pm * BM + wr * 64 + fr, col0 = u.pn * HALF + wc * 32 + 8 * fq;
        float sc[8];
        if (u.pm == pm0) {
#pragma unroll
            for (int q = 0; q < 8; ++q) sc[q] = tab[wr * 64 + fr + (q >> 2) * HALF + (q & 3) * 16];
        } else {
#pragma unroll
            for (int q = 0; q < 8; ++q) sc[q] = row_scale(ssq, row0 + (q >> 2) * HALF + (q & 3) * 16, fq);
        }
#pragma unroll
        for (int ai = 0; ai < 2; ++ai)
#pragma unroll
            for (int m = 0; m < 4; ++m) {
                const int row = row0 + ai * HALF + m * 16; const float s = sc[ai * 4 + m];
                const float k = s * -1.4426950408889634f, s2 = s * s;
                float o[8];
#pragma unroll
                for (int n = 0; n < 2; ++n)
#pragma unroll
                    for (int i = 0; i < 4; ++i) { const float g = acc[ai][0][m][n][i], up = acc[ai][1][m][n][i];
                        const float r = __builtin_amdgcn_rcpf(1.0f + __builtin_amdgcn_exp2f(g * k));
                        o[n * 4 + i] = (g * up) * (r * s2); }
                u32x4 w; w.x = cvt_pk_bf16(o[0], o[1]); w.y = cvt_pk_bf16(o[2], o[3]); w.z = cvt_pk_bf16(o[4], o[5]); w.w = cvt_pk_bf16(o[6], o[7]);
                *(u32x4*)(O + (size_t)row * ldc + col0) = w; }
    }
};
struct EpiScaleBf16 {
    static constexpr bool PERM = true, AFTER_DRAIN = false;
    bf16_t* O; size_t split_stride; const float* ssq; const PG8_LAS float* tab; int pm0;
    __device__ __forceinline__ void operator()(const f32x4 (&acc)[2][2][4][2], const Unit& u, int wr, int wc, int fr, int fq) const {
        const int row0 = u.pm * BM + wr * 64 + fr; const int t = u.pn >> 3;
        float sc[8];
        if (u.pm == pm0) {
#pragma unroll
            for (int q = 0; q < 8; ++q) sc[q] = tab[wr * 64 + fr + (q >> 2) * HALF + (q & 3) * 16];
        } else {
#pragma unroll
            for (int q = 0; q < 8; ++q) sc[q] = row_scale(ssq, row0 + (q >> 2) * HALF + (q & 3) * 16, fq);
        } bf16_t* base = O + (size_t)t * split_stride;
        const int col0 = (u.pn & 7) * BM + wc * 32 + 8 * fq;
#pragma unroll
        for (int ai = 0; ai < 2; ++ai)
#pragma unroll
            for (int m = 0; m < 4; ++m) {
                const int row = row0 + ai * HALF + m * 16; const float s = sc[ai * 4 + m];
                bf16_t* rowp = base + (size_t)row * 2048 + col0;
#pragma unroll
                for (int bj = 0; bj < 2; ++bj) { const f32x4 v0 = acc[ai][bj][m][0] * s, v1 = acc[ai][bj][m][1] * s;
                    u32x4 w; w.x = cvt_pk_bf16(v0[0], v0[1]); w.y = cvt_pk_bf16(v0[2], v0[3]); w.z = cvt_pk_bf16(v1[0], v1[1]); w.w = cvt_pk_bf16(v1[2], v1[3]);
                    *(u32x4*)(rowp + bj * HALF) = w; } }
    }
};
#ifndef RESID_LO
#define RESID_LO 0
#endif
__device__ __forceinline__ float bf_lo(unsigned w) { return __uint_as_float(w << 16); }
__device__ __forceinline__ float bf_hi(unsigned w) { return __uint_as_float(w & 0xffff0000u); }
struct EpiResid {
    static constexpr bool PERM = true, AFTER_DRAIN = false;
    const bf16_t* bhi; const void* blo; bf16_t* ohi; void* olo; float* ssq; float coef;
    __device__ __forceinline__ void operator()(const f32x4 (&acc)[2][2][4][2], const Unit& u, int wr, int wc, int fr, int fq) const {
        typedef unsigned u32x2v __attribute__((ext_vector_type(2))); typedef float f32x2v __attribute__((ext_vector_type(2)));
        const int row0 = u.pm * BM + wr * 64 + fr, col0 = u.pn * BM + wc * 32 + 8 * fq;
        float ssr[8];
#if RESID_LO == 2
        const char* hb = (const char*)bhi; const char* lb = (const char*)blo; char* ho = (char*)ohi; char* lo_ = (char*)olo;
        const unsigned hoff0 = ((unsigned)row0 * 2048u + (unsigned)col0) * 2u, loff0 = (unsigned)row0 * 2048u + (unsigned)(u.pn * BM + wc * 64 + fq * 16);
        const float c512 = 512.0f, i512 = 1.0f / 512.0f;
#pragma unroll
        for (int ai = 0; ai < 2; ++ai)
#pragma unroll
            for (int m = 0; m < 4; ++m) {
                const unsigned rofs = (unsigned)(ai * HALF + m * 16) * 2048u;
                const u32x4 h0 = *(const u32x4*)(hb + hoff0 + rofs * 2u), h1 = *(const u32x4*)(hb + hoff0 + rofs * 2u + HALF * 2), l16 = *(const u32x4*)(lb + loff0 + rofs);
                unsigned wh[8], wl[4] = {0u, 0u, 0u, 0u}; float ss = 0.f;
#pragma unroll
                for (int bj = 0; bj < 2; ++bj)
#pragma unroll
                    for (int j = 0; j < 4; ++j) { const unsigned hw = bj ? h1[j] : h0[j]; const unsigned lw = l16[2 * bj + (j >> 1)];
                        const f32x2v lf = (j & 1) ? __builtin_amdgcn_cvt_pk_f32_fp8((int)lw, true) : __builtin_amdgcn_cvt_pk_f32_fp8((int)lw, false);
                        const float a0 = acc[ai][bj][m][j >> 1][(2 * j) & 3], a1 = acc[ai][bj][m][j >> 1][(2 * j + 1) & 3];
                        const float o0 = __builtin_fmaf(a0, coef, __builtin_fmaf(lf.x, i512, bf_lo(hw))), o1 = __builtin_fmaf(a1, coef, __builtin_fmaf(lf.y, i512, bf_hi(hw)));
                        const unsigned nh = cvt_pk_bf16(o0, o1); wh[4 * bj + j] = nh;
                        const float r0 = (o0 - bf_lo(nh)) * c512, r1 = (o1 - bf_hi(nh)) * c512;
                        wl[2 * bj + (j >> 1)] = (j & 1) ? (unsigned)__builtin_amdgcn_cvt_pk_fp8_f32(r0, r1, (int)wl[2 * bj + (j >> 1)], true) : (unsigned)__builtin_amdgcn_cvt_pk_fp8_f32(r0, r1, (int)wl[2 * bj + (j >> 1)], false);
                        ss = __builtin_fmaf(o0, o0, ss); ss = __builtin_fmaf(o1, o1, ss); }
                *(u32x4*)(ho + hoff0 + rofs * 2u) = (u32x4){wh[0], wh[1], wh[2], wh[3]}; *(u32x4*)(ho + hoff0 + rofs * 2u + HALF * 2) = (u32x4){wh[4], wh[5], wh[6], wh[7]};
                *(u32x4*)(lo_ + loff0 + rofs) = (u32x4){wl[0], wl[1], wl[2], wl[3]};
                ss += __shfl_xor(ss, 16); ss += __shfl_xor(ss, 32); ssr[ai * 4 + m] = ss;
                if (m == 3) asm volatile("" ::: "memory");
            }
#else
#pragma unroll
        for (int ai = 0; ai < 2; ++ai)
#pragma unroll
            for (int m = 0; m < 4; ++m) {
                const int q = ai * 4 + m; const int row = row0 + ai * HALF + m * 16; const size_t off = (size_t)row * 2048 + col0; float ss = 0.f;
                u32x4 hvq[2], lvq[2]; u32x2v l8q[2];
#pragma unroll
                for (int bj = 0; bj < 2; ++bj) { hvq[bj] = *(const u32x4*)(bhi + off + bj * HALF);
                    if (RESID_LO == 1) lvq[bj] = *(const u32x4*)((const bf16_t*)blo + off + bj * HALF);
                }
                if (RESID_LO == 2) { const u32x4 l16 = *(const u32x4*)((const unsigned char*)blo + (size_t)row * 2048 + u.pn * BM + wc * 64 + fq * 16);
                    l8q[0] = (u32x2v){l16[0], l16[1]}; l8q[1] = (u32x2v){l16[2], l16[3]}; }
                u32x4 w16 = {0u, 0u, 0u, 0u};
#pragma unroll
                for (int bj = 0; bj < 2; ++bj) { float o[8]; u32x4 wh, wl; u32x2v w8 = {0u, 0u};
#pragma unroll
                    for (int j = 0; j < 4; ++j) { const unsigned hw = hvq[bj][j]; float b0 = bf_lo(hw), b1 = bf_hi(hw);
                        if (RESID_LO == 1) { const unsigned lw = lvq[bj][j]; b0 += bf_lo(lw); b1 += bf_hi(lw); }
                        if (RESID_LO == 2) { const f32x2v lf = (j & 1) ? __builtin_amdgcn_cvt_pk_f32_fp8((int)l8q[bj][j >> 1], true) : __builtin_amdgcn_cvt_pk_f32_fp8((int)l8q[bj][j >> 1], false);
                            b0 += lf.x * (1.0f / 512.0f); b1 += lf.y * (1.0f / 512.0f); }
                        o[2 * j] = b0 + acc[ai][bj][m][j >> 1][(2 * j) & 3] * coef; o[2 * j + 1] = b1 + acc[ai][bj][m][j >> 1][(2 * j + 1) & 3] * coef;
                        const unsigned nh = cvt_pk_bf16(o[2 * j], o[2 * j + 1]); wh[j] = nh;
                        if (RESID_LO == 1) wl[j] = cvt_pk_bf16(o[2 * j] - bf_lo(nh), o[2 * j + 1] - bf_hi(nh));
                        if (RESID_LO == 2) { const float r0 = (o[2 * j] - bf_lo(nh)) * 512.0f, r1 = (o[2 * j + 1] - bf_hi(nh)) * 512.0f;
                            w8[j >> 1] = (j & 1) ? (unsigned)__builtin_amdgcn_cvt_pk_fp8_f32(r0, r1, (int)w8[j >> 1], true) : (unsigned)__builtin_amdgcn_cvt_pk_fp8_f32(r0, r1, (int)w8[j >> 1], false); }
                        ss += o[2 * j] * o[2 * j] + o[2 * j + 1] * o[2 * j + 1]; }
                    *(u32x4*)(ohi + off + bj * HALF) = wh;
                    if (RESID_LO == 1) *(u32x4*)((bf16_t*)olo + off + bj * HALF) = wl;
                    if (RESID_LO == 2) { w16[2 * bj] = w8[0]; w16[2 * bj + 1] = w8[1]; } }
                if (RESID_LO == 2) *(u32x4*)((unsigned char*)olo + (size_t)row * 2048 + u.pn * BM + wc * 64 + fq * 16) = w16;
                ss += __shfl_xor(ss, 16); ss += __shfl_xor(ss, 32); ssr[q] = ss;
                if (m == 3) asm volatile("" ::: "memory");
            }
#endif
        { const float v0 = fq == 0 ? ssr[0] : fq == 1 ? ssr[2] : fq == 2 ? ssr[4] : ssr[6], v1 = fq == 0 ? ssr[1] : fq == 1 ? ssr[3] : fq == 2 ? ssr[5] : ssr[7];
          float* p = ssq + (size_t)(row0 + (fq >> 1) * HALF + (fq & 1) * 32) * 32 + u.pn * 4 + wc; p[0] = v0; p[16 * 32] = v1; }
    }
};

template <class E1> struct EpiTwice {
    static constexpr bool PERM = E1::PERM, AFTER_DRAIN = false;
    E1 a, b;
    __device__ __forceinline__ void operator()(const f32x4 (&acc)[2][2][4][2], const Unit& u, int wr, int wc, int fr, int fq) const { a(acc, u, wr, wc, fr, fq); asm volatile("" ::: "memory"); b(acc, u, wr, wc, fr, fq); }
};
template <class Epi, class Sched, bool ALIGN_EPI = false, bool SP2 = false>
__device__ __forceinline__ void gemm_phase(PG8_LAS unsigned char* lds, const Gemm g, const Sched& S, const Epi& E, const int tid) {
    const int wid = __builtin_amdgcn_readfirstlane(tid >> 6), lane = tid & 63, wr = wid >> 2, wc = wid & 3, fr = lane & 15, fq = lane >> 4;
    const int K = g.K, nt = K / BK;
    unsigned voffA[2], voffB[2];
#pragma unroll
    for (int i = 0; i < 2; ++i) { int R, C; stage_rc(tid * 16 + i * 8192, R, C); const int Rb = Epi::PERM ? ((R & ~31) + perm32(R & 31)) : R;
        voffA[i] = (unsigned)(R * K + C) * 2u; voffB[i] = (unsigned)(Rb * K + C) * 2u; }
    const size_t kstep = (size_t)(BK * 2);
    const size_t hstep = (size_t)HALF * K * 2;
    const size_t tstep = 2 * hstep;
    const unsigned ldsw = (unsigned)wid * 1024u;
    const int aoff = lds_byte(wr * 64 + fr, fq * 8), boff = lds_byte(wc * 32 + fr, fq * 8);
#define PG8_SA(b, h) (((b) * 2 + (h)) * HTB)
#define PG8_SB(b, h) ((4 + (b) * 2 + (h)) * HTB)
#define PG8_STAGE(bufoff, gbase, voff) do { _Pragma("unroll") for (int _i = 0; _i < 2; ++_i) \
        __builtin_amdgcn_global_load_lds((const unsigned*)((const char*)(gbase) + (voff)[_i]), (PG8_LAS unsigned*)(lds + (bufoff) + ldsw + _i * 8192), 16, 0, 0); } while (0)
#define PG8_LDA(dst, b, h) do { _Pragma("unroll") for (int m = 0; m < 4; ++m) _Pragma("unroll") for (int k = 0; k < 2; ++k) dst[m][k] = *(const PG8_LAS bf16x8*)(lds + PG8_SA(b, h) + aoff + m * 2048 + k * 1024); } while (0)
#define PG8_LDB(dst, b, h) do { _Pragma("unroll") for (int n = 0; n < 2; ++n) _Pragma("unroll") for (int k = 0; k < 2; ++k) dst[n][k] = *(const PG8_LAS bf16x8*)(lds + PG8_SB(b, h) + boff + n * 2048 + k * 1024); } while (0)
#define PG8_MMA(ai, bj, At, Bt) do { __builtin_amdgcn_s_setprio(1); _Pragma("unroll") for (int m = 0; m < 4; ++m) _Pragma("unroll") for (int n = 0; n < 2; ++n) _Pragma("unroll") for (int k = 0; k < 2; ++k) \
        acc[ai][bj][m][n] = __builtin_amdgcn_mfma_f32_16x16x32_bf16(Bt[n][k], At[m][k], acc[ai][bj][m][n], 0, 0, 0); __builtin_amdgcn_s_setprio(0); } while (0)
#define PG8_WAIT_V(n) asm volatile("s_waitcnt vmcnt(" #n ")" ::: "memory")
#define PG8_WAIT_L(n) asm volatile("s_waitcnt lgkmcnt(" #n ")" ::: "memory")
#define PG8_BAR __builtin_amdgcn_s_barrier()
#define PG8_SCHED __builtin_amdgcn_sched_barrier(0)
    Unit cur, nxt; int ui = 0;
    if (!S.next(0, cur)) return;
    f32x4 acc[2][2][4][2];
#pragma unroll
    for (int a = 0; a < 2; ++a)
#pragma unroll
        for (int b = 0; b < 2; ++b)
#pragma unroll
            for (int m = 0; m < 4; ++m)
#pragma unroll
                for (int n = 0; n < 2; ++n) acc[a][b][m][n] = (f32x4){0.f, 0.f, 0.f, 0.f};
    bf16x8 At[4][2], B0[2][2], B1[2][2];
    const char* cA = (const char*)g.A + (size_t)cur.pm * tstep; const char* cB = (const char*)g.Bt + (size_t)cur.pn * tstep;
    S.a_ready(cur);
    if constexpr (SP2) {
        PG8_STAGE(PG8_SB(0, 0), cB, voffB); PG8_STAGE(PG8_SB(0, 1), cB + hstep, voffB); PG8_STAGE(PG8_SA(0, 0), cA, voffA); PG8_STAGE(PG8_SA(0, 1), cA + hstep, voffA);
        if (wr == 1) PG8_BAR;
        PG8_WAIT_V(2); PG8_BAR;
        PG8_STAGE(PG8_SB(1, 0), cB + kstep, voffB); PG8_STAGE(PG8_SA(1, 0), cA + kstep, voffA); PG8_STAGE(PG8_SB(1, 1), cB + hstep + kstep, voffB);
        PG8_WAIT_V(6); PG8_BAR;
    } else {
        PG8_STAGE(PG8_SB(0, 0), cB, voffB); PG8_STAGE(PG8_SA(0, 0), cA, voffA); PG8_STAGE(PG8_SB(0, 1), cB + hstep, voffB); PG8_STAGE(PG8_SA(0, 1), cA + hstep, voffA);
        if (wr == 1) PG8_BAR;
        PG8_WAIT_V(4); PG8_BAR;
        PG8_STAGE(PG8_SB(1, 0), cB + kstep, voffB); PG8_STAGE(PG8_SA(1, 0), cA + kstep, voffA); PG8_STAGE(PG8_SB(1, 1), cB + hstep + kstep, voffB);
        PG8_WAIT_V(6); PG8_BAR;
    }
    for (;;) {
        const bool has_next = S.next(ui + 1, nxt);
        const char* nA = has_next ? (const char*)g.A + (size_t)nxt.pm * tstep : cA; const char* nB = has_next ? (const char*)g.Bt + (size_t)nxt.pn * tstep : cB;
        for (int t = 0; t < nt; t += 2) {
            const bool last = (t == nt - 2);
            const char* a1 = cA + (size_t)(t + 1) * kstep;
            const char* a2 = last ? nA : cA + (size_t)(t + 2) * kstep; const char* b2 = last ? nB : cB + (size_t)(t + 2) * kstep;
            const char* a3 = a2 + kstep; const char* b3 = b2 + kstep;
            if (last && has_next) S.a_ready(nxt);
            if constexpr (SP2) {
            PG8_LDB(B0, 0, 0); PG8_LDB(B1, 0, 1); PG8_SCHED; PG8_LDA(At, 0, 0); PG8_STAGE(PG8_SA(1, 1), a1 + hstep, voffA);
            PG8_WAIT_V(8); PG8_WAIT_L(0); PG8_BAR; PG8_MMA(0, 0, At, B0); PG8_MMA(0, 1, At, B1); PG8_BAR; PG8_SCHED;
            PG8_LDA(At, 0, 1); PG8_STAGE(PG8_SB(0, 0), b2, voffB); PG8_STAGE(PG8_SB(0, 1), b2 + hstep, voffB); PG8_STAGE(PG8_SA(0, 0), a2, voffA);
            PG8_WAIT_V(8); PG8_WAIT_L(0); PG8_BAR; PG8_MMA(1, 0, At, B0); PG8_MMA(1, 1, At, B1); PG8_BAR; PG8_SCHED;
            PG8_LDB(B0, 1, 0); PG8_LDB(B1, 1, 1); PG8_SCHED; PG8_LDA(At, 1, 0); PG8_STAGE(PG8_SA(0, 1), a2 + hstep, voffA);
            PG8_WAIT_V(8); PG8_WAIT_L(0); PG8_BAR; PG8_MMA(0, 0, At, B0); PG8_MMA(0, 1, At, B1); PG8_BAR; PG8_SCHED;
            PG8_LDA(At, 1, 1); PG8_STAGE(PG8_SB(1, 0), b3, voffB); PG8_STAGE(PG8_SB(1, 1), b3 + hstep, voffB); PG8_STAGE(PG8_SA(1, 0), a3, voffA);
            PG8_WAIT_V(8); PG8_WAIT_L(0); PG8_BAR; PG8_MMA(1, 0, At, B0); PG8_MMA(1, 1, At, B1); PG8_BAR; PG8_SCHED;
            } else {
            PG8_LDB(B0, 0, 0); PG8_SCHED; PG8_LDA(At, 0, 0); PG8_STAGE(PG8_SA(1, 1), a1 + hstep, voffA);
            PG8_WAIT_L(8); PG8_BAR; PG8_WAIT_L(0); PG8_MMA(0, 0, At, B0); PG8_BAR; PG8_SCHED;
            PG8_LDB(B1, 0, 1); PG8_STAGE(PG8_SB(0, 0), b2, voffB);
            PG8_BAR; PG8_WAIT_L(0); PG8_MMA(0, 1, At, B1); PG8_BAR;
            PG8_LDA(At, 0, 1); PG8_STAGE(PG8_SA(0, 0), a2, voffA);
            PG8_BAR; PG8_WAIT_L(0); PG8_MMA(1, 0, At, B0); PG8_BAR; PG8_SCHED;
            PG8_STAGE(PG8_SB(0, 1), b2 + hstep, voffB);
            PG8_WAIT_V(6); PG8_BAR; PG8_MMA(1, 1, At, B1); PG8_BAR;
            PG8_LDB(B0, 1, 0); PG8_SCHED; PG8_LDA(At, 1, 0); PG8_STAGE(PG8_SA(0, 1), a2 + hstep, voffA);
            PG8_WAIT_L(8); PG8_BAR; PG8_WAIT_L(0); PG8_MMA(0, 0, At, B0); PG8_BAR; PG8_SCHED;
            PG8_LDB(B1, 1, 1); PG8_STAGE(PG8_SB(1, 0), b3, voffB);
            PG8_BAR; PG8_WAIT_L(0); PG8_MMA(0, 1, At, B1); PG8_BAR;
            PG8_LDA(At, 1, 1); PG8_STAGE(PG8_SA(1, 0), a3, voffA);
            PG8_BAR; PG8_WAIT_L(0); PG8_MMA(1, 0, At, B0); PG8_BAR; PG8_SCHED;
            PG8_STAGE(PG8_SB(1, 1), b3 + hstep, voffB);
            PG8_WAIT_V(6); PG8_BAR; PG8_MMA(1, 1, At, B1); PG8_BAR;
            }
        }
        if constexpr (ALIGN_EPI) { if (wr == 0) PG8_BAR; }
        if constexpr (!Epi::AFTER_DRAIN) { E(acc, cur, wr, wc, fr, fq); S.done(cur); }
        if (!has_next) break;
#pragma unroll
        for (int a = 0; a < 2; ++a)
#pragma unroll
            for (int b = 0; b < 2; ++b)
#pragma unroll
                for (int m = 0; m < 4; ++m)
#pragma unroll
                    for (int n = 0; n < 2; ++n) acc[a][b][m][n] = (f32x4){0.f, 0.f, 0.f, 0.f};
        cur = nxt; cA = nA; cB = nB; ++ui;
        if constexpr (ALIGN_EPI) { if (wr == 1) PG8_BAR; }
    }
    PG8_WAIT_V(0);
    if constexpr (!ALIGN_EPI) { if (wr == 0) PG8_BAR; }
    PG8_BAR;
    if constexpr (Epi::AFTER_DRAIN) { E.fused(acc, cur, wr, wc, fr, fq, lds, wid, lane); S.done(cur); }
#undef PG8_SA
#undef PG8_SB
#undef PG8_STAGE
#undef PG8_LDA
#undef PG8_LDB
#undef PG8_MMA
#undef PG8_WAIT_V
#undef PG8_WAIT_L
#undef PG8_BAR
#undef PG8_SCHED
}
}

#define GAS __attribute__((address_space(1)))
#define LAS __attribute__((address_space(3)))
typedef unsigned short bf16;
typedef unsigned v4u __attribute__((ext_vector_type(4)));
typedef float f32x4 __attribute__((ext_vector_type(4)));
typedef short bf16x8 __attribute__((ext_vector_type(8)));
typedef GAS unsigned gu32;
typedef GAS unsigned long long gu64;
#define RLX_AGENT __ATOMIC_RELAXED, __HIP_MEMORY_SCOPE_AGENT
#define LDS_WAIT() asm volatile("s_waitcnt lgkmcnt(0)" ::: "memory")
#define VM_WAIT() asm volatile("s_waitcnt vmcnt(0)" ::: "memory")
__device__ __forceinline__ unsigned long long rt() { return __builtin_amdgcn_s_memrealtime(); }
__device__ __forceinline__ unsigned f2bf(float f) { unsigned u = __builtin_bit_cast(unsigned, f); return (u + 0x7fffu + ((u >> 16) & 1u)) >> 16; }
__device__ __forceinline__ unsigned pk2(float lo, float hi) { return f2bf(lo) | (f2bf(hi) << 16); }

#define XB_TMO      128
#define XB_XCNT(j)  (256  + 64 * (j))
#define XB_XSUB(j)  (1280 + 64 * (j))
#define XB_XGEN(j)  (2304 + 64 * (j))
#define XB_TOP      3328
#define XB_TOPGEN   3392
#define XCD_BAR_WORDS 3456
#define XB_SPIN_CAP (1u << 18)

__device__ __forceinline__ unsigned xb_ld(unsigned* p)              { return __hip_atomic_load(p, __ATOMIC_RELAXED, __HIP_MEMORY_SCOPE_AGENT); }
__device__ __forceinline__ unsigned xb_add(unsigned* p, unsigned v) { return __hip_atomic_fetch_add(p, v, __ATOMIC_RELAXED, __HIP_MEMORY_SCOPE_AGENT); }
__device__ __forceinline__ unsigned xb_xcc_id() { return (unsigned)__builtin_amdgcn_s_getreg((3 << 11) | 20) & 0xFu; }
#define XB_SPIN(cond, bar) do { unsigned _sp = 0; while (cond) { __builtin_amdgcn_s_sleep(1); \
    if ((++_sp & 255u) == 0u) { if (xb_ld(&(bar)[XB_TMO])) break; if (_sp > XB_SPIN_CAP) { atomicAdd(&(bar)[XB_TMO], 1u); break; } } } } while (0)

struct XcdBarrier {
    unsigned* bar; unsigned x;
    volatile LAS unsigned* st;
};

__device__ __forceinline__ XcdBarrier xcd_barrier_post(unsigned* bar, volatile LAS unsigned* st) {
    XcdBarrier b; b.bar = bar; b.x = xb_xcc_id(); b.st = st;
    if (threadIdx.x == 0) { const unsigned rk = xb_add(&bar[XB_XCNT(b.x)], 1u); st[2] = rk; st[3] = b.x; }
    return b;
}
__device__ __forceinline__ void xcd_barrier_complete(unsigned* bar, unsigned x, unsigned& nloc, unsigned& nx) {
    const unsigned G = gridDim.x * gridDim.y * gridDim.z;
    unsigned sum, cnt, mine, sp = 0u;
    for (;;) {
        sum = 0u; cnt = 0u; mine = 0u;
#pragma unroll
        for (unsigned j = 0; j < 16; ++j) { const unsigned c = xb_ld(&bar[XB_XCNT(j)]); sum += c; cnt += (c > 0u) ? 1u : 0u; mine = (j == x) ? c : mine; }
        if (sum == G) break;
        __builtin_amdgcn_s_sleep(1);
        if ((++sp & 255u) == 0u) { if (xb_ld(&bar[XB_TMO])) break; if (sp > XB_SPIN_CAP) { atomicAdd(&bar[XB_TMO], 1u); break; } }
    }
    nloc = mine > 0u ? mine : 1u; nx = cnt > 0u ? cnt : 1u;
}

__device__ __forceinline__ void xcd_barrier_t0(const XcdBarrier& b) {
        unsigned* bar = b.bar;
        __builtin_amdgcn_s_waitcnt(0);
        unsigned nloc = b.st[0], nx = b.st[1];
        if (nloc == 0u) { xcd_barrier_complete(bar, b.x, nloc, nx); b.st[0] = nloc; b.st[1] = nx; }
        const unsigned old = xb_add(&bar[XB_XSUB(b.x)], 1u);
        const unsigned gen = old / nloc;
        if (old + 1u == (gen + 1u) * nloc) {
            __builtin_amdgcn_fence(__ATOMIC_RELEASE, "agent");
            asm volatile("s_waitcnt vmcnt(0)" ::: "memory");
            const unsigned og = xb_add(&bar[XB_TOP], 1u);
            const unsigned tg = og / nx;
            if (og + 1u == (tg + 1u) * nx) xb_add(&bar[XB_TOPGEN], 1u);
            else XB_SPIN(xb_ld(&bar[XB_TOPGEN]) == tg, bar);
            __builtin_amdgcn_fence(__ATOMIC_ACQUIRE, "agent");
            xb_add(&bar[XB_XGEN(b.x)], 1u);
            asm volatile("s_waitcnt vmcnt(0)" ::: "memory");
        } else {
            XB_SPIN(xb_ld(&bar[XB_XGEN(b.x)]) == gen, bar);
            __builtin_amdgcn_fence(__ATOMIC_ACQUIRE, "agent");
            asm volatile("s_waitcnt vmcnt(0)" ::: "memory");
        }
}
__device__ __forceinline__ void xcd_barrier(const XcdBarrier& b) {
    asm volatile("s_waitcnt vmcnt(0)" ::: "memory");
    __syncthreads();
    if (threadIdx.x == 0) xcd_barrier_t0(b);
    __syncthreads();
}
template <class Fn> __device__ __forceinline__ void xcd_barrier_side(const XcdBarrier& b, int wave, const Fn& side) {
    asm volatile("s_waitcnt vmcnt(0)" ::: "memory");
    __syncthreads();
    if (wave == 0) { if (threadIdx.x == 0) xcd_barrier_t0(b); }
    else side();
    __syncthreads();
}

constexpr int BATCH = 4, SEQ = 2048, DM = 2048, NH = 16, HD = 128, FF = 5632, DEPTH = 4;
constexpr int M = BATCH * SEQ;
constexpr float RMS_EPS = 1e-6f;
constexpr int NWAVES = 8;

constexpr size_t MiB = 1u << 20;
constexpr size_t WS_CTL = 0, CTL_ZERO_BYTES = 1 * MiB;
constexpr size_t WS_SSQ = 1 * MiB;
constexpr size_t WS_H = 2 * MiB;
constexpr size_t WS_HB = 66 * MiB;
constexpr size_t WS_Q = 98 * MiB, WS_K = 130 * MiB, WS_V = 162 * MiB;
constexpr size_t WS_MIX = 194 * MiB;
constexpr size_t WS_ACT = 226 * MiB;
constexpr size_t WS_W = 320 * MiB;
constexpr size_t W_FFN_STRIDE = 66 * MiB, W_FFN_DOWN = 44 * MiB;
constexpr size_t WS_WATT = WS_W + 8 * W_FFN_STRIDE;
constexpr size_t WS_END = WS_WATT + 112 * MiB;
constexpr int CW_BAR = 4096;

constexpr int RING_OFF = 0;
constexpr int SCALE_OFF = 135168;
constexpr int LDSCTL_OFF = 139264;
constexpr int LDS_BYTES = 147456;

namespace att {
using bf16x8 = __attribute__((ext_vector_type(8))) short;
using s16x4  = __attribute__((ext_vector_type(4))) short;
using f32x16 = __attribute__((ext_vector_type(16))) float;
using u32x4  = __attribute__((ext_vector_type(4))) unsigned;
constexpr int D = 128, QBLK = 32, KVBLK = 64, PITCH = 2048;
constexpr float SCALE = 0.088388347648318440f, LOG2E = 1.4426950408889634f;
constexpr int SHM_V = KVBLK * D * 2, SHM_K = KVBLK * D * 2;
constexpr int OST_ROW = 272, OST_WAVE = 32 * OST_ROW;
constexpr int OFF_V = 0, OFF_K = 2 * SHM_V, OFF_WS = NWAVES * OST_WAVE, OFF_BIAS = OFF_WS + NWAVES * 256;
static_assert(OFF_WS >= 2 * SHM_V + 2 * SHM_K && OFF_BIAS + (513 + 64) * 4 <= 131072, "attention LDS map");
#define KSWZ(row, colB) ((row) * 256 + ((colB) ^ (((row) & 7) << 4)))
#define SBAR() __builtin_amdgcn_sched_barrier(0)
__device__ __forceinline__ int crow(int r, int hi) { return (r & 3) + 8 * (r >> 2) + 4 * hi; }
__device__ __forceinline__ unsigned cvtpk(float lo, float hi) { unsigned r; asm volatile("v_cvt_pk_bf16_f32 %0, %1, %2" : "=v"(r) : "v"(lo), "v"(hi)); return r; }
__device__ __forceinline__ void qkt(f32x16& p0, f32x16& p1, const char* Ks, const bf16x8* qr, int r32, int hi) {
  p0 = f32x16{}; p1 = f32x16{};
  bf16x8 ka[4], kb[4];
#pragma unroll
  for (int hb = 0; hb < 2; ++hb) {
#pragma unroll
    for (int d = 0; d < 4; ++d) { const int cb = ((hb * 4 + d) * 16 + hi * 8) * 2;
      ka[d] = *reinterpret_cast<const bf16x8*>(Ks + KSWZ(r32, cb)); kb[d] = *reinterpret_cast<const bf16x8*>(Ks + KSWZ(32 + r32, cb)); }
    SBAR();
#pragma unroll
    for (int d = 0; d < 4; ++d) {
      p0 = __builtin_amdgcn_mfma_f32_32x32x16_bf16(ka[d], qr[hb * 4 + d], p0, 0, 0, 0);
      p1 = __builtin_amdgcn_mfma_f32_32x32x16_bf16(kb[d], qr[hb * 4 + d], p1, 0, 0, 0); }
    SBAR();
  }
}
__device__ __forceinline__ int v_st(int k, int c) { const int kk = (k & ~0xC) | ((k & 4) << 1) | ((k & 8) >> 1); return ((kk >> 3) * 4 + (c >> 5)) * 512 + ((kk & 7) * 32 + (c & 31)) * 2; }
__device__ __forceinline__ int v_rd_base(int lane) { return ((lane & 3) << 3) | (((lane >> 2) & 3) << 6) | (((lane >> 4) & 1) << 5) | (((lane >> 5) & 1) << 8); }
constexpr int v_rd_off(int d0, int ks, int half) { return d0 * 512 + ks * 4096 + half * 2048; }
template <int OFF> __device__ __forceinline__ s16x4 tr_read(int vb) {
  s16x4 r; asm volatile("ds_read_b64_tr_b16 %0, %1 offset:%2" : "=&v"(r) : "v"(vb), "i"(OFF) : "memory"); return r;
}
struct VFrag { s16x4 l0, h0, l1, h1, l2, h2, l3, h3; };
template <int D0> __device__ __forceinline__ void v_reads(VFrag& f, int vb) {
  f.l0 = tr_read<v_rd_off(D0, 0, 0)>(vb); f.h0 = tr_read<v_rd_off(D0, 0, 1)>(vb); f.l1 = tr_read<v_rd_off(D0, 1, 0)>(vb); f.h1 = tr_read<v_rd_off(D0, 1, 1)>(vb);
  f.l2 = tr_read<v_rd_off(D0, 2, 0)>(vb); f.h2 = tr_read<v_rd_off(D0, 2, 1)>(vb); f.l3 = tr_read<v_rd_off(D0, 3, 0)>(vb); f.h3 = tr_read<v_rd_off(D0, 3, 1)>(vb);
}
__device__ __forceinline__ void pv_mma(f32x16& od, const VFrag& f, bf16x8 pa0, bf16x8 pa1, bf16x8 pa2, bf16x8 pa3) {
#define PK(L, H) (bf16x8){L[0], L[1], L[2], L[3], H[0], H[1], H[2], H[3]}
  od = __builtin_amdgcn_mfma_f32_32x32x16_bf16(pa0, PK(f.l0, f.h0), od, 0, 0, 0);
  od = __builtin_amdgcn_mfma_f32_32x32x16_bf16(pa1, PK(f.l1, f.h1), od, 0, 0, 0);
  od = __builtin_amdgcn_mfma_f32_32x32x16_bf16(pa2, PK(f.l2, f.h2), od, 0, 0, 0);
  od = __builtin_amdgcn_mfma_f32_32x32x16_bf16(pa3, PK(f.l3, f.h3), od, 0, 0, 0);
#undef PK
}
__device__ __forceinline__ void pv_d0(f32x16* o, int vb, bf16x8 pa0, bf16x8 pa1, bf16x8 pa2, bf16x8 pa3) {
  VFrag fa, fb;
  v_reads<0>(fa, vb); v_reads<1>(fb, vb);
  asm volatile("s_waitcnt lgkmcnt(8)" ::: "memory"); SBAR(); pv_mma(o[0], fa, pa0, pa1, pa2, pa3); SBAR();
  v_reads<2>(fa, vb);
  asm volatile("s_waitcnt lgkmcnt(8)" ::: "memory"); SBAR(); pv_mma(o[1], fb, pa0, pa1, pa2, pa3); SBAR();
  v_reads<3>(fb, vb);
  asm volatile("s_waitcnt lgkmcnt(8)" ::: "memory"); SBAR(); pv_mma(o[2], fa, pa0, pa1, pa2, pa3); SBAR();
  asm volatile("s_waitcnt lgkmcnt(0)" ::: "memory"); SBAR(); pv_mma(o[3], fb, pa0, pa1, pa2, pa3);
}
__device__ __forceinline__ void pack_p(const f32x16& p0, const f32x16& p1, bf16x8& pa0, bf16x8& pa1, bf16x8& pa2, bf16x8& pa3) {
#define PK4(P, BASE, OUT) do { unsigned a0 = cvtpk(P[BASE + 0], P[BASE + 1]), a1 = cvtpk(P[BASE + 2], P[BASE + 3]);   \
    unsigned b0 = cvtpk(P[BASE + 4], P[BASE + 5]), b1 = cvtpk(P[BASE + 6], P[BASE + 7]);                              \
    auto r0 = __builtin_amdgcn_permlane32_swap(a0, b0, false, false); auto r1 = __builtin_amdgcn_permlane32_swap(a1, b1, false, false); \
    u32x4 w = {r0[0], r1[0], r0[1], r1[1]}; OUT = *reinterpret_cast<bf16x8*>(&w); } while (0)
  PK4(p0, 0, pa0); PK4(p0, 8, pa1); PK4(p1, 0, pa2); PK4(p1, 8, pa3);
#undef PK4
}
__device__ __forceinline__ void swap2(float x, float& lo, float& hi) {
  auto rr = __builtin_amdgcn_permlane32_swap(__float_as_uint(x), __float_as_uint(x), false, false); lo = __uint_as_float(rr[0]); hi = __uint_as_float(rr[1]);
}
__device__ __forceinline__ unsigned short f2bf1(float f) { return (unsigned short)(cvtpk(f, 0.f) & 0xffffu); }

struct Stg { bf16x8 vs0, vs1, ks0, ks1; };
__device__ __forceinline__ void sload(Stg& s, const unsigned short* Kh, const unsigned short* Vh, int k0, int sr, int sc) {
  s.vs0 = *reinterpret_cast<const bf16x8*>(Vh + (size_t)(k0 + sr) * PITCH + sc); s.vs1 = *reinterpret_cast<const bf16x8*>(Vh + (size_t)(k0 + 32 + sr) * PITCH + sc);
  s.ks0 = *reinterpret_cast<const bf16x8*>(Kh + (size_t)(k0 + sr) * PITCH + sc); s.ks1 = *reinterpret_cast<const bf16x8*>(Kh + (size_t)(k0 + 32 + sr) * PITCH + sc);
}
__device__ __forceinline__ void swrite(const Stg& s, char* lds, int buf, int sr, int sc, int vst0, int vst1) {
  *(bf16x8*)(lds + OFF_V + buf * SHM_V + vst0) = s.vs0; *(bf16x8*)(lds + OFF_V + buf * SHM_V + vst1) = s.vs1; const int kc = sc * 2;
  *(bf16x8*)(lds + OFF_K + buf * SHM_K + KSWZ(sr, kc)) = s.ks0; *(bf16x8*)(lds + OFF_K + buf * SHM_K + KSWZ(32 + sr, kc)) = s.ks1;
}
__device__ __forceinline__ void store_o(const f32x16* o, const float* rs, unsigned short* Ow, int r32, int hi, char* lds, int wid, int lane) {
  char* stg = lds + wid * OST_WAVE;
#pragma unroll
  for (int r = 0; r < 16; ++r) { const int orow = crow(r, hi);
#pragma unroll
    for (int d0 = 0; d0 < 4; ++d0) *(unsigned short*)(stg + orow * OST_ROW + (d0 * 32 + r32) * 2) = f2bf1(o[d0][r] * rs[r]); }
  asm volatile("s_waitcnt lgkmcnt(0)" ::: "memory");
#pragma unroll
  for (int j = 0; j < 8; ++j) { const int row = (lane >> 4) + 4 * j; const u32x4 v = *(const u32x4*)(stg + row * OST_ROW + (lane & 15) * 16);
    *(u32x4*)(Ow + (size_t)row * PITCH + (lane & 15) * 8) = v; }
}

template <bool MASK> __device__ __forceinline__ void stick_tile(f32x16& p0, f32x16& p1, float& Rm, int& Re, int tkh, int hi) {
  constexpr float C2 = SCALE * LOG2E;
  float x0[16], x1[16];
#pragma unroll
  for (int r = 0; r < 16; ++r) {
    { const float y = fmaxf(p0[r] * C2, -126.f); const float e = __builtin_amdgcn_exp2f(-y); const float sg = __builtin_amdgcn_rcpf(1.0f + e); const float om = e * sg;
      p0[r] = sg; x0[r] = (!MASK || ((r & 3) + 8 * (r >> 2)) < tkh) ? om : 1.0f; }
    { const float y = fmaxf(p1[r] * C2, -126.f); const float e = __builtin_amdgcn_exp2f(-y); const float sg = __builtin_amdgcn_rcpf(1.0f + e); const float om = e * sg;
      p1[r] = sg; x1[r] = (!MASK || (32 + (r & 3) + 8 * (r >> 2)) < tkh) ? om : 1.0f; }
  }
  float G[16];
#pragma unroll
  for (int c = 0; c < 4; ++c) {
    swap2((x0[4 * c] * x0[4 * c + 1]) * (x0[4 * c + 2] * x0[4 * c + 3]), G[2 * c], G[2 * c + 1]); swap2((x1[4 * c] * x1[4 * c + 1]) * (x1[4 * c + 2] * x1[4 * c + 3]), G[8 + 2 * c], G[8 + 2 * c + 1]);
  }
  float SG[16]; SG[15] = 1.0f;
#pragma unroll
  for (int g = 14; g >= 0; --g) SG[g] = SG[g + 1] * G[g + 1];
  const float total = SG[0] * G[0];
  const float Rs = ldexpf(Rm, Re);
#pragma unroll
  for (int c = 0; c < 4; ++c) {
    const float b0 = Rs * (hi ? SG[2 * c + 1] : SG[2 * c]), b1 = Rs * (hi ? SG[8 + 2 * c + 1] : SG[8 + 2 * c]);
    float e0[4], e1[4];
    e0[3] = b0; e0[2] = e0[3] * x0[4 * c + 3]; e0[1] = e0[2] * x0[4 * c + 2]; e0[0] = e0[1] * x0[4 * c + 1];
    e1[3] = b1; e1[2] = e1[3] * x1[4 * c + 3]; e1[1] = e1[2] * x1[4 * c + 2]; e1[0] = e1[1] * x1[4 * c + 1];
#pragma unroll
    for (int i = 0; i < 4; ++i) { const int r = 4 * c + i;
      const float a0 = p0[r] * e0[i], a1 = p1[r] * e1[i];
      p0[r] = (!MASK || ((r & 3) + 8 * (r >> 2)) < tkh) ? a0 : 0.f; p1[r] = (!MASK || (32 + (r & 3) + 8 * (r >> 2)) < tkh) ? a1 : 0.f; }
  }
  Rm *= total;
#pragma unroll
  for (int k = 0; k < 2; ++k) { const bool sm = Rm < 5.421010862427522e-20f; Rm = sm ? Rm * 18446744073709551616.0f : Rm; Re = sm ? Re - 64 : Re; }
}

__device__ __forceinline__ void stick_unit(const unsigned short* Q, const unsigned short* K, const unsigned short* V, unsigned short* O, int b, int h, int qb, char* lds, const int tid) {
  const int wid = __builtin_amdgcn_readfirstlane(tid >> 6), lane = tid & 63, r32 = lane & 31, hi = lane >> 5;
  const int t = 256 * qb + 32 * wid + r32;
  const int tmaxw = 256 * qb + 32 * wid + 31, tminw = 256 * qb + 32 * wid;
  const size_t rowb = (size_t)b * SEQ;
  bf16x8 qr[8];
  { const unsigned short* Qw = Q + (rowb + t) * PITCH + h * HD + hi * 8;
#pragma unroll
    for (int d0 = 0; d0 < 8; ++d0) qr[d0] = *reinterpret_cast<const bf16x8*>(Qw + d0 * 16); }
  const unsigned short* Kh = K + rowb * PITCH + h * HD; const unsigned short* Vh = V + rowb * PITCH + h * HD;
  const int sr = tid >> 4, sc = (tid & 15) * 8, vst0 = v_st(sr, sc), vst1 = v_st(32 + sr, sc);
  const int vb0 = (int)(uintptr_t)(lds + OFF_V) + v_rd_base(lane);
  f32x16 o[4] = {}; float Rm = 1.0f; int Re = 0;
  const int NT = 4 * qb + 4; int buf = 0;
  Stg st;
  volatile __attribute__((address_space(3))) int* flags = (volatile __attribute__((address_space(3))) int*)(lds + OFF_WS);
  bool wdone = false;
  __syncthreads();
  if (lane < 2) flags[lane * 8 + wid] = 0;
  sload(st, Kh, Vh, (NT - 1) * KVBLK, sr, sc); asm volatile("s_waitcnt vmcnt(0)" ::: "memory"); swrite(st, lds, 0, sr, sc, vst0, vst1); __syncthreads();
  for (int kt = NT - 1; kt >= 0; --kt) {
    if (kt > 0) sload(st, Kh, Vh, (kt - 1) * KVBLK, sr, sc);
    const int k0 = kt * KVBLK;
    if (k0 < tmaxw && !wdone) {
      f32x16 p0, p1;
      qkt(p0, p1, lds + OFF_K + buf * SHM_K, qr, r32, hi);
      const int tkh = t - k0 - 4 * hi;
      if (k0 + 63 < tminw) stick_tile<false>(p0, p1, Rm, Re, tkh, hi); else stick_tile<true>(p0, p1, Rm, Re, tkh, hi);
      bf16x8 pa0, pa1, pa2, pa3; pack_p(p0, p1, pa0, pa1, pa2, pa3);
      pv_d0(o, vb0 + buf * SHM_V, pa0, pa1, pa2, pa3);
      wdone = __all(Re <= -192 || Rm == 0.f);
    }
    if (lane == 0) flags[(kt & 1) * 8 + wid] = wdone ? 1 : 0;
    if (kt > 0) { asm volatile("s_waitcnt vmcnt(0)" ::: "memory"); swrite(st, lds, buf ^ 1, sr, sc, vst0, vst1); }
    __syncthreads();
    buf ^= 1;
    { const int fl = flags[(kt & 1) * 8 + (lane & 7)]; if (__all(fl != 0)) break; }
  }
  float rs[16];
#pragma unroll
  for (int r = 0; r < 16; ++r) rs[r] = 1.0f;
  store_o(o, rs, O + (rowb + 256 * qb + 32 * wid) * PITCH + h * HD, r32, hi, lds, wid, lane);
  if (PROBE_DUP == 10) { asm volatile("s_waitcnt vmcnt(0)" ::: "memory"); store_o(o, rs, O + (rowb + 256 * qb + 32 * wid) * PITCH + h * HD, r32, hi, lds, wid, lane); }
}

__device__ __forceinline__ void band_unit(const unsigned short* Q, const unsigned short* K, const unsigned short* V, unsigned short* O, const float* bias  , int b, int h, int qb, char* lds, const int tid) {
  const int wid = __builtin_amdgcn_readfirstlane(tid >> 6), lane = tid & 63, r32 = lane & 31, hi = lane >> 5;
  const int t = 256 * qb + 32 * wid + r32;
  const int cq = 4 * qb + (wid >> 1);
  const size_t rowb = (size_t)b * SEQ;
  bf16x8 qr[8];
  { const unsigned short* Qw = Q + (rowb + t) * PITCH + h * HD + hi * 8;
#pragma unroll
    for (int d0 = 0; d0 < 8; ++d0) qr[d0] = *reinterpret_cast<const bf16x8*>(Qw + d0 * 16); }
  const unsigned short* Kh = K + rowb * PITCH + h * HD; const unsigned short* Vh = V + rowb * PITCH + h * HD;
  const int sr = tid >> 4, sc = (tid & 15) * 8, vst0 = v_st(sr, sc), vst1 = v_st(32 + sr, sc);
  const int vb0 = (int)(uintptr_t)(lds + OFF_V) + v_rd_base(lane);
  float* wsf = (float*)(lds + OFF_WS) + wid * 64; float* al_l = wsf + 32;
  float* bias_l = (float*)(lds + OFF_BIAS);
  f32x16 o[4] = {}; f32x16 lacc = {}; float m_reg = -1e30f;
  const int kc_lo = (4 * qb - 8) > 0 ? (4 * qb - 8) : 0, kc_hi = 4 * qb + 3; int buf = 0;
  Stg st;
  const bf16x8 ones = {0x3F80, 0x3F80, 0x3F80, 0x3F80, 0x3F80, 0x3F80, 0x3F80, 0x3F80};
  constexpr float THR2 = 8.0f * LOG2E;
  __syncthreads();
  for (int i = tid; i < 513 + 64; i += NWAVES * 64) bias_l[i] = bias[i < 512 ? i : 512] * LOG2E;
  sload(st, Kh, Vh, kc_lo * KVBLK, sr, sc); asm volatile("s_waitcnt vmcnt(0)" ::: "memory"); swrite(st, lds, 0, sr, sc, vst0, vst1); __syncthreads();
  for (int kc = kc_lo; kc <= kc_hi; ++kc) {
    if (kc < kc_hi) sload(st, Kh, Vh, (kc + 1) * KVBLK, sr, sc);
    if (kc >= cq - 8 && kc <= cq) {
      f32x16 p0, p1;
      qkt(p0, p1, lds + OFF_K + buf * SHM_K, qr, r32, hi);
      constexpr float C2 = SCALE * LOG2E;
      float pmax = -1e30f;
      if (kc <= cq - 5) {
        const float bfar = bias_l[512];
#pragma unroll
        for (int r = 0; r < 16; ++r) { p0[r] = p0[r] * C2 + bfar; p1[r] = p1[r] * C2 + bfar; pmax = fmaxf(pmax, fmaxf(p0[r], p1[r])); }
      } else {
        const float* bp = bias_l + (t - kc * KVBLK - 4 * hi + 256);
        float bv0[16], bv1[16];
#pragma unroll
        for (int r = 0; r < 16; ++r) { bv0[r] = bp[-((r & 3) + 8 * (r >> 2))]; bv1[r] = bp[-(32 + (r & 3) + 8 * (r >> 2))]; }
        SBAR();
#pragma unroll
        for (int r = 0; r < 16; ++r) { p0[r] = p0[r] * C2 + bv0[r]; p1[r] = p1[r] * C2 + bv1[r]; pmax = fmaxf(pmax, fmaxf(p0[r], p1[r])); }
      }
      { float lo, hh; swap2(pmax, lo, hh); pmax = fmaxf(lo, hh); }
      float mn, alpha;
      if (__all(pmax - m_reg <= THR2)) { mn = m_reg; alpha = 1.f; } else { mn = fmaxf(m_reg, pmax); alpha = __builtin_amdgcn_exp2f(m_reg - mn); m_reg = mn; }
#pragma unroll
      for (int r = 0; r < 16; ++r) { p0[r] = __builtin_amdgcn_exp2f(p0[r] - mn); p1[r] = __builtin_amdgcn_exp2f(p1[r] - mn); }
      if (__any(alpha < 1.f)) { if (hi == 0) al_l[r32] = alpha; asm volatile("s_waitcnt lgkmcnt(0)" ::: "memory");
#pragma unroll
        for (int r = 0; r < 16; ++r) { const float a = al_l[crow(r, hi)]; lacc[r] *= a;
#pragma unroll
          for (int d = 0; d < 4; ++d) o[d][r] *= a; } }
      bf16x8 pa0, pa1, pa2, pa3; pack_p(p0, p1, pa0, pa1, pa2, pa3);
      lacc = __builtin_amdgcn_mfma_f32_32x32x16_bf16(pa0, ones, lacc, 0, 0, 0); lacc = __builtin_amdgcn_mfma_f32_32x32x16_bf16(pa1, ones, lacc, 0, 0, 0);
      lacc = __builtin_amdgcn_mfma_f32_32x32x16_bf16(pa2, ones, lacc, 0, 0, 0); lacc = __builtin_amdgcn_mfma_f32_32x32x16_bf16(pa3, ones, lacc, 0, 0, 0);
      pv_d0(o, vb0 + buf * SHM_V, pa0, pa1, pa2, pa3);
    }
    if (kc < kc_hi) { asm volatile("s_waitcnt vmcnt(0)" ::: "memory"); swrite(st, lds, buf ^ 1, sr, sc, vst0, vst1); }
    __syncthreads();
    buf ^= 1;
  }
  float rs[16];
#pragma unroll
  for (int r = 0; r < 16; ++r) rs[r] = __builtin_amdgcn_rcpf(lacc[r]);
  store_o(o, rs, O + (rowb + 256 * qb + 32 * wid) * PITCH + h * HD, r32, hi, lds, wid, lane);
  if (PROBE_DUP == 10) { asm volatile("s_waitcnt vmcnt(0)" ::: "memory"); store_o(o, rs, O + (rowb + 256 * qb + 32 * wid) * PITCH + h * HD, r32, hi, lds, wid, lane); }
}
#undef KSWZ
#undef SBAR
}

struct Frame {
    LAS unsigned char* lds;
    volatile LAS unsigned* MISC;
    gu32* ctl;
    int tid, lane, wave;
    int vcu, G;
};
__device__ __forceinline__ float wave_sum(float v) {
#pragma unroll
    for (int o = 1; o < 64; o <<= 1) v += __shfl_xor(v, o);
    return v;
}
struct ConvItem { const float* src; const float* gain; bf16* dst; int N, Kd; };
__device__ __forceinline__ void tr_load(const ConvItem& c, f32x4 (&v)[16], int lane) {
    const float* src = c.src + (size_t)(lane >> 4) * c.N + (lane & 15) * 4;
#pragma unroll
    for (int j = 0; j < 16; ++j) v[j] = __builtin_nontemporal_load((const f32x4*)(src + (size_t)(4 * j) * c.N));
}
__device__ __forceinline__ void tr_lds_write(const f32x4 (&v)[16], LAS float* scr, int lane) {
    LAS float* d = scr + (lane >> 4) * 65 + (lane & 15) * 4;
#pragma unroll
    for (int j = 0; j < 16; ++j) { d[(4 * j) * 65 + 0] = v[j][0]; d[(4 * j) * 65 + 1] = v[j][1]; d[(4 * j) * 65 + 2] = v[j][2]; d[(4 * j) * 65 + 3] = v[j][3]; }
}
__device__ __forceinline__ void tr_store(const ConvItem& it, LAS float* scr, int lane) {
    const int c = lane & 7;
    float gk[8];
#pragma unroll
    for (int i = 0; i < 8; ++i) gk[i] = it.gain ? it.gain[8 * c + i] : 1.0f;
    LDS_WAIT(); asm volatile("" ::: "memory");
#pragma unroll
    for (int j = 0; j < 8; ++j) { const int n = (lane >> 3) + 8 * j; const LAS float* s = scr + (8 * c) * 65 + n;
        v4u o; o.x = pk2(s[0 * 65] * gk[0], s[1 * 65] * gk[1]); o.y = pk2(s[2 * 65] * gk[2], s[3 * 65] * gk[3]); o.z = pk2(s[4 * 65] * gk[4], s[5 * 65] * gk[5]); o.w = pk2(s[6 * 65] * gk[6], s[7 * 65] * gk[7]);
        __builtin_nontemporal_store(o, (GAS v4u*)(it.dst + (size_t)n * it.Kd + 8 * c)); }
    LDS_WAIT(); asm volatile("" ::: "memory");
}

struct Args { const float* in[14]; float* out; unsigned char* ws; int ph_lo, ph_hi; };

__device__ __forceinline__ bf16* w_gu(unsigned char* ws, int f) { return (bf16*)(ws + WS_W + (size_t)f * W_FFN_STRIDE); }
__device__ __forceinline__ bf16* w_dn(unsigned char* ws, int f) { return (bf16*)(ws + WS_W + (size_t)f * W_FFN_STRIDE + W_FFN_DOWN); }
__device__ __forceinline__ bf16* w_mix1(unsigned char* ws, int layer) { return (bf16*)(ws + WS_WATT + (size_t)layer * 32 * MiB); }
__device__ __forceinline__ bf16* w_mixo(unsigned char* ws, int layer) { return (bf16*)(ws + WS_WATT + (size_t)layer * 32 * MiB + (layer < 3 ? 24 : 8) * MiB); }

constexpr int CONV_TOTAL = 81920;
#ifndef CONV_CAP
#define CONV_CAP 8192
#endif
#ifndef CONV_NBW
#define CONV_NBW 4
#endif
constexpr int CONV_NB = CONV_NBW * 256;
constexpr int bar_off(int b) { if (b <= 0) return 0; const int L = (b - 1) / 7, j = (b - 1) % 7 + 1; return CONV_NB + L * (7 * CONV_NB + 2 * CONV_CAP) + CONV_CAP + (j - 1) * CONV_NB + (j >= 6 ? CONV_CAP : 0); }
constexpr int slot_off(int k) { return CONV_NB + (k / 2) * (7 * CONV_NB + 2 * CONV_CAP) + ((k & 1) ? CONV_CAP + 5 * CONV_NB : 0); }
constexpr int conv_up() { int u = 0;
    for (int L = 0; L < 4; ++L) { const int base = L * 20992, msz = L < 3 ? 4096 : 2048, q = L < 3 ? 3072 : 1024;
        const int need[6] = {base + 5632, base + 8448, base + 8448 + q, base + 8448 + msz, base + 8448 + msz + 5632, base + 8448 + msz + 8448};
        const int at[6] = {7 * L, 7 * L + 1, 7 * L + 2, 7 * L + 4, 7 * L + 5, 7 * L + 6};
        for (int i = 0; i < 6; ++i) { const int d = need[i] - bar_off(at[i]); if (d > u) u = d; } }
    return u < CONV_TOTAL ? u : CONV_TOTAL; }
constexpr int CONV_UP = (CONV_CAP > 0 || CONV_NBW > 0) ? conv_up() : CONV_TOTAL;
static_assert(CONV_UP + bar_off(27) >= CONV_TOTAL, "conversion schedule covers every item");
static_assert(CONV_NBW >= 0 && CONV_NBW <= 7, "waves 1..7 only");
__device__ __forceinline__ void conv_decode(const Args& a, int it, ConvItem& ci) {
    unsigned char* ws = a.ws;
    const float *g_ffn = a.in[1], *wg = a.in[2], *wu = a.in[3], *wd = a.in[4], *g_mix = a.in[5], *wqkv = a.in[6], *woa = a.in[7], *g_kv = a.in[8], *wkv = a.in[9], *wqb = a.in[10], *wob = a.in[11];
        const float* W; const float* gain = nullptr; bf16* WT; int N, Kd, kb, nb, drow_add = 0; bool ilv = false; int mat = 0;
        int L = it / 20992; if (L > 3) L = 3; int r = it - L * 20992;
        const int msz = L < 3 ? 4096 : 2048;
        int f = 2 * L; bool ffn = true;
        if (r >= 8448) { r -= 8448; if (r < msz) ffn = false; else { r -= msz; f = 2 * L + 1; } }
        if (ffn) { mat = r / 2816; r -= mat * 2816;
            if (mat < 2) { N = FF; Kd = DM; W = (mat == 0 ? wg : wu) + (size_t)f * DM * FF; gain = g_ffn + (size_t)f * DM; WT = w_gu(ws, f); kb = r / 88; nb = r - kb * 88; ilv = true; }
            else { N = DM; Kd = FF; W = wd + (size_t)f * FF * DM; WT = w_dn(ws, f); kb = r / 32; nb = r - kb * 32; }
        } else if (L < 2) {
            if (r < 3072) { N = 3 * DM; Kd = DM; W = wqkv + (size_t)L * DM * 3 * DM; gain = g_mix + (size_t)L * DM; WT = w_mix1(ws, L); kb = r / 96; nb = r - kb * 96; }
            else { r -= 3072; N = DM; Kd = DM; W = woa + (size_t)L * DM * DM; WT = w_mixo(ws, L); kb = r / 32; nb = r - kb * 32; }
        } else if (L == 2) {
            if (r < 1024) { N = DM; Kd = DM; W = wqb; gain = g_mix + 2 * DM; WT = w_mix1(ws, 2); kb = r / 32; nb = r - kb * 32; }
            else if (r < 3072) { r -= 1024; N = 2 * DM; Kd = DM; W = wkv; gain = g_kv; WT = w_mix1(ws, 2); kb = r / 64; nb = r - kb * 64; drow_add = DM; }
            else { r -= 3072; N = DM; Kd = DM; W = wob; WT = w_mixo(ws, 2); kb = r / 32; nb = r - kb * 32; }
        } else {
            if (r < 1024) { N = DM; Kd = DM; W = wqb + (size_t)DM * DM; gain = g_mix + 3 * DM; WT = w_mix1(ws, 3); kb = r / 32; nb = r - kb * 32; }
            else { r -= 1024; N = DM; Kd = DM; W = wob + (size_t)DM * DM; WT = w_mixo(ws, 3); kb = r / 32; nb = r - kb * 32; }
        }
        const int n0 = nb * 64, k0 = kb * 64; const int drow = ilv ? (256 * (n0 >> 7) + (n0 & 127) + 128 * mat) : (n0 + drow_add);
        ci.src = W + (size_t)k0 * N + n0; ci.gain = gain ? gain + k0 : nullptr; ci.dst = WT + (size_t)drow * Kd + k0; ci.N = N; ci.Kd = Kd;
}
__device__ __forceinline__ void conv_one(Frame& F, const Args& a, int it) {
    LAS float* scr = (LAS float*)(F.lds + RING_OFF + F.wave * 16640);
    int lane_ = threadIdx.x; asm volatile("" : "+v"(lane_)); lane_ &= 63;
    ConvItem c; f32x4 v[16]; conv_decode(a, it, c); tr_load(c, v, lane_); tr_lds_write(v, scr, lane_); tr_store(c, scr, lane_);
}
__device__ __forceinline__ void conv_items(Frame& F, const Args& a, int it_lo, int it_hi, int rank, int nranks) {
    LAS float* scr = (LAS float*)(F.lds + RING_OFF + F.wave * 16640);
    auto decode = [&](int it, ConvItem& ci) { conv_decode(a, it, ci); };
    const int stride = nranks * NWAVES; int it = it_lo + rank * NWAVES + F.wave;
    int lane_ = threadIdx.x; asm volatile("" : "+v"(lane_)); lane_ &= 63;
    ConvItem cA, cB; f32x4 vA[16], vB[16];
    if (it < it_hi) { decode(it, cA); tr_load(cA, vA, lane_); }
    if (it + stride < it_hi) { decode(it + stride, cB); tr_load(cB, vB, lane_); }
    while (it < it_hi) {
        tr_lds_write(vA, scr, lane_);
        { const ConvItem cur = cA; const int itn = it + 2 * stride; if (itn < it_hi) { decode(itn, cA); tr_load(cA, vA, lane_); } tr_store(cur, scr, lane_); }
        it += stride; if (it >= it_hi) break;
        tr_lds_write(vB, scr, lane_);
        { const ConvItem cur = cB; const int itn = it + 2 * stride; if (itn < it_hi) { decode(itn, cB); tr_load(cB, vB, lane_); } tr_store(cur, scr, lane_); }
        it += stride;
    }
}
__device__ __forceinline__ int lo_perm(int c) { return (c & ~255) | (((c >> 5) & 3) << 6) | (((c >> 3) & 3) << 4) | (((c >> 7) & 1) << 3) | (c & 7); }
__device__ __forceinline__ void p0_prologue(Frame& F, const Args& a) {
    unsigned char* ws = a.ws;
    const int gw = F.vcu * NWAVES + F.wave, NGW = F.G * NWAVES;
    conv_items(F, a, 0, CONV_UP, F.vcu, F.G);
    const float* x = a.in[0]; bf16* hb = (bf16*)(ws + WS_HB); bf16* hl = (bf16*)(ws + WS_H); float* ssq = (float*)(ws + WS_SSQ);
    int lane_ = threadIdx.x; asm volatile("" : "+v"(lane_)); lane_ &= 63;
    for (int m = gw; m < M; m += NGW) {
        const GAS f32x4* xr = (const GAS f32x4*)(x + (size_t)m * DM) + lane_; f32x4 v[8]; float s = 0.f;
#pragma unroll
        for (int j = 0; j < 8; ++j) { v[j] = xr[64 * j]; s += (v[j].x * v[j].x + v[j].y * v[j].y) + (v[j].z * v[j].z + v[j].w * v[j].w); }
        s = wave_sum(s);
        GAS unsigned long long* o8 = (GAS unsigned long long*)(hb + (size_t)m * DM) + lane_; GAS unsigned long long* l8 = (GAS unsigned long long*)(hl + (size_t)m * DM) + lane_;
#pragma unroll
        for (int j = 0; j < 8; ++j) { const unsigned h0 = pk2(v[j].x, v[j].y), h1 = pk2(v[j].z, v[j].w);
            o8[64 * j] = (unsigned long long)h0 | ((unsigned long long)h1 << 32);
            if (RESID_LO == 1) l8[64 * j] = (unsigned long long)pk2(v[j].x - pg8::bf_lo(h0), v[j].y - pg8::bf_hi(h0)) | ((unsigned long long)pk2(v[j].z - pg8::bf_lo(h1), v[j].w - pg8::bf_hi(h1)) << 32);
            if (RESID_LO == 2) { int w = __builtin_amdgcn_cvt_pk_fp8_f32((v[j].x - pg8::bf_lo(h0)) * 512.0f, (v[j].y - pg8::bf_hi(h0)) * 512.0f, 0, false);
                w = __builtin_amdgcn_cvt_pk_fp8_f32((v[j].z - pg8::bf_lo(h1)) * 512.0f, (v[j].w - pg8::bf_hi(h1)) * 512.0f, w, true);
                *(GAS unsigned*)((unsigned char*)hl + (size_t)m * DM + lo_perm(4 * (lane_ + 64 * j))) = (unsigned)w; } }
        if (lane_ < 32) ssq[(size_t)m * 32 + lane_] = lane_ == 0 ? s : 0.f;
    }
}
__device__ __forceinline__ void final_norm(Frame& F, const Args& a) {
    const int gw = F.vcu * NWAVES + F.wave, NGW = F.G * NWAVES;
    const bf16* hb = (const bf16*)(a.ws + WS_HB); const bf16* hl = (const bf16*)(a.ws + WS_H); const float* ssq = (const float*)(a.ws + WS_SSQ); const float* g = a.in[13];
    int lane_ = threadIdx.x; asm volatile("" : "+v"(lane_)); lane_ &= 63;
    f32x4 gv[8];
#pragma unroll
    for (int j = 0; j < 8; ++j) gv[j] = ((const GAS f32x4*)g)[lane_ + 64 * j];
    for (int m = gw; m < M; m += NGW) {
        float s = lane_ < 32 ? ssq[(size_t)m * 32 + lane_] : 0.f; s = wave_sum(s);
        const float rs = __builtin_amdgcn_rsqf(s * (1.0f / DM) + RMS_EPS);
        const GAS unsigned long long* hr = (const GAS unsigned long long*)(hb + (size_t)m * DM) + lane_; const GAS unsigned long long* lr = (const GAS unsigned long long*)(hl + (size_t)m * DM) + lane_;
        GAS f32x4* orow = (GAS f32x4*)(a.out + (size_t)m * DM) + lane_;
#pragma unroll
        for (int j = 0; j < 8; ++j) { const unsigned long long hw = hr[64 * j]; const unsigned h0 = (unsigned)hw, h1 = (unsigned)(hw >> 32);
            f32x4 hv = {pg8::bf_lo(h0), pg8::bf_hi(h0), pg8::bf_lo(h1), pg8::bf_hi(h1)};
            if (RESID_LO == 1) { const unsigned long long lw = lr[64 * j]; const unsigned l0 = (unsigned)lw, l1 = (unsigned)(lw >> 32); hv += (f32x4){pg8::bf_lo(l0), pg8::bf_hi(l0), pg8::bf_lo(l1), pg8::bf_hi(l1)}; }
            if (RESID_LO == 2) { typedef float f32x2v __attribute__((ext_vector_type(2))); const int w = (int)*(const GAS unsigned*)((const unsigned char*)hl + (size_t)m * DM + lo_perm(4 * (lane_ + 64 * j)));
                const f32x2v a = __builtin_amdgcn_cvt_pk_f32_fp8(w, false), b = __builtin_amdgcn_cvt_pk_f32_fp8(w, true); hv += (f32x4){a.x, a.y, b.x, b.y} * (1.0f / 512.0f); }
            orow[64 * j] = hv * rs * gv[j]; }
    }
}

#ifndef KN_ALIGN
#define KN_ALIGN true
#endif
#ifndef KN_SP2
#define KN_SP2 true
#endif
#ifndef MK_PER_PHASE
#define MK_PER_PHASE 0
#endif
constexpr size_t WS_DUMMY = 960 * MiB;
constexpr int N_PHASES = 38;
__global__ void __launch_bounds__(NWAVES * 64, 2) mega_fwd(Args args) {
    extern __shared__ __attribute__((aligned(16))) unsigned char lds[];
    Frame F;
    F.lds = (LAS unsigned char*)lds;
    F.MISC = (volatile LAS unsigned*)(F.lds + LDSCTL_OFF);
    F.tid = threadIdx.x; F.lane = F.tid & 63; F.wave = __builtin_amdgcn_readfirstlane(F.tid >> 6);
    F.G = gridDim.x; { const int bx = blockIdx.x; F.vcu = (F.G % 8 == 0) ? (bx % 8) * (F.G / 8) + bx / 8 : bx; }
    unsigned char* ws = args.ws;
    F.ctl = (gu32*)(ws + WS_CTL);
    for (int u = F.tid; u < 256; u += NWAVES * 64) ((LAS unsigned*)(F.lds + LDSCTL_OFF))[u] = 0u;
    __syncthreads();
#if MK_PER_PHASE
#define GRID_BAR() do { } while (0)
#else
    XcdBarrier bar = xcd_barrier_post((unsigned*)(F.ctl + CW_BAR), F.MISC + 8);
    int bar_cls = 0;
#ifndef PROBE_BLK
#define PROBE_BLK 0
#endif
#ifndef PROBE_CLS
#define PROBE_CLS -1
#endif
#define GRID_BAR() do { unsigned long long t0_ = 0; if (PROBE_DUP == 13 && blockIdx.x == PROBE_BLK && F.tid == 0) t0_ = __builtin_amdgcn_s_memrealtime(); xcd_barrier(bar); if (PROBE_DUP == 12) xcd_barrier(bar); \
    if (PROBE_DUP == 13 && blockIdx.x == PROBE_BLK && F.tid == 0 && (PROBE_CLS < 0 || PROBE_CLS == bar_cls)) { volatile unsigned long long* pw = (volatile unsigned long long*)(ws + WS_CTL + 8192); *pw = *pw + (__builtin_amdgcn_s_memrealtime() - t0_); } } while (0)
#endif
#if MK_PER_PHASE || CONV_NBW == 0
#define GRID_BARC() GRID_BAR()
#else
    int bidx = 0;
#define GRID_BARC() do { const int bo_ = CONV_UP + bar_off(bidx); ++bidx; \
    xcd_barrier_side(bar, F.wave, [&]() { if (F.wave <= CONV_NBW) for (int j_ = F.vcu * CONV_NBW + F.wave - 1; j_ < CONV_NB; j_ += F.G * CONV_NBW) { const int it_ = bo_ + j_; if (it_ < CONV_TOTAL) conv_one(F, args, it_); } }); } while (0)
#endif
    const int lo = args.ph_lo, hi = args.ph_hi;
#define IN(k) (lo <= (k) && (k) < hi)
#define BOTH(k) (IN(k) && (k) + 1 < hi)

    bf16* HL = (bf16*)(ws + WS_H); bf16* HB = (bf16*)(ws + WS_HB); float* SSQ = (float*)(ws + WS_SSQ);
    bf16* QB = (bf16*)(ws + WS_Q); bf16* KB = (bf16*)(ws + WS_K); bf16* VB = (bf16*)(ws + WS_V); bf16* MIX = (bf16*)(ws + WS_MIX); bf16* ACT = (bf16*)(ws + WS_ACT);

    if (IN(0)) { p0_prologue(F, args); if (PROBE_DUP == 1) { GRID_BAR(); p0_prologue(F, args); } if (BOTH(0)) GRID_BARC(); }
    int cid = (int)blockIdx.x;
#if !MK_PER_PHASE
    if (lo == 0 && hi > 1) {
        if (F.tid == 0) { bool ok = (F.G % 8) == 0;
            for (unsigned j = 0; j < 16; ++j) { const unsigned cnt = xb_ld((unsigned*)(F.ctl + CW_BAR) + XB_XCNT(j)); ok = ok && (cnt == (j < 8 ? (unsigned)F.G / 8u : 0u)); }
            F.MISC[12] = ok ? (F.MISC[10] * 8u + F.MISC[11]) : (unsigned)blockIdx.x; }
        __syncthreads();
        cid = __builtin_amdgcn_readfirstlane((int)F.MISC[12]);
    }
#endif
    const int vcid = (F.G % 8 == 0) ? (cid % 8) * (F.G / 8) + cid / 8 : cid;

#pragma unroll 1
    for (int s = 0; s < 12; ++s) {
        const int layer = s / 3, kind = s - 3 * layer, pb = 1 + 3 * s;
        int ltid = threadIdx.x; asm volatile("" : "+v"(ltid));
        unsigned long long pc0 = 0, pr0 = 0;
        if (PROBE_DUP == 11 && s == 3 && blockIdx.x == 0 && F.tid == 0) { pc0 = __builtin_amdgcn_s_memtime(); pr0 = __builtin_amdgcn_s_memrealtime(); }
        if (IN(pb)) {
          for (int rep = 0; rep < (((PROBE_DUP == 4 && kind != 1) || (PROBE_DUP == 6 && kind == 1)) ? 2 : 1); ++rep) {
            if (rep) GRID_BAR();
            asm volatile("" : "+v"(ltid));
            int pm0 = -1; const PG8_LAS float* stab = (const PG8_LAS float*)(F.lds + SCALE_OFF);
            { pg8::StaticOrder S0; S0.init(M, kind != 1 ? 2 * FF : (layer < 3 ? 3 * DM : DM), F.G, cid); pg8::Unit u0;
              if (S0.next(0, u0)) { pm0 = u0.pm;
                if (ltid < 256) { const f32x4* p = (const f32x4*)(SSQ + (size_t)(pm0 * 256 + ltid) * 32); float a = 0.f;
#pragma unroll
                    for (int q = 0; q < 8; ++q) { const f32x4 v = p[q]; a += (v[0] + v[1]) + (v[2] + v[3]); }
                    ((PG8_LAS float*)(F.lds + SCALE_OFF))[ltid] = __builtin_amdgcn_rsqf(a * (1.0f / DM) + RMS_EPS); } }
              __syncthreads(); }
            if (kind != 1) {
                const int f = 2 * layer + (kind >> 1);
                pg8::Gemm g{HB, w_gu(ws, f), M, 2 * FF, DM}; pg8::StaticOrder S; S.init(M, 2 * FF, F.G, cid);
                pg8::EpiSwiglu E{ACT, FF, SSQ, stab, pm0};
                const int nu = (M / 256) * (2 * FF / 256), rem = nu % F.G, c = cid;
                const int lo_it = CONV_UP + (CONV_NB + (f >> 1) * (7 * CONV_NB + 2 * CONV_CAP) + ((f & 1) ? CONV_CAP + 5 * CONV_NB : 0)), hi_it = (lo_it + CONV_CAP) < CONV_TOTAL ? (lo_it + CONV_CAP) : CONV_TOTAL;
                const bool cv = CONV_CAP > 0 && lo_it < hi_it && (rem == 0 || c >= rem); const int crank = rem == 0 ? c : c - rem, cn = rem == 0 ? F.G : F.G - rem;
                pg8::gemm_phase<pg8::EpiSwiglu, pg8::StaticOrder, KN_ALIGN, KN_SP2>(F.lds + RING_OFF, g, S, E, ltid);
                if (cv) conv_items(F, args, lo_it, hi_it, crank, cn);
            } else {
                const int N = layer < 3 ? 3 * DM : DM;
                pg8::Gemm g{HB, w_mix1(ws, layer), M, N, DM}; pg8::StaticOrder S; S.init(M, N, F.G, cid);
                pg8::EpiScaleBf16 E{QB, (size_t)(WS_K - WS_Q) / 2, SSQ, stab, pm0};
                pg8::gemm_phase<pg8::EpiScaleBf16, pg8::StaticOrder, KN_ALIGN, KN_SP2>(F.lds + RING_OFF, g, S, E, ltid);
            }
          }
            if (PROBE_DUP == 11 && s == 3 && blockIdx.x == 0 && F.tid == 0) {
                const unsigned long long cyc = __builtin_amdgcn_s_memtime() - pc0, rt = __builtin_amdgcn_s_memrealtime() - pr0;
                const unsigned long long delay = cyc * 10000ull / (rt ? rt : 1ull);
                const unsigned long long t0 = __builtin_amdgcn_s_memrealtime(); while (__builtin_amdgcn_s_memrealtime() - t0 < delay) __builtin_amdgcn_s_sleep(8);
            }
            bar_cls = kind != 1 ? 1 : 3; if (BOTH(pb)) GRID_BARC();
        }
        if (kind == 1 && IN(pb + 1)) {
          for (int rep = 0; rep < (((PROBE_DUP == 2 && layer < 2) || (PROBE_DUP == 3 && layer >= 2)) ? 2 : 1); ++rep) {
            if (rep) GRID_BAR();
            for (int p = vcid; p < 256; p += F.G) {
                const int bh = p >> 2, j = p & 3, b = bh >> 4, h = bh & 15;
                if (layer < 2) {
#pragma unroll 1
                    for (int uu = 0; uu < 2; ++uu) { asm volatile("" : "+v"(ltid)); att::stick_unit(QB, KB, VB, MIX, b, h, uu == 0 ? 7 - j : j, (char*)lds + RING_OFF, ltid); }
                } else { const float* bias = args.in[12] + ((size_t)(layer - 2) * NH + h) * 513;
#pragma unroll 1
                    for (int uu = 0; uu < 2; ++uu) { asm volatile("" : "+v"(ltid)); att::band_unit(QB, KB, VB, MIX, bias, b, h, uu == 0 ? 7 - j : j, (char*)lds + RING_OFF, ltid); }
                }
            }
          }
            bar_cls = 4; if (BOTH(pb + 1)) GRID_BARC();
        }
        if (IN(pb + 2)) {
            const bool ffn = kind != 1; const int f = 2 * layer + (kind >> 1);
            pg8::Gemm g{ffn ? ACT : MIX, ffn ? w_dn(ws, f) : w_mixo(ws, layer), M, DM, ffn ? FF : DM}; pg8::StaticOrder S; S.init(M, DM, F.G, cid);
          for (int rep = (((PROBE_DUP == 5 && ffn) || (PROBE_DUP == 7 && !ffn)) ? 0 : 1); rep < 2; ++rep) {
            const bool dummy = rep == 0;
            asm volatile("" : "+v"(ltid));
            pg8::EpiResid E{HB, HL, dummy ? (bf16*)(ws + WS_DUMMY + 64 * MiB) : HB, dummy ? (bf16*)(ws + WS_DUMMY) : HL, dummy ? (float*)(ws + WS_DUMMY + 96 * MiB) : SSQ, ffn ? 0.5f : 1.0f};
#if PROBE_DUP == 9
            pg8::EpiResid Ed{HB, HL, (bf16*)(ws + WS_DUMMY + 64 * MiB), (bf16*)(ws + WS_DUMMY), (float*)(ws + WS_DUMMY + 96 * MiB), ffn ? 0.5f : 1.0f};
            pg8::EpiTwice<pg8::EpiResid> E2{Ed, E};
            pg8::gemm_phase<pg8::EpiTwice<pg8::EpiResid>, pg8::StaticOrder, KN_ALIGN, KN_SP2>(F.lds + RING_OFF, g, S, E2, ltid);
#else
            pg8::gemm_phase<pg8::EpiResid, pg8::StaticOrder, KN_ALIGN, KN_SP2>(F.lds + RING_OFF, g, S, E, ltid);
#endif
            if (dummy) GRID_BAR();
          }
            bar_cls = ffn ? 2 : 5; if (BOTH(pb + 2)) GRID_BARC();
        }
    }
    if (PROBE_DUP == 13 && blockIdx.x == PROBE_BLK && F.tid == 0) { const unsigned long long bw_acc = *(volatile unsigned long long*)(ws + WS_CTL + 8192); const unsigned long long t0 = __builtin_amdgcn_s_memrealtime(); while (__builtin_amdgcn_s_memrealtime() - t0 < bw_acc) __builtin_amdgcn_s_sleep(8); }
    if (IN(37)) { final_norm(F, args); if (PROBE_DUP == 8) { GRID_BAR(); final_norm(F, args); } }
#undef IN
#undef BOTH
}

extern "C" void kernel_launch(void* const* d_in, const int* in_sizes, int n_in, void* d_out, int out_size, void* d_ws, size_t ws_size, hipStream_t stream) {
    static int grid = 0;
    if (grid == 0) {
        if (n_in != 14 || in_sizes[0] != M * DM || out_size != M * DM || ws_size < WS_END) { fprintf(stderr, "kernel_launch: shape mismatch: n_in %d in0 %d out %d ws %zu (need %zu)\n", n_in, n_in > 0 ? in_sizes[0] : -1, out_size, ws_size, (size_t)WS_END); grid = -1; return; }
        int dev = 0, cus = 0, per_cu = 0;
        if (hipGetDevice(&dev) != hipSuccess || hipDeviceGetAttribute(&cus, hipDeviceAttributeMultiprocessorCount, dev) != hipSuccess) { fprintf(stderr, "kernel_launch: device query failed\n"); grid = -1; return; }
        if (hipFuncSetAttribute((const void*)mega_fwd, hipFuncAttributeMaxDynamicSharedMemorySize, LDS_BYTES) != hipSuccess) { fprintf(stderr, "kernel_launch: hipFuncSetAttribute failed\n"); grid = -1; return; }
        if (hipOccupancyMaxActiveBlocksPerMultiprocessor(&per_cu, (const void*)mega_fwd, NWAVES * 64, LDS_BYTES) != hipSuccess || per_cu < 1) { fprintf(stderr, "kernel_launch: occupancy query reports %d workgroups per CU\n", per_cu); (void)hipGetLastError(); grid = -1; return; }
        grid = cus;
    }
    if (grid < 0) return;
    if (hipMemsetAsync((char*)d_ws + WS_CTL, 0, CTL_ZERO_BYTES, stream) != hipSuccess) { fprintf(stderr, "kernel_launch: hipMemsetAsync failed\n"); return; }
    Args a{};
    for (int i = 0; i < 14; ++i) a.in[i] = (const float*)d_in[i];
    a.out = (float*)d_out; a.ws = (unsigned char*)d_ws;
#if MK_PER_PHASE
    for (int ph = 0; ph < N_PHASES; ++ph) {
        if (ph >= 1 && ph <= 36) { const int s = (ph - 1) / 3, j = (ph - 1) % 3; if (j == 1 && (s % 3) != 1) continue; }
        a.ph_lo = ph; a.ph_hi = ph + 1;
        hipLaunchKernelGGL(mega_fwd, dim3(grid), dim3(NWAVES * 64), LDS_BYTES, stream, a);
    }
#else
    a.ph_lo = 0; a.ph_hi = N_PHASES;
    hipLaunchKernelGGL(mega_fwd, dim3(grid), dim3(NWAVES * 64), LDS_BYTES, stream, a);
#endif
    const hipError_t le = hipPeekAtLastError();
    if (le != hipSuccess) fprintf(stderr, "kernel_launch: launch failed: %s (grid %d)\n", hipGetErrorName(le), grid);
}
```

```cpp
#include <hip/hip_runtime.h>
#include <cstdio>
#include <cstdint>
#ifndef PROBE_DUP
#define PROBE_DUP 0
#endif
namespace pg8 {
#define PG8_LAS __attribute__((address_space(3)))
typedef unsigned short bf16_t;
typedef short bf16x8 __attribute__((ext_vector_type(8)));
typedef float f32x4 __attribute__((ext_vector_type(4)));
typedef unsigned u32x4 __attribute__((ext_vector_type(4)));
constexpr int BM = 256, BK = 64, HALF = 128, HTB = HALF * BK * 2  , STAGE_BYTES = 8 * HTB, NXCD = 8, WGM = 8;

__host__ __device__ __forceinline__ int lds_byte(int r, int c) { const int st = (r >> 4) * 2 + (c >> 5), rr = r & 15, cc = c & 31, ob = rr * 64 + cc * 2; return st * 1024 + (ob ^ (((ob >> 9) & 1) << 5)); }
__host__ __device__ __forceinline__ void stage_rc(int b, int& R, int& C) { const int st = b / 1024, sb = b % 1024, swz = sb ^ (((sb >> 9) & 1) << 5); R = (st >> 1) * 16 + swz / 64; C = (st & 1) * 32 + (swz % 64) / 2; }
__host__ __device__ __forceinline__ int perm32(int rho) { const int n = rho >> 4, i = rho & 15; return 8 * (i >> 2) + 4 * n + (i & 3); }

struct Unit { int pm, pn; };
struct Gemm { const bf16_t* A; const bf16_t* Bt; int M, N, K; };

struct StaticOrder {
    int nM, nN, nwg, G, c;
    __host__ __device__ void init(int M, int N, int G_, int c_) { nM = M / BM; nN = N / BM; nwg = nM * nN; G = G_; c = c_; }
    __host__ __device__ bool next(int i, Unit& u) const {
        const long L = (long)i * G + c; if (L >= nwg) return false;
        int wgid = (int)L; { const int q = nwg / NXCD, r = nwg % NXCD, xcd = wgid % NXCD, off = wgid / NXCD; wgid = (xcd < r ? xcd * (q + 1) : r * (q + 1) + (xcd - r) * q) + off; }
        const int nig = WGM * nN, gid = wgid / nig, fm = gid * WGM, gsz = (nM - fm) < WGM ? (nM - fm) : WGM;
        u.pm = fm + ((wgid % nig) % gsz); u.pn = (wgid % nig) / gsz; return true;
    }
    __device__ __forceinline__ void a_ready(const Unit&) const {}
    __device__ __forceinline__ void done(const Unit&) const {}
};

typedef float f32x2c __attribute__((ext_vector_type(2))); typedef __bf16 bf16x2c __attribute__((ext_vector_type(2)));
__device__ __forceinline__ unsigned cvt_pk_bf16(float lo, float hi) { const f32x2c v = {lo, hi}; const bf16x2c b = __builtin_convertvector(v, bf16x2c); return __builtin_bit_cast(unsigned, b); }
typedef float f32x2 __attribute__((ext_vector_type(2)));
__device__ __forceinline__ float row_scale(const float* ssq, int row, int fq) {
    const f32x4* p = (const f32x4*)(ssq + (size_t)row * 32 + fq * 8);
    const f32x4 a = p[0], b = p[1];
    float s = ((a[0] + a[1]) + (a[2] + a[3])) + ((b[0] + b[1]) + (b[2] + b[3]));
    s += __shfl_xor(s, 16); s += __shfl_xor(s, 32);
    return __builtin_amdgcn_rsqf(s * (1.0f / 2048.0f) + 1e-6f);
}
struct EpiSwiglu {
    static constexpr bool PERM = true, AFTER_DRAIN = false;
    bf16_t* O; int ldc; const float* ssq; const PG8_LAS float* tab; int pm0;
    __device__ __forceinline__ void operator()(const f32x4 (&acc)[2][2][4][2], const Unit& u, int wr, int wc, int fr, int fq) const {
        const int row0 = u.pm * BM + wr * 64 + fr, col0 = u.pn * HALF + wc * 32 + 8 * fq;
        float sc[8];
        if (u.pm == pm0) {
#pragma unroll
            for (int q = 0; q < 8; ++q) sc[q] = tab[wr * 64 + fr + (q >> 2) * HALF + (q & 3) * 16];
        } else {
#pragma unroll
            for (int q = 0; q < 8; ++q) sc[q] = row_scale(ssq, row0 + (q >> 2) * HALF + (q & 3) * 16, fq);
        }
#pragma unroll
        for (int ai = 0; ai < 2; ++ai)
#pragma unroll
            for (int m = 0; m < 4; ++m) {
                const int row = row0 + ai * HALF + m * 16; const float s = sc[ai * 4 + m];
                const float k = s * -1.4426950408889634f, s2 = s * s;
                float o[8];
#pragma unroll
                for (int n = 0; n < 2; ++n)
#pragma unroll
                    for (int i = 0; i < 4; ++i) { const float g = acc[ai][0][m][n][i], up = acc[ai][1][m][n][i];
                        const float r = __builtin_amdgcn_rcpf(1.0f + __builtin_amdgcn_exp2f(g * k));
                        o[n * 4 + i] = (g * up) * (r * s2); }
                u32x4 w; w.x = cvt_pk_bf16(o[0], o[1]); w.y = cvt_pk_bf16(o[2], o[3]); w.z = cvt_pk_bf16(o[4], o[5]); w.w = cvt_pk_bf16(o[6], o[7]);
                *(u32x4*)(O + (size_t)row * ldc + col0) = w; }
    }
};
struct EpiScaleBf16 {
    static constexpr bool PERM = true, AFTER_DRAIN = false;
    bf16_t* O; size_t split_stride; const float* ssq; const PG8_LAS float* tab; int pm0;
    __device__ __forceinline__ void operator()(const f32x4 (&acc)[2][2][4][2], const Unit& u, int wr, int wc, int fr, int fq) const {
        const int row0 = u.pm * BM + wr * 64 + fr; const int t = u.pn >> 3;
        float sc[8];
        if (u.pm == pm0) {
#pragma unroll
            for (int q = 0; q < 8; ++q) sc[q] = tab[wr * 64 + fr + (q >> 2) * HALF + (q & 3) * 16];
        } else {
#pragma unroll
            for (int q = 0; q < 8; ++q) sc[q] = row_scale(ssq, row0 + (q >> 2) * HALF + (q & 3) * 16, fq);
        } bf16_t* base = O + (size_t)t * split_stride;
        const int col0 = (u.pn & 7) * BM + wc * 32 + 8 * fq;
#pragma unroll
        for (int ai = 0; ai < 2; ++ai)
#pragma unroll
            for (int m = 0; m < 4; ++m) {
                const int row = row0 + ai * HALF + m * 16; const float s = sc[ai * 4 + m];
                bf16_t* rowp = base + (size_t)row * 2048 + col0;
#pragma unroll
                for (int bj = 0; bj < 2; ++bj) { const f32x4 v0 = acc[ai][bj][m][0] * s, v1 = acc[ai][bj][m][1] * s;
                    u32x4 w; w.x = cvt_pk_bf16(v0[0], v0[1]); w.y = cvt_pk_bf16(v0[2], v0[3]); w.z = cvt_pk_bf16(v1[0], v1[1]); w.w = cvt_pk_bf16(v1[2], v1[3]);
                    *(u32x4*)(rowp + bj * HALF) = w; } }
    }
};
#ifndef RESID_LO
#define RESID_LO 0
#endif
__device__ __forceinline__ float bf_lo(unsigned w) { return __uint_as_float(w << 16); }
__device__ __forceinline__ float bf_hi(unsigned w) { return __uint_as_float(w & 0xffff0000u); }
struct EpiResid {
    static constexpr bool PERM = true, AFTER_DRAIN = false;
    const bf16_t* bhi; const void* blo; bf16_t* ohi; void* olo; float* ssq; float coef;
    __device__ __forceinline__ void operator()(const f32x4 (&acc)[2][2][4][2], const Unit& u, int wr, int wc, int fr, int fq) const {
        typedef unsigned u32x2v __attribute__((ext_vector_type(2))); typedef float f32x2v __attribute__((ext_vector_type(2)));
        const int row0 = u.pm * BM + wr * 64 + fr, col0 = u.pn * BM + wc * 32 + 8 * fq;
        float ssr[8];
#if RESID_LO == 2
        const char* hb = (const char*)bhi; const char* lb = (const char*)blo; char* ho = (char*)ohi; char* lo_ = (char*)olo;
        const unsigned hoff0 = ((unsigned)row0 * 2048u + (unsigned)col0) * 2u, loff0 = (unsigned)row0 * 2048u + (unsigned)(u.pn * BM + wc * 64 + fq * 16);
        const float c512 = 512.0f, i512 = 1.0f / 512.0f;
#pragma unroll
        for (int ai = 0; ai < 2; ++ai)
#pragma unroll
            for (int m = 0; m < 4; ++m) {
                const unsigned rofs = (unsigned)(ai * HALF + m * 16) * 2048u;
                const u32x4 h0 = *(const u32x4*)(hb + hoff0 + rofs * 2u), h1 = *(const u32x4*)(hb + hoff0 + rofs * 2u + HALF * 2), l16 = *(const u32x4*)(lb + loff0 + rofs);
                unsigned wh[8], wl[4] = {0u, 0u, 0u, 0u}; float ss = 0.f;
#pragma unroll
                for (int bj = 0; bj < 2; ++bj)
#pragma unroll
                    for (int j = 0; j < 4; ++j) { const unsigned hw = bj ? h1[j] : h0[j]; const unsigned lw = l16[2 * bj + (j >> 1)];
                        const f32x2v lf = (j & 1) ? __builtin_amdgcn_cvt_pk_f32_fp8((int)lw, true) : __builtin_amdgcn_cvt_pk_f32_fp8((int)lw, false);
                        const float a0 = acc[ai][bj][m][j >> 1][(2 * j) & 3], a1 = acc[ai][bj][m][j >> 1][(2 * j + 1) & 3];
                        const float o0 = __builtin_fmaf(a0, coef, __builtin_fmaf(lf.x, i512, bf_lo(hw))), o1 = __builtin_fmaf(a1, coef, __builtin_fmaf(lf.y, i512, bf_hi(hw)));
                        const unsigned nh = cvt_pk_bf16(o0, o1); wh[4 * bj + j] = nh;
                        const float r0 = (o0 - bf_lo(nh)) * c512, r1 = (o1 - bf_hi(nh)) * c512;
                        wl[2 * bj + (j >> 1)] = (j & 1) ? (unsigned)__builtin_amdgcn_cvt_pk_fp8_f32(r0, r1, (int)wl[2 * bj + (j >> 1)], true) : (unsigned)__builtin_amdgcn_cvt_pk_fp8_f32(r0, r1, (int)wl[2 * bj + (j >> 1)], false);
                        ss = __builtin_fmaf(o0, o0, ss); ss = __builtin_fmaf(o1, o1, ss); }
                *(u32x4*)(ho + hoff0 + rofs * 2u) = (u32x4){wh[0], wh[1], wh[2], wh[3]}; *(u32x4*)(ho + hoff0 + rofs * 2u + HALF * 2) = (u32x4){wh[4], wh[5], wh[6], wh[7]};
                *(u32x4*)(lo_ + loff0 + rofs) = (u32x4){wl[0], wl[1], wl[2], wl[3]};
                ss += __shfl_xor(ss, 16); ss += __shfl_xor(ss, 32); ssr[ai * 4 + m] = ss;
                if (m == 3) asm volatile("" ::: "memory");
            }
#elif RESID_LO == 0
        const char* hb = (const char*)bhi; char* ho = (char*)ohi;
        const unsigned hoff0 = ((unsigned)row0 * 2048u + (unsigned)col0) * 2u;
#pragma unroll
        for (int ai = 0; ai < 2; ++ai)
#pragma unroll
            for (int m = 0; m < 4; ++m) {
                const unsigned rofs = (unsigned)(ai * HALF + m * 16) * 4096u;
                const u32x4 h0 = *(const u32x4*)(hb + hoff0 + rofs), h1 = *(const u32x4*)(hb + hoff0 + rofs + HALF * 2);
                unsigned wh[8]; float ss = 0.f;
#pragma unroll
                for (int bj = 0; bj < 2; ++bj)
#pragma unroll
                    for (int j = 0; j < 4; ++j) { const unsigned hw = bj ? h1[j] : h0[j];
                        const float a0 = acc[ai][bj][m][j >> 1][(2 * j) & 3], a1 = acc[ai][bj][m][j >> 1][(2 * j + 1) & 3];
                        const float o0 = __builtin_fmaf(a0, coef, bf_lo(hw)), o1 = __builtin_fmaf(a1, coef, bf_hi(hw));
                        wh[4 * bj + j] = cvt_pk_bf16(o0, o1);
                        ss = __builtin_fmaf(o0, o0, ss); ss = __builtin_fmaf(o1, o1, ss); }
                *(u32x4*)(ho + hoff0 + rofs) = (u32x4){wh[0], wh[1], wh[2], wh[3]}; *(u32x4*)(ho + hoff0 + rofs + HALF * 2) = (u32x4){wh[4], wh[5], wh[6], wh[7]};
                ss += __shfl_xor(ss, 16); ss += __shfl_xor(ss, 32); ssr[ai * 4 + m] = ss;
                if (m == 3) asm volatile("" ::: "memory");
            }
#else
#pragma unroll
        for (int ai = 0; ai < 2; ++ai)
#pragma unroll
            for (int m = 0; m < 4; ++m) {
                const int q = ai * 4 + m; const int row = row0 + ai * HALF + m * 16; const size_t off = (size_t)row * 2048 + col0; float ss = 0.f;
                u32x4 hvq[2], lvq[2]; u32x2v l8q[2];
#pragma unroll
                for (int bj = 0; bj < 2; ++bj) { hvq[bj] = *(const u32x4*)(bhi + off + bj * HALF);
                    if (RESID_LO == 1) lvq[bj] = *(const u32x4*)((const bf16_t*)blo + off + bj * HALF);
                }
                if (RESID_LO == 2) { const u32x4 l16 = *(const u32x4*)((const unsigned char*)blo + (size_t)row * 2048 + u.pn * BM + wc * 64 + fq * 16);
                    l8q[0] = (u32x2v){l16[0], l16[1]}; l8q[1] = (u32x2v){l16[2], l16[3]}; }
                u32x4 w16 = {0u, 0u, 0u, 0u};
#pragma unroll
                for (int bj = 0; bj < 2; ++bj) { float o[8]; u32x4 wh, wl; u32x2v w8 = {0u, 0u};
#pragma unroll
                    for (int j = 0; j < 4; ++j) { const unsigned hw = hvq[bj][j]; float b0 = bf_lo(hw), b1 = bf_hi(hw);
                        if (RESID_LO == 1) { const unsigned lw = lvq[bj][j]; b0 += bf_lo(lw); b1 += bf_hi(lw); }
                        if (RESID_LO == 2) { const f32x2v lf = (j & 1) ? __builtin_amdgcn_cvt_pk_f32_fp8((int)l8q[bj][j >> 1], true) : __builtin_amdgcn_cvt_pk_f32_fp8((int)l8q[bj][j >> 1], false);
                            b0 += lf.x * (1.0f / 512.0f); b1 += lf.y * (1.0f / 512.0f); }
                        o[2 * j] = b0 + acc[ai][bj][m][j >> 1][(2 * j) & 3] * coef; o[2 * j + 1] = b1 + acc[ai][bj][m][j >> 1][(2 * j + 1) & 3] * coef;
                        const unsigned nh = cvt_pk_bf16(o[2 * j], o[2 * j + 1]); wh[j] = nh;
                        if (RESID_LO == 1) wl[j] = cvt_pk_bf16(o[2 * j] - bf_lo(nh), o[2 * j + 1] - bf_hi(nh));
                        if (RESID_LO == 2) { const float r0 = (o[2 * j] - bf_lo(nh)) * 512.0f, r1 = (o[2 * j + 1] - bf_hi(nh)) * 512.0f;
                            w8[j >> 1] = (j & 1) ? (unsigned)__builtin_amdgcn_cvt_pk_fp8_f32(r0, r1, (int)w8[j >> 1], true) : (unsigned)__builtin_amdgcn_cvt_pk_fp8_f32(r0, r1, (int)w8[j >> 1], false); }
                        ss += o[2 * j] * o[2 * j] + o[2 * j + 1] * o[2 * j + 1]; }
                    *(u32x4*)(ohi + off + bj * HALF) = wh;
                    if (RESID_LO == 1) *(u32x4*)((bf16_t*)olo + off + bj * HALF) = wl;
                    if (RESID_LO == 2) { w16[2 * bj] = w8[0]; w16[2 * bj + 1] = w8[1]; } }
                if (RESID_LO == 2) *(u32x4*)((unsigned char*)olo + (size_t)row * 2048 + u.pn * BM + wc * 64 + fq * 16) = w16;
                ss += __shfl_xor(ss, 16); ss += __shfl_xor(ss, 32); ssr[q] = ss;
                if (m == 3) asm volatile("" ::: "memory");
            }
#endif
        { const float v0 = fq == 0 ? ssr[0] : fq == 1 ? ssr[2] : fq == 2 ? ssr[4] : ssr[6], v1 = fq == 0 ? ssr[1] : fq == 1 ? ssr[3] : fq == 2 ? ssr[5] : ssr[7];
          float* p = ssq + (size_t)(row0 + (fq >> 1) * HALF + (fq & 1) * 32) * 32 + u.pn * 4 + wc; p[0] = v0; p[16 * 32] = v1; }
    }
};

template <class E1> struct EpiTwice {
    static constexpr bool PERM = E1::PERM, AFTER_DRAIN = false;
    E1 a, b;
    __device__ __forceinline__ void operator()(const f32x4 (&acc)[2][2][4][2], const Unit& u, int wr, int wc, int fr, int fq) const { a(acc, u, wr, wc, fr, fq); asm volatile("" ::: "memory"); b(acc, u, wr, wc, fr, fq); }
};
template <class Epi, class Sched, bool ALIGN_EPI = false, bool SP2 = false>
__device__ __forceinline__ void gemm_phase(PG8_LAS unsigned char* lds, const Gemm g, const Sched& S, const Epi& E, const int tid) {
    const int wid = __builtin_amdgcn_readfirstlane(tid >> 6), lane = tid & 63, wr = wid >> 2, wc = wid & 3, fr = lane & 15, fq = lane >> 4;
    const int K = g.K, nt = K / BK;
    unsigned voffA[2], voffB[2];
#pragma unroll
    for (int i = 0; i < 2; ++i) { int R, C; stage_rc(tid * 16 + i * 8192, R, C); const int Rb = Epi::PERM ? ((R & ~31) + perm32(R & 31)) : R;
        voffA[i] = (unsigned)(R * K + C) * 2u; voffB[i] = (unsigned)(Rb * K + C) * 2u; }
    const size_t kstep = (size_t)(BK * 2);
    const size_t hstep = (size_t)HALF * K * 2;
    const size_t tstep = 2 * hstep;
    const unsigned ldsw = (unsigned)wid * 1024u;
    const int aoff = lds_byte(wr * 64 + fr, fq * 8), boff = lds_byte(wc * 32 + fr, fq * 8);
#define PG8_SA(b, h) (((b) * 2 + (h)) * HTB)
#define PG8_SB(b, h) ((4 + (b) * 2 + (h)) * HTB)
#define PG8_STAGE(bufoff, gbase, voff) do { _Pragma("unroll") for (int _i = 0; _i < 2; ++_i) \
        __builtin_amdgcn_global_load_lds((const unsigned*)((const char*)(gbase) + (voff)[_i]), (PG8_LAS unsigned*)(lds + (bufoff) + ldsw + _i * 8192), 16, 0, 0); } while (0)
#define PG8_LDA(dst, b, h) do { _Pragma("unroll") for (int m = 0; m < 4; ++m) _Pragma("unroll") for (int k = 0; k < 2; ++k) dst[m][k] = *(const PG8_LAS bf16x8*)(lds + PG8_SA(b, h) + aoff + m * 2048 + k * 1024); } while (0)
#define PG8_LDB(dst, b, h) do { _Pragma("unroll") for (int n = 0; n < 2; ++n) _Pragma("unroll") for (int k = 0; k < 2; ++k) dst[n][k] = *(const PG8_LAS bf16x8*)(lds + PG8_SB(b, h) + boff + n * 2048 + k * 1024); } while (0)
#define PG8_MMA(ai, bj, At, Bt) do { __builtin_amdgcn_s_setprio(1); _Pragma("unroll") for (int m = 0; m < 4; ++m) _Pragma("unroll") for (int n = 0; n < 2; ++n) _Pragma("unroll") for (int k = 0; k < 2; ++k) \
        acc[ai][bj][m][n] = __builtin_amdgcn_mfma_f32_16x16x32_bf16(Bt[n][k], At[m][k], acc[ai][bj][m][n], 0, 0, 0); __builtin_amdgcn_s_setprio(0); } while (0)
#define PG8_WAIT_V(n) asm volatile("s_waitcnt vmcnt(" #n ")" ::: "memory")
#define PG8_WAIT_L(n) asm volatile("s_waitcnt lgkmcnt(" #n ")" ::: "memory")
#define PG8_BAR __builtin_amdgcn_s_barrier()
#define PG8_SCHED __builtin_amdgcn_sched_barrier(0)
    Unit cur, nxt; int ui = 0;
    if (!S.next(0, cur)) return;
    f32x4 acc[2][2][4][2];
#pragma unroll
    for (int a = 0; a < 2; ++a)
#pragma unroll
        for (int b = 0; b < 2; ++b)
#pragma unroll
            for (int m = 0; m < 4; ++m)
#pragma unroll
                for (int n = 0; n < 2; ++n) acc[a][b][m][n] = (f32x4){0.f, 0.f, 0.f, 0.f};
    bf16x8 At[4][2], B0[2][2], B1[2][2];
    const char* cA = (const char*)g.A + (size_t)cur.pm * tstep; const char* cB = (const char*)g.Bt + (size_t)cur.pn * tstep;
    S.a_ready(cur);
    if constexpr (SP2) {
        PG8_STAGE(PG8_SB(0, 0), cB, voffB); PG8_STAGE(PG8_SB(0, 1), cB + hstep, voffB); PG8_STAGE(PG8_SA(0, 0), cA, voffA); PG8_STAGE(PG8_SA(0, 1), cA + hstep, voffA);
        if (wr == 1) PG8_BAR;
        PG8_WAIT_V(2); PG8_BAR;
        PG8_STAGE(PG8_SB(1, 0), cB + kstep, voffB); PG8_STAGE(PG8_SA(1, 0), cA + kstep, voffA); PG8_STAGE(PG8_SB(1, 1), cB + hstep + kstep, voffB);
        PG8_WAIT_V(6); PG8_BAR;
    } else {
        PG8_STAGE(PG8_SB(0, 0), cB, voffB); PG8_STAGE(PG8_SA(0, 0), cA, voffA); PG8_STAGE(PG8_SB(0, 1), cB + hstep, voffB); PG8_STAGE(PG8_SA(0, 1), cA + hstep, voffA);
        if (wr == 1) PG8_BAR;
        PG8_WAIT_V(4); PG8_BAR;
        PG8_STAGE(PG8_SB(1, 0), cB + kstep, voffB); PG8_STAGE(PG8_SA(1, 0), cA + kstep, voffA); PG8_STAGE(PG8_SB(1, 1), cB + hstep + kstep, voffB);
        PG8_WAIT_V(6); PG8_BAR;
    }
    for (;;) {
        const bool has_next = S.next(ui + 1, nxt);
        const char* nA = has_next ? (const char*)g.A + (size_t)nxt.pm * tstep : cA; const char* nB = has_next ? (const char*)g.Bt + (size_t)nxt.pn * tstep : cB;
        for (int t = 0; t < nt; t += 2) {
            const bool last = (t == nt - 2);
            const char* a1 = cA + (size_t)(t + 1) * kstep;
            const char* a2 = last ? nA : cA + (size_t)(t + 2) * kstep; const char* b2 = last ? nB : cB + (size_t)(t + 2) * kstep;
            const char* a3 = a2 + kstep; const char* b3 = b2 + kstep;
            if (last && has_next) S.a_ready(nxt);
            if constexpr (SP2) {
            PG8_LDB(B0, 0, 0); PG8_LDB(B1, 0, 1); PG8_SCHED; PG8_LDA(At, 0, 0); PG8_STAGE(PG8_SA(1, 1), a1 + hstep, voffA);
            PG8_WAIT_V(8); PG8_WAIT_L(0); PG8_BAR; PG8_MMA(0, 0, At, B0); PG8_MMA(0, 1, At, B1); PG8_BAR; PG8_SCHED;
            PG8_LDA(At, 0, 1); PG8_STAGE(PG8_SB(0, 0), b2, voffB); PG8_STAGE(PG8_SB(0, 1), b2 + hstep, voffB); PG8_STAGE(PG8_SA(0, 0), a2, voffA);
            PG8_WAIT_V(8); PG8_WAIT_L(0); PG8_BAR; PG8_MMA(1, 0, At, B0); PG8_MMA(1, 1, At, B1); PG8_BAR; PG8_SCHED;
            PG8_LDB(B0, 1, 0); PG8_LDB(B1, 1, 1); PG8_SCHED; PG8_LDA(At, 1, 0); PG8_STAGE(PG8_SA(0, 1), a2 + hstep, voffA);
            PG8_WAIT_V(8); PG8_WAIT_L(0); PG8_BAR; PG8_MMA(0, 0, At, B0); PG8_MMA(0, 1, At, B1); PG8_BAR; PG8_SCHED;
            PG8_LDA(At, 1, 1); PG8_STAGE(PG8_SB(1, 0), b3, voffB); PG8_STAGE(PG8_SB(1, 1), b3 + hstep, voffB); PG8_STAGE(PG8_SA(1, 0), a3, voffA);
            PG8_WAIT_V(8); PG8_WAIT_L(0); PG8_BAR; PG8_MMA(1, 0, At, B0); PG8_MMA(1, 1, At, B1); PG8_BAR; PG8_SCHED;
            } else {
            PG8_LDB(B0, 0, 0); PG8_SCHED; PG8_LDA(At, 0, 0); PG8_STAGE(PG8_SA(1, 1), a1 + hstep, voffA);
            PG8_WAIT_L(8); PG8_BAR; PG8_WAIT_L(0); PG8_MMA(0, 0, At, B0); PG8_BAR; PG8_SCHED;
            PG8_LDB(B1, 0, 1); PG8_STAGE(PG8_SB(0, 0), b2, voffB);
            PG8_BAR; PG8_WAIT_L(0); PG8_MMA(0, 1, At, B1); PG8_BAR;
            PG8_LDA(At, 0, 1); PG8_STAGE(PG8_SA(0, 0), a2, voffA);
            PG8_BAR; PG8_WAIT_L(0); PG8_MMA(1, 0, At, B0); PG8_BAR; PG8_SCHED;
            PG8_STAGE(PG8_SB(0, 1), b2 + hstep, voffB);
            PG8_WAIT_V(6); PG8_BAR; PG8_MMA(1, 1, At, B1); PG8_BAR;
            PG8_LDB(B0, 1, 0); PG8_SCHED; PG8_LDA(At, 1, 0); PG8_STAGE(PG8_SA(0, 1), a2 + hstep, voffA);
            PG8_WAIT_L(8); PG8_BAR; PG8_WAIT_L(0); PG8_MMA(0, 0, At, B0); PG8_BAR; PG8_SCHED;
            PG8_LDB(B1, 1, 1); PG8_STAGE(PG8_SB(1, 0), b3, voffB);
            PG8_BAR; PG8_WAIT_L(0); PG8_MMA(0, 1, At, B1); PG8_BAR;
            PG8_LDA(At, 1, 1); PG8_STAGE(PG8_SA(1, 0), a3, voffA);
            PG8_BAR; PG8_WAIT_L(0); PG8_MMA(1, 0, At, B0); PG8_BAR; PG8_SCHED;
            PG8_STAGE(PG8_SB(1, 1), b3 + hstep, voffB);
            PG8_WAIT_V(6); PG8_BAR; PG8_MMA(1, 1, At, B1); PG8_BAR;
            }
        }
        if constexpr (ALIGN_EPI) { if (wr == 0) PG8_BAR; }
        if constexpr (!Epi::AFTER_DRAIN) { E(acc, cur, wr, wc, fr, fq); S.done(cur); }
        if (!has_next) break;
#pragma unroll
        for (int a = 0; a < 2; ++a)
#pragma unroll
            for (int b = 0; b < 2; ++b)
#pragma unroll
                for (int m = 0; m < 4; ++m)
#pragma unroll
                    for (int n = 0; n < 2; ++n) acc[a][b][m][n] = (f32x4){0.f, 0.f, 0.f, 0.f};
        cur = nxt; cA = nA; cB = nB; ++ui;
        if constexpr (ALIGN_EPI) { if (wr == 1) PG8_BAR; }
    }
    PG8_WAIT_V(0);
    if constexpr (!ALIGN_EPI) { if (wr == 0) PG8_BAR; }
    PG8_BAR;
    if constexpr (Epi::AFTER_DRAIN) { E.fused(acc, cur, wr, wc, fr, fq, lds, wid, lane); S.done(cur); }
#undef PG8_SA
#undef PG8_SB
#undef PG8_STAGE
#undef PG8_LDA
#undef PG8_LDB
#undef PG8_MMA
#undef PG8_WAIT_V
#undef PG8_WAIT_L
#undef PG8_BAR
#undef PG8_SCHED
}
}

#define GAS __attribute__((address_space(1)))
#define LAS __attribute__((address_space(3)))
typedef unsigned short bf16;
typedef unsigned v4u __attribute__((ext_vector_type(4)));
typedef float f32x4 __attribute__((ext_vector_type(4)));
typedef short bf16x8 __attribute__((ext_vector_type(8)));
typedef GAS unsigned gu32;
typedef GAS unsigned long long gu64;
#define RLX_AGENT __ATOMIC_RELAXED, __HIP_MEMORY_SCOPE_AGENT
#define LDS_WAIT() asm volatile("s_waitcnt lgkmcnt(0)" ::: "memory")
#define VM_WAIT() asm volatile("s_waitcnt vmcnt(0)" ::: "memory")
__device__ __forceinline__ unsigned long long rt() { return __builtin_amdgcn_s_memrealtime(); }
__device__ __forceinline__ unsigned f2bf(float f) { unsigned u = __builtin_bit_cast(unsigned, f); return (u + 0x7fffu + ((u >> 16) & 1u)) >> 16; }
__device__ __forceinline__ unsigned pk2(float lo, float hi) { return f2bf(lo) | (f2bf(hi) << 16); }

#define XB_TMO      128
#define XB_XCNT(j)  (256  + 64 * (j))
#define XB_XSUB(j)  (1280 + 64 * (j))
#define XB_XGEN(j)  (2304 + 64 * (j))
#define XB_TOP      3328
#define XB_TOPGEN   3392
#define XCD_BAR_WORDS 3456
#define XB_SPIN_CAP (1u << 18)

__device__ __forceinline__ unsigned xb_ld(unsigned* p)              { return __hip_atomic_load(p, __ATOMIC_RELAXED, __HIP_MEMORY_SCOPE_AGENT); }
__device__ __forceinline__ unsigned xb_add(unsigned* p, unsigned v) { return __hip_atomic_fetch_add(p, v, __ATOMIC_RELAXED, __HIP_MEMORY_SCOPE_AGENT); }
__device__ __forceinline__ unsigned xb_xcc_id() { return (unsigned)__builtin_amdgcn_s_getreg((3 << 11) | 20) & 0xFu; }
#define XB_SPIN(cond, bar) do { unsigned _sp = 0; while (cond) { __builtin_amdgcn_s_sleep(1); \
    if ((++_sp & 255u) == 0u) { if (xb_ld(&(bar)[XB_TMO])) break; if (_sp > XB_SPIN_CAP) { atomicAdd(&(bar)[XB_TMO], 1u); break; } } } } while (0)

struct XcdBarrier {
    unsigned* bar; unsigned x;
    volatile LAS unsigned* st;
};

__device__ __forceinline__ XcdBarrier xcd_barrier_post(unsigned* bar, volatile LAS unsigned* st) {
    XcdBarrier b; b.bar = bar; b.x = xb_xcc_id(); b.st = st;
    if (threadIdx.x == 0) { const unsigned rk = xb_add(&bar[XB_XCNT(b.x)], 1u); st[2] = rk; st[3] = b.x; }
    return b;
}
__device__ __forceinline__ void xcd_barrier_complete(unsigned* bar, unsigned x, unsigned& nloc, unsigned& nx) {
    const unsigned G = gridDim.x * gridDim.y * gridDim.z;
    unsigned sum, cnt, mine, sp = 0u;
    for (;;) {
        sum = 0u; cnt = 0u; mine = 0u;
#pragma unroll
        for (unsigned j = 0; j < 16; ++j) { const unsigned c = xb_ld(&bar[XB_XCNT(j)]); sum += c; cnt += (c > 0u) ? 1u : 0u; mine = (j == x) ? c : mine; }
        if (sum == G) break;
        __builtin_amdgcn_s_sleep(1);
        if ((++sp & 255u) == 0u) { if (xb_ld(&bar[XB_TMO])) break; if (sp > XB_SPIN_CAP) { atomicAdd(&bar[XB_TMO], 1u); break; } }
    }
    nloc = mine > 0u ? mine : 1u; nx = cnt > 0u ? cnt : 1u;
}

__device__ __forceinline__ void xcd_barrier_t0(const XcdBarrier& b) {
        unsigned* bar = b.bar;
        __builtin_amdgcn_s_waitcnt(0);
        unsigned nloc = b.st[0], nx = b.st[1];
        if (nloc == 0u) { xcd_barrier_complete(bar, b.x, nloc, nx); b.st[0] = nloc; b.st[1] = nx; }
        const unsigned old = xb_add(&bar[XB_XSUB(b.x)], 1u);
        const unsigned gen = old / nloc;
        if (old + 1u == (gen + 1u) * nloc) {
            __builtin_amdgcn_fence(__ATOMIC_RELEASE, "agent");
            asm volatile("s_waitcnt vmcnt(0)" ::: "memory");
            const unsigned og = xb_add(&bar[XB_TOP], 1u);
            const unsigned tg = og / nx;
            if (og + 1u == (tg + 1u) * nx) xb_add(&bar[XB_TOPGEN], 1u);
            else XB_SPIN(xb_ld(&bar[XB_TOPGEN]) == tg, bar);
            __builtin_amdgcn_fence(__ATOMIC_ACQUIRE, "agent");
            xb_add(&bar[XB_XGEN(b.x)], 1u);
            asm volatile("s_waitcnt vmcnt(0)" ::: "memory");
        } else {
            XB_SPIN(xb_ld(&bar[XB_XGEN(b.x)]) == gen, bar);
            __builtin_amdgcn_fence(__ATOMIC_ACQUIRE, "agent");
            asm volatile("s_waitcnt vmcnt(0)" ::: "memory");
        }
}
__device__ __forceinline__ void xcd_barrier(const XcdBarrier& b) {
    asm volatile("s_waitcnt vmcnt(0)" ::: "memory");
    __syncthreads();
    if (threadIdx.x == 0) xcd_barrier_t0(b);
    __syncthreads();
}
template <class Fn> __device__ __forceinline__ void xcd_barrier_side(const XcdBarrier& b, int wave, const Fn& side) {
    asm volatile("s_waitcnt vmcnt(0)" ::: "memory");
    __syncthreads();
    if (wave == 0) { if (threadIdx.x == 0) xcd_barrier_t0(b); }
    else side();
    __syncthreads();
}

constexpr int BATCH = 4, SEQ = 2048, DM = 2048, NH = 16, HD = 128, FF = 5632, DEPTH = 4;
constexpr int M = BATCH * SEQ;
constexpr float RMS_EPS = 1e-6f;
constexpr int NWAVES = 8;

constexpr size_t MiB = 1u << 20;
constexpr size_t WS_CTL = 0, CTL_ZERO_BYTES = 1 * MiB;
constexpr size_t WS_SSQ = 1 * MiB;
constexpr size_t WS_H = 2 * MiB;
constexpr size_t WS_HB = 66 * MiB;
constexpr size_t WS_Q = 98 * MiB, WS_K = 130 * MiB, WS_V = 162 * MiB;
constexpr size_t WS_MIX = 194 * MiB;
constexpr size_t WS_ACT = 226 * MiB;
constexpr size_t WS_W = 320 * MiB;
constexpr size_t W_FFN_STRIDE = 66 * MiB, W_FFN_DOWN = 44 * MiB;
constexpr size_t WS_WATT = WS_W + 8 * W_FFN_STRIDE;
constexpr size_t WS_END = WS_WATT + 112 * MiB;
constexpr int CW_BAR = 4096;

constexpr int RING_OFF = 0;
constexpr int SCALE_OFF = 135168;
constexpr int LDSCTL_OFF = 139264;
constexpr int LDS_BYTES = 147456;

namespace att {
using bf16x8 = __attribute__((ext_vector_type(8))) short;
using s16x4  = __attribute__((ext_vector_type(4))) short;
using f32x16 = __attribute__((ext_vector_type(16))) float;
using u32x4  = __attribute__((ext_vector_type(4))) unsigned;
constexpr int D = 128, QBLK = 32, KVBLK = 64, PITCH = 2048;
constexpr float SCALE = 0.088388347648318440f, LOG2E = 1.4426950408889634f;
constexpr int SHM_V = KVBLK * D * 2, SHM_K = KVBLK * D * 2;
constexpr int OST_ROW = 272, OST_WAVE = 32 * OST_ROW;
constexpr int OFF_V = 0, OFF_K = 2 * SHM_V, OFF_WS = NWAVES * OST_WAVE, OFF_BIAS = OFF_WS + NWAVES * 256;
static_assert(OFF_WS >= 2 * SHM_V + 2 * SHM_K && OFF_BIAS + (513 + 64) * 4 <= 131072, "attention LDS map");
#define KSWZ(row, colB) ((row) * 256 + ((colB) ^ (((row) & 7) << 4)))
#define SBAR() __builtin_amdgcn_sched_barrier(0)
__device__ __forceinline__ int crow(int r, int hi) { return (r & 3) + 8 * (r >> 2) + 4 * hi; }
__device__ __forceinline__ unsigned cvtpk(float lo, float hi) { unsigned r; asm volatile("v_cvt_pk_bf16_f32 %0, %1, %2" : "=v"(r) : "v"(lo), "v"(hi)); return r; }
__device__ __forceinline__ void qkt(f32x16& p0, f32x16& p1, const char* Ks, const bf16x8* qr, int r32, int hi) {
  p0 = f32x16{}; p1 = f32x16{};
  bf16x8 ka[4], kb[4];
#pragma unroll
  for (int hb = 0; hb < 2; ++hb) {
#pragma unroll
    for (int d = 0; d < 4; ++d) { const int cb = ((hb * 4 + d) * 16 + hi * 8) * 2;
      ka[d] = *reinterpret_cast<const bf16x8*>(Ks + KSWZ(r32, cb)); kb[d] = *reinterpret_cast<const bf16x8*>(Ks + KSWZ(32 + r32, cb)); }
    SBAR();
#pragma unroll
    for (int d = 0; d < 4; ++d) {
      p0 = __builtin_amdgcn_mfma_f32_32x32x16_bf16(ka[d], qr[hb * 4 + d], p0, 0, 0, 0);
      p1 = __builtin_amdgcn_mfma_f32_32x32x16_bf16(kb[d], qr[hb * 4 + d], p1, 0, 0, 0); }
    SBAR();
  }
}
__device__ __forceinline__ int v_st(int k, int c) { const int kk = (k & ~0xC) | ((k & 4) << 1) | ((k & 8) >> 1); return ((kk >> 3) * 4 + (c >> 5)) * 512 + ((kk & 7) * 32 + (c & 31)) * 2; }
__device__ __forceinline__ int v_rd_base(int lane) { return ((lane & 3) << 3) | (((lane >> 2) & 3) << 6) | (((lane >> 4) & 1) << 5) | (((lane >> 5) & 1) << 8); }
constexpr int v_rd_off(int d0, int ks, int half) { return d0 * 512 + ks * 4096 + half * 2048; }
template <int OFF> __device__ __forceinline__ s16x4 tr_read(int vb) {
  s16x4 r; asm volatile("ds_read_b64_tr_b16 %0, %1 offset:%2" : "=&v"(r) : "v"(vb), "i"(OFF) : "memory"); return r;
}
struct VFrag { s16x4 l0, h0, l1, h1, l2, h2, l3, h3; };
template <int D0> __device__ __forceinline__ void v_reads(VFrag& f, int vb) {
  f.l0 = tr_read<v_rd_off(D0, 0, 0)>(vb); f.h0 = tr_read<v_rd_off(D0, 0, 1)>(vb); f.l1 = tr_read<v_rd_off(D0, 1, 0)>(vb); f.h1 = tr_read<v_rd_off(D0, 1, 1)>(vb);
  f.l2 = tr_read<v_rd_off(D0, 2, 0)>(vb); f.h2 = tr_read<v_rd_off(D0, 2, 1)>(vb); f.l3 = tr_read<v_rd_off(D0, 3, 0)>(vb); f.h3 = tr_read<v_rd_off(D0, 3, 1)>(vb);
}
__device__ __forceinline__ void pv_mma(f32x16& od, const VFrag& f, bf16x8 pa0, bf16x8 pa1, bf16x8 pa2, bf16x8 pa3) {
#define PK(L, H) (bf16x8){L[0], L[1], L[2], L[3], H[0], H[1], H[2], H[3]}
  od = __builtin_amdgcn_mfma_f32_32x32x16_bf16(pa0, PK(f.l0, f.h0), od, 0, 0, 0);
  od = __builtin_amdgcn_mfma_f32_32x32x16_bf16(pa1, PK(f.l1, f.h1), od, 0, 0, 0);
  od = __builtin_amdgcn_mfma_f32_32x32x16_bf16(pa2, PK(f.l2, f.h2), od, 0, 0, 0);
  od = __builtin_amdgcn_mfma_f32_32x32x16_bf16(pa3, PK(f.l3, f.h3), od, 0, 0, 0);
#undef PK
}
__device__ __forceinline__ void pv_d0(f32x16* o, int vb, bf16x8 pa0, bf16x8 pa1, bf16x8 pa2, bf16x8 pa3) {
  VFrag fa, fb;
  v_reads<0>(fa, vb); v_reads<1>(fb, vb);
  asm volatile("s_waitcnt lgkmcnt(8)" ::: "memory"); SBAR(); pv_mma(o[0], fa, pa0, pa1, pa2, pa3); SBAR();
  v_reads<2>(fa, vb);
  asm volatile("s_waitcnt lgkmcnt(8)" ::: "memory"); SBAR(); pv_mma(o[1], fb, pa0, pa1, pa2, pa3); SBAR();
  v_reads<3>(fb, vb);
  asm volatile("s_waitcnt lgkmcnt(8)" ::: "memory"); SBAR(); pv_mma(o[2], fa, pa0, pa1, pa2, pa3); SBAR();
  asm volatile("s_waitcnt lgkmcnt(0)" ::: "memory"); SBAR(); pv_mma(o[3], fb, pa0, pa1, pa2, pa3);
}
__device__ __forceinline__ void pack_p(const f32x16& p0, const f32x16& p1, bf16x8& pa0, bf16x8& pa1, bf16x8& pa2, bf16x8& pa3) {
#define PK4(P, BASE, OUT) do { unsigned a0 = cvtpk(P[BASE + 0], P[BASE + 1]), a1 = cvtpk(P[BASE + 2], P[BASE + 3]);   \
    unsigned b0 = cvtpk(P[BASE + 4], P[BASE + 5]), b1 = cvtpk(P[BASE + 6], P[BASE + 7]);                              \
    auto r0 = __builtin_amdgcn_permlane32_swap(a0, b0, false, false); auto r1 = __builtin_amdgcn_permlane32_swap(a1, b1, false, false); \
    u32x4 w = {r0[0], r1[0], r0[1], r1[1]}; OUT = *reinterpret_cast<bf16x8*>(&w); } while (0)
  PK4(p0, 0, pa0); PK4(p0, 8, pa1); PK4(p1, 0, pa2); PK4(p1, 8, pa3);
#undef PK4
}
__device__ __forceinline__ void swap2(float x, float& lo, float& hi) {
  auto rr = __builtin_amdgcn_permlane32_swap(__float_as_uint(x), __float_as_uint(x), false, false); lo = __uint_as_float(rr[0]); hi = __uint_as_float(rr[1]);
}
__device__ __forceinline__ unsigned short f2bf1(float f) { return (unsigned short)(cvtpk(f, 0.f) & 0xffffu); }

struct Stg { bf16x8 vs0, vs1, ks0, ks1; };
__device__ __forceinline__ void sload(Stg& s, const unsigned short* Kh, const unsigned short* Vh, int k0, int sr, int sc) {
  s.vs0 = *reinterpret_cast<const bf16x8*>(Vh + (size_t)(k0 + sr) * PITCH + sc); s.vs1 = *reinterpret_cast<const bf16x8*>(Vh + (size_t)(k0 + 32 + sr) * PITCH + sc);
  s.ks0 = *reinterpret_cast<const bf16x8*>(Kh + (size_t)(k0 + sr) * PITCH + sc); s.ks1 = *reinterpret_cast<const bf16x8*>(Kh + (size_t)(k0 + 32 + sr) * PITCH + sc);
}
__device__ __forceinline__ void swrite(const Stg& s, char* lds, int buf, int sr, int sc, int vst0, int vst1) {
  *(bf16x8*)(lds + OFF_V + buf * SHM_V + vst0) = s.vs0; *(bf16x8*)(lds + OFF_V + buf * SHM_V + vst1) = s.vs1; const int kc = sc * 2;
  *(bf16x8*)(lds + OFF_K + buf * SHM_K + KSWZ(sr, kc)) = s.ks0; *(bf16x8*)(lds + OFF_K + buf * SHM_K + KSWZ(32 + sr, kc)) = s.ks1;
}
__device__ __forceinline__ void store_o(const f32x16* o, const float* rs, unsigned short* Ow, int r32, int hi, char* lds, int wid, int lane) {
  char* stg = lds + wid * OST_WAVE;
#pragma unroll
  for (int r = 0; r < 16; ++r) { const int orow = crow(r, hi);
#pragma unroll
    for (int d0 = 0; d0 < 4; ++d0) *(unsigned short*)(stg + orow * OST_ROW + (d0 * 32 + r32) * 2) = f2bf1(o[d0][r] * rs[r]); }
  asm volatile("s_waitcnt lgkmcnt(0)" ::: "memory");
#pragma unroll
  for (int j = 0; j < 8; ++j) { const int row = (lane >> 4) + 4 * j; const u32x4 v = *(const u32x4*)(stg + row * OST_ROW + (lane & 15) * 16);
    *(u32x4*)(Ow + (size_t)row * PITCH + (lane & 15) * 8) = v; }
}

template <bool MASK> __device__ __forceinline__ void stick_tile(f32x16& p0, f32x16& p1, float& Rm, int& Re, int tkh, int hi) {
  constexpr float C2 = SCALE * LOG2E;
  float x0[16], x1[16];
#pragma unroll
  for (int r = 0; r < 16; ++r) {
    { const float y = fmaxf(p0[r] * C2, -126.f); const float e = __builtin_amdgcn_exp2f(-y); const float sg = __builtin_amdgcn_rcpf(1.0f + e); const float om = e * sg;
      p0[r] = sg; x0[r] = (!MASK || ((r & 3) + 8 * (r >> 2)) < tkh) ? om : 1.0f; }
    { const float y = fmaxf(p1[r] * C2, -126.f); const float e = __builtin_amdgcn_exp2f(-y); const float sg = __builtin_amdgcn_rcpf(1.0f + e); const float om = e * sg;
      p1[r] = sg; x1[r] = (!MASK || (32 + (r & 3) + 8 * (r >> 2)) < tkh) ? om : 1.0f; }
  }
  float G[16];
#pragma unroll
  for (int c = 0; c < 4; ++c) {
    swap2((x0[4 * c] * x0[4 * c + 1]) * (x0[4 * c + 2] * x0[4 * c + 3]), G[2 * c], G[2 * c + 1]); swap2((x1[4 * c] * x1[4 * c + 1]) * (x1[4 * c + 2] * x1[4 * c + 3]), G[8 + 2 * c], G[8 + 2 * c + 1]);
  }
  float SG[16]; SG[15] = 1.0f;
#pragma unroll
  for (int g = 14; g >= 0; --g) SG[g] = SG[g + 1] * G[g + 1];
  const float total = SG[0] * G[0];
  const float Rs = ldexpf(Rm, Re);
#pragma unroll
  for (int c = 0; c < 4; ++c) {
    const float b0 = Rs * (hi ? SG[2 * c + 1] : SG[2 * c]), b1 = Rs * (hi ? SG[8 + 2 * c + 1] : SG[8 + 2 * c]);
    float e0[4], e1[4];
    e0[3] = b0; e0[2] = e0[3] * x0[4 * c + 3]; e0[1] = e0[2] * x0[4 * c + 2]; e0[0] = e0[1] * x0[4 * c + 1];
    e1[3] = b1; e1[2] = e1[3] * x1[4 * c + 3]; e1[1] = e1[2] * x1[4 * c + 2]; e1[0] = e1[1] * x1[4 * c + 1];
#pragma unroll
    for (int i = 0; i < 4; ++i) { const int r = 4 * c + i;
      const float a0 = p0[r] * e0[i], a1 = p1[r] * e1[i];
      p0[r] = (!MASK || ((r & 3) + 8 * (r >> 2)) < tkh) ? a0 : 0.f; p1[r] = (!MASK || (32 + (r & 3) + 8 * (r >> 2)) < tkh) ? a1 : 0.f; }
  }
  Rm *= total;
#pragma unroll
  for (int k = 0; k < 2; ++k) { const bool sm = Rm < 5.421010862427522e-20f; Rm = sm ? Rm * 18446744073709551616.0f : Rm; Re = sm ? Re - 64 : Re; }
}

__device__ __forceinline__ void stick_unit(const unsigned short* Q, const unsigned short* K, const unsigned short* V, unsigned short* O, int b, int h, int qb, char* lds, const int tid) {
  const int wid = __builtin_amdgcn_readfirstlane(tid >> 6), lane = tid & 63, r32 = lane & 31, hi = lane >> 5;
  const int t = 256 * qb + 32 * wid + r32;
  const int tmaxw = 256 * qb + 32 * wid + 31, tminw = 256 * qb + 32 * wid;
  const size_t rowb = (size_t)b * SEQ;
  bf16x8 qr[8];
  { const unsigned short* Qw = Q + (rowb + t) * PITCH + h * HD + hi * 8;
#pragma unroll
    for (int d0 = 0; d0 < 8; ++d0) qr[d0] = *reinterpret_cast<const bf16x8*>(Qw + d0 * 16); }
  const unsigned short* Kh = K + rowb * PITCH + h * HD; const unsigned short* Vh = V + rowb * PITCH + h * HD;
  const int sr = tid >> 4, sc = (tid & 15) * 8, vst0 = v_st(sr, sc), vst1 = v_st(32 + sr, sc);
  const int vb0 = (int)(uintptr_t)(lds + OFF_V) + v_rd_base(lane);
  f32x16 o[4] = {}; float Rm = 1.0f; int Re = 0;
  const int NT = 4 * qb + 4; int buf = 0;
  Stg st;
  volatile __attribute__((address_space(3))) int* flags = (volatile __attribute__((address_space(3))) int*)(lds + OFF_WS);
  bool wdone = false;
  __syncthreads();
  if (lane < 2) flags[lane * 8 + wid] = 0;
  sload(st, Kh, Vh, (NT - 1) * KVBLK, sr, sc); asm volatile("s_waitcnt vmcnt(0)" ::: "memory"); swrite(st, lds, 0, sr, sc, vst0, vst1); __syncthreads();
  for (int kt = NT - 1; kt >= 0; --kt) {
    if (kt > 0) sload(st, Kh, Vh, (kt - 1) * KVBLK, sr, sc);
    const int k0 = kt * KVBLK;
    if (k0 < tmaxw && !wdone) {
      f32x16 p0, p1;
      qkt(p0, p1, lds + OFF_K + buf * SHM_K, qr, r32, hi);
      const int tkh = t - k0 - 4 * hi;
      if (k0 + 63 < tminw) stick_tile<false>(p0, p1, Rm, Re, tkh, hi); else stick_tile<true>(p0, p1, Rm, Re, tkh, hi);
      bf16x8 pa0, pa1, pa2, pa3; pack_p(p0, p1, pa0, pa1, pa2, pa3);
      pv_d0(o, vb0 + buf * SHM_V, pa0, pa1, pa2, pa3);
      wdone = __all(Re <= -192 || Rm == 0.f);
    }
    if (lane == 0) flags[(kt & 1) * 8 + wid] = wdone ? 1 : 0;
    if (kt > 0) { asm volatile("s_waitcnt vmcnt(0)" ::: "memory"); swrite(st, lds, buf ^ 1, sr, sc, vst0, vst1); }
    __syncthreads();
    buf ^= 1;
    { const int fl = flags[(kt & 1) * 8 + (lane & 7)]; if (__all(fl != 0)) break; }
  }
  float rs[16];
#pragma unroll
  for (int r = 0; r < 16; ++r) rs[r] = 1.0f;
  store_o(o, rs, O + (rowb + 256 * qb + 32 * wid) * PITCH + h * HD, r32, hi, lds, wid, lane);
  if (PROBE_DUP == 10) { asm volatile("s_waitcnt vmcnt(0)" ::: "memory"); store_o(o, rs, O + (rowb + 256 * qb + 32 * wid) * PITCH + h * HD, r32, hi, lds, wid, lane); }
}

__device__ __forceinline__ void band_unit(const unsigned short* Q, const unsigned short* K, const unsigned short* V, unsigned short* O, const float* bias  , int b, int h, int qb, char* lds, const int tid) {
  const int wid = __builtin_amdgcn_readfirstlane(tid >> 6), lane = tid & 63, r32 = lane & 31, hi = lane >> 5;
  const int t = 256 * qb + 32 * wid + r32;
  const int cq = 4 * qb + (wid >> 1);
  const size_t rowb = (size_t)b * SEQ;
  bf16x8 qr[8];
  { const unsigned short* Qw = Q + (rowb + t) * PITCH + h * HD + hi * 8;
#pragma unroll
    for (int d0 = 0; d0 < 8; ++d0) qr[d0] = *reinterpret_cast<const bf16x8*>(Qw + d0 * 16); }
  const unsigned short* Kh = K + rowb * PITCH + h * HD; const unsigned short* Vh = V + rowb * PITCH + h * HD;
  const int sr = tid >> 4, sc = (tid & 15) * 8, vst0 = v_st(sr, sc), vst1 = v_st(32 + sr, sc);
  const int vb0 = (int)(uintptr_t)(lds + OFF_V) + v_rd_base(lane);
  float* wsf = (float*)(lds + OFF_WS) + wid * 64; float* al_l = wsf + 32;
  float* bias_l = (float*)(lds + OFF_BIAS);
  f32x16 o[4] = {}; f32x16 lacc = {}; float m_reg = -1e30f;
  const int kc_lo = (4 * qb - 8) > 0 ? (4 * qb - 8) : 0, kc_hi = 4 * qb + 3; int buf = 0;
  Stg st;
  const bf16x8 ones = {0x3F80, 0x3F80, 0x3F80, 0x3F80, 0x3F80, 0x3F80, 0x3F80, 0x3F80};
  constexpr float THR2 = 8.0f * LOG2E;
  __syncthreads();
  for (int i = tid; i < 513 + 64; i += NWAVES * 64) bias_l[i] = bias[i < 512 ? i : 512] * LOG2E;
  sload(st, Kh, Vh, kc_lo * KVBLK, sr, sc); asm volatile("s_waitcnt vmcnt(0)" ::: "memory"); swrite(st, lds, 0, sr, sc, vst0, vst1); __syncthreads();
  for (int kc = kc_lo; kc <= kc_hi; ++kc) {
    if (kc < kc_hi) sload(st, Kh, Vh, (kc + 1) * KVBLK, sr, sc);
    if (kc >= cq - 8 && kc <= cq) {
      f32x16 p0, p1;
      qkt(p0, p1, lds + OFF_K + buf * SHM_K, qr, r32, hi);
      constexpr float C2 = SCALE * LOG2E;
      float pmax = -1e30f;
      if (kc <= cq - 5) {
        const float bfar = bias_l[512];
#pragma unroll
        for (int r = 0; r < 16; ++r) { p0[r] = p0[r] * C2 + bfar; p1[r] = p1[r] * C2 + bfar; pmax = fmaxf(pmax, fmaxf(p0[r], p1[r])); }
      } else {
        const float* bp = bias_l + (t - kc * KVBLK - 4 * hi + 256);
        float bv0[16], bv1[16];
#pragma unroll
        for (int r = 0; r < 16; ++r) { bv0[r] = bp[-((r & 3) + 8 * (r >> 2))]; bv1[r] = bp[-(32 + (r & 3) + 8 * (r >> 2))]; }
        SBAR();
#pragma unroll
        for (int r = 0; r < 16; ++r) { p0[r] = p0[r] * C2 + bv0[r]; p1[r] = p1[r] * C2 + bv1[r]; pmax = fmaxf(pmax, fmaxf(p0[r], p1[r])); }
      }
      { float lo, hh; swap2(pmax, lo, hh); pmax = fmaxf(lo, hh); }
      float mn, alpha;
      if (__all(pmax - m_reg <= THR2)) { mn = m_reg; alpha = 1.f; } else { mn = fmaxf(m_reg, pmax); alpha = __builtin_amdgcn_exp2f(m_reg - mn); m_reg = mn; }
#pragma unroll
      for (int r = 0; r < 16; ++r) { p0[r] = __builtin_amdgcn_exp2f(p0[r] - mn); p1[r] = __builtin_amdgcn_exp2f(p1[r] - mn); }
      if (__any(alpha < 1.f)) { if (hi == 0) al_l[r32] = alpha; asm volatile("s_waitcnt lgkmcnt(0)" ::: "memory");
#pragma unroll
        for (int r = 0; r < 16; ++r) { const float a = al_l[crow(r, hi)]; lacc[r] *= a;
#pragma unroll
          for (int d = 0; d < 4; ++d) o[d][r] *= a; } }
      bf16x8 pa0, pa1, pa2, pa3; pack_p(p0, p1, pa0, pa1, pa2, pa3);
      lacc = __builtin_amdgcn_mfma_f32_32x32x16_bf16(pa0, ones, lacc, 0, 0, 0); lacc = __builtin_amdgcn_mfma_f32_32x32x16_bf16(pa1, ones, lacc, 0, 0, 0);
      lacc = __builtin_amdgcn_mfma_f32_32x32x16_bf16(pa2, ones, lacc, 0, 0, 0); lacc = __builtin_amdgcn_mfma_f32_32x32x16_bf16(pa3, ones, lacc, 0, 0, 0);
      pv_d0(o, vb0 + buf * SHM_V, pa0, pa1, pa2, pa3);
    }
    if (kc < kc_hi) { asm volatile("s_waitcnt vmcnt(0)" ::: "memory"); swrite(st, lds, buf ^ 1, sr, sc, vst0, vst1); }
    __syncthreads();
    buf ^= 1;
  }
  float rs[16];
#pragma unroll
  for (int r = 0; r < 16; ++r) rs[r] = __builtin_amdgcn_rcpf(lacc[r]);
  store_o(o, rs, O + (rowb + 256 * qb + 32 * wid) * PITCH + h * HD, r32, hi, lds, wid, lane);
  if (PROBE_DUP == 10) { asm volatile("s_waitcnt vmcnt(0)" ::: "memory"); store_o(o, rs, O + (rowb + 256 * qb + 32 * wid) * PITCH + h * HD, r32, hi, lds, wid, lane); }
}
#undef KSWZ
#undef SBAR
}

struct Frame {
    LAS unsigned char* lds;
    volatile LAS unsigned* MISC;
    gu32* ctl;
    int tid, lane, wave;
    int vcu, G;
};
__device__ __forceinline__ float wave_sum(float v) {
#pragma unroll
    for (int o = 1; o < 64; o <<= 1) v += __shfl_xor(v, o);
    return v;
}
struct ConvItem { const float* src; const float* gain; bf16* dst; int N, Kd; };
__device__ __forceinline__ void tr_load(const ConvItem& c, f32x4 (&v)[16], int lane) {
    const float* src = c.src + (size_t)(lane >> 4) * c.N + (lane & 15) * 4;
#pragma unroll
    for (int j = 0; j < 16; ++j) v[j] = __builtin_nontemporal_load((const f32x4*)(src + (size_t)(4 * j) * c.N));
}
__device__ __forceinline__ void tr_lds_write(const f32x4 (&v)[16], LAS float* scr, int lane) {
    LAS float* d = scr + (lane >> 4) * 65 + (lane & 15) * 4;
#pragma unroll
    for (int j = 0; j < 16; ++j) { d[(4 * j) * 65 + 0] = v[j][0]; d[(4 * j) * 65 + 1] = v[j][1]; d[(4 * j) * 65 + 2] = v[j][2]; d[(4 * j) * 65 + 3] = v[j][3]; }
}
__device__ __forceinline__ void tr_store(const ConvItem& it, LAS float* scr, int lane) {
    const int c = lane & 7;
    float gk[8];
#pragma unroll
    for (int i = 0; i < 8; ++i) gk[i] = it.gain ? it.gain[8 * c + i] : 1.0f;
    LDS_WAIT(); asm volatile("" ::: "memory");
#pragma unroll
    for (int j = 0; j < 8; ++j) { const int n = (lane >> 3) + 8 * j; const LAS float* s = scr + (8 * c) * 65 + n;
        v4u o; o.x = pk2(s[0 * 65] * gk[0], s[1 * 65] * gk[1]); o.y = pk2(s[2 * 65] * gk[2], s[3 * 65] * gk[3]); o.z = pk2(s[4 * 65] * gk[4], s[5 * 65] * gk[5]); o.w = pk2(s[6 * 65] * gk[6], s[7 * 65] * gk[7]);
        __builtin_nontemporal_store(o, (GAS v4u*)(it.dst + (size_t)n * it.Kd + 8 * c)); }
    LDS_WAIT(); asm volatile("" ::: "memory");
}

struct Args { const float* in[14]; float* out; unsigned char* ws; int ph_lo, ph_hi; };

__device__ __forceinline__ bf16* w_gu(unsigned char* ws, int f) { return (bf16*)(ws + WS_W + (size_t)f * W_FFN_STRIDE); }
__device__ __forceinline__ bf16* w_dn(unsigned char* ws, int f) { return (bf16*)(ws + WS_W + (size_t)f * W_FFN_STRIDE + W_FFN_DOWN); }
__device__ __forceinline__ bf16* w_mix1(unsigned char* ws, int layer) { return (bf16*)(ws + WS_WATT + (size_t)layer * 32 * MiB); }
__device__ __forceinline__ bf16* w_mixo(unsigned char* ws, int layer) { return (bf16*)(ws + WS_WATT + (size_t)layer * 32 * MiB + (layer < 3 ? 24 : 8) * MiB); }

constexpr int CONV_TOTAL = 81920;
#ifndef CONV_CAP
#define CONV_CAP 8192
#endif
#ifndef CONV_NBW
#define CONV_NBW 4
#endif
constexpr int CONV_NB = CONV_NBW * 256;
constexpr int bar_off(int b) { if (b <= 0) return 0; const int L = (b - 1) / 7, j = (b - 1) % 7 + 1; return CONV_NB + L * (7 * CONV_NB + 2 * CONV_CAP) + CONV_CAP + (j - 1) * CONV_NB + (j >= 6 ? CONV_CAP : 0); }
constexpr int slot_off(int k) { return CONV_NB + (k / 2) * (7 * CONV_NB + 2 * CONV_CAP) + ((k & 1) ? CONV_CAP + 5 * CONV_NB : 0); }
constexpr int conv_up() { int u = 0;
    for (int L = 0; L < 4; ++L) { const int base = L * 20992, msz = L < 3 ? 4096 : 2048, q = L < 3 ? 3072 : 1024;
        const int need[6] = {base + 5632, base + 8448, base + 8448 + q, base + 8448 + msz, base + 8448 + msz + 5632, base + 8448 + msz + 8448};
        const int at[6] = {7 * L, 7 * L + 1, 7 * L + 2, 7 * L + 4, 7 * L + 5, 7 * L + 6};
        for (int i = 0; i < 6; ++i) { const int d = need[i] - bar_off(at[i]); if (d > u) u = d; } }
    return u < CONV_TOTAL ? u : CONV_TOTAL; }
constexpr int CONV_UP = (CONV_CAP > 0 || CONV_NBW > 0) ? conv_up() : CONV_TOTAL;
static_assert(CONV_UP + bar_off(27) >= CONV_TOTAL, "conversion schedule covers every item");
static_assert(CONV_NBW >= 0 && CONV_NBW <= 7, "waves 1..7 only");
__device__ __forceinline__ void conv_decode(const Args& a, int it, ConvItem& ci) {
    unsigned char* ws = a.ws;
    const float *g_ffn = a.in[1], *wg = a.in[2], *wu = a.in[3], *wd = a.in[4], *g_mix = a.in[5], *wqkv = a.in[6], *woa = a.in[7], *g_kv = a.in[8], *wkv = a.in[9], *wqb = a.in[10], *wob = a.in[11];
        const float* W; const float* gain = nullptr; bf16* WT; int N, Kd, kb, nb, drow_add = 0; bool ilv = false; int mat = 0;
        int L = it / 20992; if (L > 3) L = 3; int r = it - L * 20992;
        const int msz = L < 3 ? 4096 : 2048;
        int f = 2 * L; bool ffn = true;
        if (r >= 8448) { r -= 8448; if (r < msz) ffn = false; else { r -= msz; f = 2 * L + 1; } }
        if (ffn) { mat = r / 2816; r -= mat * 2816;
            if (mat < 2) { N = FF; Kd = DM; W = (mat == 0 ? wg : wu) + (size_t)f * DM * FF; gain = g_ffn + (size_t)f * DM; WT = w_gu(ws, f); kb = r / 88; nb = r - kb * 88; ilv = true; }
            else { N = DM; Kd = FF; W = wd + (size_t)f * FF * DM; WT = w_dn(ws, f); kb = r / 32; nb = r - kb * 32; }
        } else if (L < 2) {
            if (r < 3072) { N = 3 * DM; Kd = DM; W = wqkv + (size_t)L * DM * 3 * DM; gain = g_mix + (size_t)L * DM; WT = w_mix1(ws, L); kb = r / 96; nb = r - kb * 96; }
            else { r -= 3072; N = DM; Kd = DM; W = woa + (size_t)L * DM * DM; WT = w_mixo(ws, L); kb = r / 32; nb = r - kb * 32; }
        } else if (L == 2) {
            if (r < 1024) { N = DM; Kd = DM; W = wqb; gain = g_mix + 2 * DM; WT = w_mix1(ws, 2); kb = r / 32; nb = r - kb * 32; }
            else if (r < 3072) { r -= 1024; N = 2 * DM; Kd = DM; W = wkv; gain = g_kv; WT = w_mix1(ws, 2); kb = r / 64; nb = r - kb * 64; drow_add = DM; }
            else { r -= 3072; N = DM; Kd = DM; W = wob; WT = w_mixo(ws, 2); kb = r / 32; nb = r - kb * 32; }
        } else {
            if (r < 1024) { N = DM; Kd = DM; W = wqb + (size_t)DM * DM; gain = g_mix + 3 * DM; WT = w_mix1(ws, 3); kb = r / 32; nb = r - kb * 32; }
            else { r -= 1024; N = DM; Kd = DM; W = wob + (size_t)DM * DM; WT = w_mixo(ws, 3); kb = r / 32; nb = r - kb * 32; }
        }
        const int n0 = nb * 64, k0 = kb * 64; const int drow = ilv ? (256 * (n0 >> 7) + (n0 & 127) + 128 * mat) : (n0 + drow_add);
        ci.src = W + (size_t)k0 * N + n0; ci.gain = gain ? gain + k0 : nullptr; ci.dst = WT + (size_t)drow * Kd + k0; ci.N = N; ci.Kd = Kd;
}
__device__ __forceinline__ void conv_one(Frame& F, const Args& a, int it) {
    LAS float* scr = (LAS float*)(F.lds + RING_OFF + F.wave * 16640);
    int lane_ = threadIdx.x; asm volatile("" : "+v"(lane_)); lane_ &= 63;
    ConvItem c; f32x4 v[16]; conv_decode(a, it, c); tr_load(c, v, lane_); tr_lds_write(v, scr, lane_); tr_store(c, scr, lane_);
}
__device__ __forceinline__ void conv_items(Frame& F, const Args& a, int it_lo, int it_hi, int rank, int nranks) {
    LAS float* scr = (LAS float*)(F.lds + RING_OFF + F.wave * 16640);
    auto decode = [&](int it, ConvItem& ci) { conv_decode(a, it, ci); };
    const int stride = nranks * NWAVES; int it = it_lo + rank * NWAVES + F.wave;
    int lane_ = threadIdx.x; asm volatile("" : "+v"(lane_)); lane_ &= 63;
    ConvItem cA, cB; f32x4 vA[16], vB[16];
    if (it < it_hi) { decode(it, cA); tr_load(cA, vA, lane_); }
    if (it + stride < it_hi) { decode(it + stride, cB); tr_load(cB, vB, lane_); }
    while (it < it_hi) {
        tr_lds_write(vA, scr, lane_);
        { const ConvItem cur = cA; const int itn = it + 2 * stride; if (itn < it_hi) { decode(itn, cA); tr_load(cA, vA, lane_); } tr_store(cur, scr, lane_); }
        it += stride; if (it >= it_hi) break;
        tr_lds_write(vB, scr, lane_);
        { const ConvItem cur = cB; const int itn = it + 2 * stride; if (itn < it_hi) { decode(itn, cB); tr_load(cB, vB, lane_); } tr_store(cur, scr, lane_); }
        it += stride;
    }
}
__device__ __forceinline__ int lo_perm(int c) { return (c & ~255) | (((c >> 5) & 3) << 6) | (((c >> 3) & 3) << 4) | (((c >> 7) & 1) << 3) | (c & 7); }
__device__ __forceinline__ void p0_prologue(Frame& F, const Args& a) {
    unsigned char* ws = a.ws;
    const int gw = F.vcu * NWAVES + F.wave, NGW = F.G * NWAVES;
    conv_items(F, a, 0, CONV_UP, F.vcu, F.G);
    const float* x = a.in[0]; bf16* hb = (bf16*)(ws + WS_HB); bf16* hl = (bf16*)(ws + WS_H); float* ssq = (float*)(ws + WS_SSQ);
    int lane_ = threadIdx.x; asm volatile("" : "+v"(lane_)); lane_ &= 63;
    for (int m = gw; m < M; m += NGW) {
        const GAS f32x4* xr = (const GAS f32x4*)(x + (size_t)m * DM) + lane_; f32x4 v[8]; float s = 0.f;
#pragma unroll
        for (int j = 0; j < 8; ++j) { v[j] = xr[64 * j]; s += (v[j].x * v[j].x + v[j].y * v[j].y) + (v[j].z * v[j].z + v[j].w * v[j].w); }
        s = wave_sum(s);
        GAS unsigned long long* o8 = (GAS unsigned long long*)(hb + (size_t)m * DM) + lane_; GAS unsigned long long* l8 = (GAS unsigned long long*)(hl + (size_t)m * DM) + lane_;
#pragma unroll
        for (int j = 0; j < 8; ++j) { const unsigned h0 = pk2(v[j].x, v[j].y), h1 = pk2(v[j].z, v[j].w);
            o8[64 * j] = (unsigned long long)h0 | ((unsigned long long)h1 << 32);
            if (RESID_LO == 1) l8[64 * j] = (unsigned long long)pk2(v[j].x - pg8::bf_lo(h0), v[j].y - pg8::bf_hi(h0)) | ((unsigned long long)pk2(v[j].z - pg8::bf_lo(h1), v[j].w - pg8::bf_hi(h1)) << 32);
            if (RESID_LO == 2) { int w = __builtin_amdgcn_cvt_pk_fp8_f32((v[j].x - pg8::bf_lo(h0)) * 512.0f, (v[j].y - pg8::bf_hi(h0)) * 512.0f, 0, false);
                w = __builtin_amdgcn_cvt_pk_fp8_f32((v[j].z - pg8::bf_lo(h1)) * 512.0f, (v[j].w - pg8::bf_hi(h1)) * 512.0f, w, true);
                *(GAS unsigned*)((unsigned char*)hl + (size_t)m * DM + lo_perm(4 * (lane_ + 64 * j))) = (unsigned)w; } }
        if (lane_ < 32) ssq[(size_t)m * 32 + lane_] = lane_ == 0 ? s : 0.f;
    }
}
__device__ __forceinline__ void final_norm(Frame& F, const Args& a) {
    const int gw = F.vcu * NWAVES + F.wave, NGW = F.G * NWAVES;
    const bf16* hb = (const bf16*)(a.ws + WS_HB); const bf16* hl = (const bf16*)(a.ws + WS_H); const float* ssq = (const float*)(a.ws + WS_SSQ); const float* g = a.in[13];
    int lane_ = threadIdx.x; asm volatile("" : "+v"(lane_)); lane_ &= 63;
    f32x4 gv[8];
#pragma unroll
    for (int j = 0; j < 8; ++j) gv[j] = ((const GAS f32x4*)g)[lane_ + 64 * j];
    for (int m = gw; m < M; m += NGW) {
        float s = lane_ < 32 ? ssq[(size_t)m * 32 + lane_] : 0.f; s = wave_sum(s);
        const float rs = __builtin_amdgcn_rsqf(s * (1.0f / DM) + RMS_EPS);
        const GAS unsigned long long* hr = (const GAS unsigned long long*)(hb + (size_t)m * DM) + lane_; const GAS unsigned long long* lr = (const GAS unsigned long long*)(hl + (size_t)m * DM) + lane_;
        GAS f32x4* orow = (GAS f32x4*)(a.out + (size_t)m * DM) + lane_;
#pragma unroll
        for (int j = 0; j < 8; ++j) { const unsigned long long hw = hr[64 * j]; const unsigned h0 = (unsigned)hw, h1 = (unsigned)(hw >> 32);
            f32x4 hv = {pg8::bf_lo(h0), pg8::bf_hi(h0), pg8::bf_lo(h1), pg8::bf_hi(h1)};
            if (RESID_LO == 1) { const unsigned long long lw = lr[64 * j]; const unsigned l0 = (unsigned)lw, l1 = (unsigned)(lw >> 32); hv += (f32x4){pg8::bf_lo(l0), pg8::bf_hi(l0), pg8::bf_lo(l1), pg8::bf_hi(l1)}; }
            if (RESID_LO == 2) { typedef float f32x2v __attribute__((ext_vector_type(2))); const int w = (int)*(const GAS unsigned*)((const unsigned char*)hl + (size_t)m * DM + lo_perm(4 * (lane_ + 64 * j)));
                const f32x2v a = __builtin_amdgcn_cvt_pk_f32_fp8(w, false), b = __builtin_amdgcn_cvt_pk_f32_fp8(w, true); hv += (f32x4){a.x, a.y, b.x, b.y} * (1.0f / 512.0f); }
            orow[64 * j] = hv * rs * gv[j]; }
    }
}

#ifndef KN_ALIGN
#define KN_ALIGN true
#endif
#ifndef KN_SP2
#define KN_SP2 true
#endif
#ifndef MK_PER_PHASE
#define MK_PER_PHASE 0
#endif
constexpr size_t WS_DUMMY = 960 * MiB;
constexpr int N_PHASES = 38;
__global__ void __launch_bounds__(NWAVES * 64, 2) mega_fwd(Args args) {
    extern __shared__ __attribute__((aligned(16))) unsigned char lds[];
    Frame F;
    F.lds = (LAS unsigned char*)lds;
    F.MISC = (volatile LAS unsigned*)(F.lds + LDSCTL_OFF);
    F.tid = threadIdx.x; F.lane = F.tid & 63; F.wave = __builtin_amdgcn_readfirstlane(F.tid >> 6);
    F.G = gridDim.x; { const int bx = blockIdx.x; F.vcu = (F.G % 8 == 0) ? (bx % 8) * (F.G / 8) + bx / 8 : bx; }
    unsigned char* ws = args.ws;
    F.ctl = (gu32*)(ws + WS_CTL);
    for (int u = F.tid; u < 256; u += NWAVES * 64) ((LAS unsigned*)(F.lds + LDSCTL_OFF))[u] = 0u;
    __syncthreads();
#if MK_PER_PHASE
#define GRID_BAR() do { } while (0)
#else
    XcdBarrier bar = xcd_barrier_post((unsigned*)(F.ctl + CW_BAR), F.MISC + 8);
    int bar_cls = 0;
#ifndef PROBE_BLK
#define PROBE_BLK 0
#endif
#ifndef PROBE_CLS
#define PROBE_CLS -1
#endif
#define GRID_BAR() do { unsigned long long t0_ = 0; if (PROBE_DUP == 13 && blockIdx.x == PROBE_BLK && F.tid == 0) t0_ = __builtin_amdgcn_s_memrealtime(); xcd_barrier(bar); if (PROBE_DUP == 12) xcd_barrier(bar); \
    if (PROBE_DUP == 13 && blockIdx.x == PROBE_BLK && F.tid == 0 && (PROBE_CLS < 0 || PROBE_CLS == bar_cls)) { volatile unsigned long long* pw = (volatile unsigned long long*)(ws + WS_CTL + 8192); *pw = *pw + (__builtin_amdgcn_s_memrealtime() - t0_); } } while (0)
#endif
#if MK_PER_PHASE || CONV_NBW == 0
#define GRID_BARC() GRID_BAR()
#else
    int bidx = 0;
#define GRID_BARC() do { const int bo_ = CONV_UP + bar_off(bidx); ++bidx; \
    xcd_barrier_side(bar, F.wave, [&]() { if (F.wave <= CONV_NBW) for (int j_ = F.vcu * CONV_NBW + F.wave - 1; j_ < CONV_NB; j_ += F.G * CONV_NBW) { const int it_ = bo_ + j_; if (it_ < CONV_TOTAL) conv_one(F, args, it_); } }); } while (0)
#endif
    const int lo = args.ph_lo, hi = args.ph_hi;
#define IN(k) (lo <= (k) && (k) < hi)
#define BOTH(k) (IN(k) && (k) + 1 < hi)

    bf16* HL = (bf16*)(ws + WS_H); bf16* HB = (bf16*)(ws + WS_HB); float* SSQ = (float*)(ws + WS_SSQ);
    bf16* QB = (bf16*)(ws + WS_Q); bf16* KB = (bf16*)(ws + WS_K); bf16* VB = (bf16*)(ws + WS_V); bf16* MIX = (bf16*)(ws + WS_MIX); bf16* ACT = (bf16*)(ws + WS_ACT);

    if (IN(0)) { p0_prologue(F, args); if (PROBE_DUP == 1) { GRID_BAR(); p0_prologue(F, args); } if (BOTH(0)) GRID_BARC(); }
    int cid = (int)blockIdx.x;
#if !MK_PER_PHASE
    if (lo == 0 && hi > 1) {
        if (F.tid == 0) { bool ok = (F.G % 8) == 0;
            for (unsigned j = 0; j < 16; ++j) { const unsigned cnt = xb_ld((unsigned*)(F.ctl + CW_BAR) + XB_XCNT(j)); ok = ok && (cnt == (j < 8 ? (unsigned)F.G / 8u : 0u)); }
            F.MISC[12] = ok ? (F.MISC[10] * 8u + F.MISC[11]) : (unsigned)blockIdx.x; }
        __syncthreads();
        cid = __builtin_amdgcn_readfirstlane((int)F.MISC[12]);
    }
#endif
    const int vcid = (F.G % 8 == 0) ? (cid % 8) * (F.G / 8) + cid / 8 : cid;

#pragma unroll 1
    for (int s = 0; s < 12; ++s) {
        const int layer = s / 3, kind = s - 3 * layer, pb = 1 + 3 * s;
        int ltid = threadIdx.x; asm volatile("" : "+v"(ltid));
        unsigned long long pc0 = 0, pr0 = 0;
        if (PROBE_DUP == 11 && s == 3 && blockIdx.x == 0 && F.tid == 0) { pc0 = __builtin_amdgcn_s_memtime(); pr0 = __builtin_amdgcn_s_memrealtime(); }
        if (IN(pb)) {
          for (int rep = 0; rep < (((PROBE_DUP == 4 && kind != 1) || (PROBE_DUP == 6 && kind == 1)) ? 2 : 1); ++rep) {
            if (rep) GRID_BAR();
            asm volatile("" : "+v"(ltid));
            int pm0 = -1; const PG8_LAS float* stab = (const PG8_LAS float*)(F.lds + SCALE_OFF);
            { pg8::StaticOrder S0; S0.init(M, kind != 1 ? 2 * FF : (layer < 3 ? 3 * DM : DM), F.G, cid); pg8::Unit u0;
              if (S0.next(0, u0)) { pm0 = u0.pm;
                if (ltid < 256) { const f32x4* p = (const f32x4*)(SSQ + (size_t)(pm0 * 256 + ltid) * 32); float a = 0.f;
#pragma unroll
                    for (int q = 0; q < 8; ++q) { const f32x4 v = p[q]; a += (v[0] + v[1]) + (v[2] + v[3]); }
                    ((PG8_LAS float*)(F.lds + SCALE_OFF))[ltid] = __builtin_amdgcn_rsqf(a * (1.0f / DM) + RMS_EPS); } }
              __syncthreads(); }
            if (kind != 1) {
                const int f = 2 * layer + (kind >> 1);
                pg8::Gemm g{HB, w_gu(ws, f), M, 2 * FF, DM}; pg8::StaticOrder S; S.init(M, 2 * FF, F.G, cid);
                pg8::EpiSwiglu E{ACT, FF, SSQ, stab, pm0};
                const int nu = (M / 256) * (2 * FF / 256), rem = nu % F.G, c = cid;
                const int lo_it = CONV_UP + (CONV_NB + (f >> 1) * (7 * CONV_NB + 2 * CONV_CAP) + ((f & 1) ? CONV_CAP + 5 * CONV_NB : 0)), hi_it = (lo_it + CONV_CAP) < CONV_TOTAL ? (lo_it + CONV_CAP) : CONV_TOTAL;
                const bool cv = CONV_CAP > 0 && lo_it < hi_it && (rem == 0 || c >= rem); const int crank = rem == 0 ? c : c - rem, cn = rem == 0 ? F.G : F.G - rem;
                pg8::gemm_phase<pg8::EpiSwiglu, pg8::StaticOrder, KN_ALIGN, KN_SP2>(F.lds + RING_OFF, g, S, E, ltid);
                if (cv) conv_items(F, args, lo_it, hi_it, crank, cn);
            } else {
                const int N = layer < 3 ? 3 * DM : DM;
                pg8::Gemm g{HB, w_mix1(ws, layer), M, N, DM}; pg8::StaticOrder S; S.init(M, N, F.G, cid);
                pg8::EpiScaleBf16 E{QB, (size_t)(WS_K - WS_Q) / 2, SSQ, stab, pm0};
                pg8::gemm_phase<pg8::EpiScaleBf16, pg8::StaticOrder, KN_ALIGN, KN_SP2>(F.lds + RING_OFF, g, S, E, ltid);
            }
          }
            if (PROBE_DUP == 11 && s == 3 && blockIdx.x == 0 && F.tid == 0) {
                const unsigned long long cyc = __builtin_amdgcn_s_memtime() - pc0, rt = __builtin_amdgcn_s_memrealtime() - pr0;
                const unsigned long long delay = cyc * 10000ull / (rt ? rt : 1ull);
                const unsigned long long t0 = __builtin_amdgcn_s_memrealtime(); while (__builtin_amdgcn_s_memrealtime() - t0 < delay) __builtin_amdgcn_s_sleep(8);
            }
            bar_cls = kind != 1 ? 1 : 3; if (BOTH(pb)) GRID_BARC();
        }
        if (kind == 1 && IN(pb + 1)) {
          for (int rep = 0; rep < (((PROBE_DUP == 2 && layer < 2) || (PROBE_DUP == 3 && layer >= 2)) ? 2 : 1); ++rep) {
            if (rep) GRID_BAR();
            for (int p = vcid; p < 256; p += F.G) {
                const int bh = p >> 2, j = p & 3, b = bh >> 4, h = bh & 15;
                if (layer < 2) {
#pragma unroll 1
                    for (int uu = 0; uu < 2; ++uu) { asm volatile("" : "+v"(ltid)); att::stick_unit(QB, KB, VB, MIX, b, h, uu == 0 ? 7 - j : j, (char*)lds + RING_OFF, ltid); }
                } else { const float* bias = args.in[12] + ((size_t)(layer - 2) * NH + h) * 513;
#pragma unroll 1
                    for (int uu = 0; uu < 2; ++uu) { asm volatile("" : "+v"(ltid)); att::band_unit(QB, KB, VB, MIX, bias, b, h, uu == 0 ? 7 - j : j, (char*)lds + RING_OFF, ltid); }
                }
            }
          }
            bar_cls = 4; if (BOTH(pb + 1)) GRID_BARC();
        }
        if (IN(pb + 2)) {
            const bool ffn = kind != 1; const int f = 2 * layer + (kind >> 1);
            pg8::Gemm g{ffn ? ACT : MIX, ffn ? w_dn(ws, f) : w_mixo(ws, layer), M, DM, ffn ? FF : DM}; pg8::StaticOrder S; S.init(M, DM, F.G, cid);
          for (int rep = (((PROBE_DUP == 5 && ffn) || (PROBE_DUP == 7 && !ffn)) ? 0 : 1); rep < 2; ++rep) {
            const bool dummy = rep == 0;
            asm volatile("" : "+v"(ltid));
            pg8::EpiResid E{HB, HL, dummy ? (bf16*)(ws + WS_DUMMY + 64 * MiB) : HB, dummy ? (bf16*)(ws + WS_DUMMY) : HL, dummy ? (float*)(ws + WS_DUMMY + 96 * MiB) : SSQ, ffn ? 0.5f : 1.0f};
#if PROBE_DUP == 9
            pg8::EpiResid Ed{HB, HL, (bf16*)(ws + WS_DUMMY + 64 * MiB), (bf16*)(ws + WS_DUMMY), (float*)(ws + WS_DUMMY + 96 * MiB), ffn ? 0.5f : 1.0f};
            pg8::EpiTwice<pg8::EpiResid> E2{Ed, E};
            pg8::gemm_phase<pg8::EpiTwice<pg8::EpiResid>, pg8::StaticOrder, KN_ALIGN, KN_SP2>(F.lds + RING_OFF, g, S, E2, ltid);
#else
            pg8::gemm_phase<pg8::EpiResid, pg8::StaticOrder, KN_ALIGN, KN_SP2>(F.lds + RING_OFF, g, S, E, ltid);
#endif
            if (dummy) GRID_BAR();
          }
            bar_cls = ffn ? 2 : 5; if (BOTH(pb + 2)) GRID_BARC();
        }
    }
    if (PROBE_DUP == 13 && blockIdx.x == PROBE_BLK && F.tid == 0) { const unsigned long long bw_acc = *(volatile unsigned long long*)(ws + WS_CTL + 8192); const unsigned long long t0 = __builtin_amdgcn_s_memrealtime(); while (__builtin_amdgcn_s_memrealtime() - t0 < bw_acc) __builtin_amdgcn_s_sleep(8); }
    if (IN(37)) { final_norm(F, args); if (PROBE_DUP == 8) { GRID_BAR(); final_norm(F, args); } }
#undef IN
#undef BOTH
}

extern "C" void kernel_launch(void* const* d_in, const int* in_sizes, int n_in, void* d_out, int out_size, void* d_ws, size_t ws_size, hipStream_t stream) {
    static int grid = 0;
    if (grid == 0) {
        if (n_in != 14 || in_sizes[0] != M * DM || out_size != M * DM || ws_size < WS_END) { fprintf(stderr, "kernel_launch: shape mismatch: n_in %d in0 %d out %d ws %zu (need %zu)\n", n_in, n_in > 0 ? in_sizes[0] : -1, out_size, ws_size, (size_t)WS_END); grid = -1; return; }
        int dev = 0, cus = 0, per_cu = 0;
        if (hipGetDevice(&dev) != hipSuccess || hipDeviceGetAttribute(&cus, hipDeviceAttributeMultiprocessorCount, dev) != hipSuccess) { fprintf(stderr, "kernel_launch: device query failed\n"); grid = -1; return; }
        if (hipFuncSetAttribute((const void*)mega_fwd, hipFuncAttributeMaxDynamicSharedMemorySize, LDS_BYTES) != hipSuccess) { fprintf(stderr, "kernel_launch: hipFuncSetAttribute failed\n"); grid = -1; return; }
        if (hipOccupancyMaxActiveBlocksPerMultiprocessor(&per_cu, (const void*)mega_fwd, NWAVES * 64, LDS_BYTES) != hipSuccess || per_cu < 1) { fprintf(stderr, "kernel_launch: occupancy query reports %d workgroups per CU\n", per_cu); (void)hipGetLastError(); grid = -1; return; }
        grid = cus;
    }
    if (grid < 0) return;
    if (hipMemsetAsync((char*)d_ws + WS_CTL, 0, CTL_ZERO_BYTES, stream) != hipSuccess) { fprintf(stderr, "kernel_launch: hipMemsetAsync failed\n"); return; }
    Args a{};
    for (int i = 0; i < 14; ++i) a.in[i] = (const float*)d_in[i];
    a.out = (float*)d_out; a.ws = (unsigned char*)d_ws;
#if MK_PER_PHASE
    for (int ph = 0; ph < N_PHASES; ++ph) {
        if (ph >= 1 && ph <= 36) { const int s = (ph - 1) / 3, j = (ph - 1) % 3; if (j == 1 && (s % 3) != 1) continue; }
        a.ph_lo = ph; a.ph_hi = ph + 1;
        hipLaunchKernelGGL(mega_fwd, dim3(grid), dim3(NWAVES * 64), LDS_BYTES, stream, a);
    }
#else
    a.ph_lo = 0; a.ph_hi = N_PHASES;
    hipLaunchKernelGGL(mega_fwd, dim3(grid), dim3(NWAVES * 64), LDS_BYTES, stream, a);
#endif
    const hipError_t le = hipPeekAtLastError();
    if (le != hipSuccess) fprintf(stderr, "kernel_launch: launch failed: %s (grid %d)\n", hipGetErrorName(le), grid);
}
```

```cpp
#include <hip/hip_runtime.h>
#include <cstdio>
#include <cstdint>
#ifndef PROBE_DUP
#define PROBE_DUP 0
#endif
namespace pg8 {
#define PG8_LAS __attribute__((address_space(3)))
typedef unsigned short bf16_t;
typedef short bf16x8 __attribute__((ext_vector_type(8)));
typedef float f32x4 __attribute__((ext_vector_type(4)));
typedef unsigned u32x4 __attribute__((ext_vector_type(4)));
constexpr int BM = 256, BK = 64, HALF = 128, HTB = HALF * BK * 2  , STAGE_BYTES = 8 * HTB, NXCD = 8, WGM = 8;

__host__ __device__ __forceinline__ int lds_byte(int r, int c) { const int st = (r >> 4) * 2 + (c >> 5), rr = r & 15, cc = c & 31, ob = rr * 64 + cc * 2; return st * 1024 + (ob ^ (((ob >> 9) & 1) << 5)); }
__host__ __device__ __forceinline__ void stage_rc(int b, int& R, int& C) { const int st = b / 1024, sb = b % 1024, swz = sb ^ (((sb >> 9) & 1) << 5); R = (st >> 1) * 16 + swz / 64; C = (st & 1) * 32 + (swz % 64) / 2; }
__host__ __device__ __forceinline__ int perm32(int rho) { const int n = rho >> 4, i = rho & 15; return 8 * (i >> 2) + 4 * n + (i & 3); }

struct Unit { int pm, pn; };
struct Gemm { const bf16_t* A; const bf16_t* Bt; int M, N, K; };

struct StaticOrder {
    int nM, nN, nwg, G, c;
    __host__ __device__ void init(int M, int N, int G_, int c_) { nM = M / BM; nN = N / BM; nwg = nM * nN; G = G_; c = c_; }
    __host__ __device__ bool next(int i, Unit& u) const {
        const long L = (long)i * G + c; if (L >= nwg) return false;
        int wgid = (int)L; { const int q = nwg / NXCD, r = nwg % NXCD, xcd = wgid % NXCD, off = wgid / NXCD; wgid = (xcd < r ? xcd * (q + 1) : r * (q + 1) + (xcd - r) * q) + off; }
        const int nig = WGM * nN, gid = wgid / nig, fm = gid * WGM, gsz = (nM - fm) < WGM ? (nM - fm) : WGM;
        u.pm = fm + ((wgid % nig) % gsz); u.pn = (wgid % nig) / gsz; return true;
    }
    __device__ __forceinline__ void a_ready(const Unit&) const {}
    __device__ __forceinline__ void done(const Unit&) const {}
};

typedef float f32x2c __attribute__((ext_vector_type(2))); typedef __bf16 bf16x2c __attribute__((ext_vector_type(2)));
__device__ __forceinline__ unsigned cvt_pk_bf16(float lo, float hi) { const f32x2c v = {lo, hi}; const bf16x2c b = __builtin_convertvector(v, bf16x2c); return __builtin_bit_cast(unsigned, b); }
typedef float f32x2 __attribute__((ext_vector_type(2)));
__device__ __forceinline__ float row_scale(const float* ssq, int row, int fq) {
    const f32x4* p = (const f32x4*)(ssq + (size_t)row * 32 + fq * 8);
    const f32x4 a = p[0], b = p[1];
    float s = ((a[0] + a[1]) + (a[2] + a[3])) + ((b[0] + b[1]) + (b[2] + b[3]));
    s += __shfl_xor(s, 16); s += __shfl_xor(s, 32);
    return __builtin_amdgcn_rsqf(s * (1.0f / 2048.0f) + 1e-6f);
}
struct EpiSwiglu {
    static constexpr bool PERM = true, AFTER_DRAIN = false;
    bf16_t* O; int ldc; const float* ssq; const PG8_LAS float* tab; int pm0;
    __device__ __forceinline__ void operator()(const f32x4 (&acc)[2][2][4][2], const Unit& u, int wr, int wc, int fr, int fq) const {
        const int row0 = u.pm * BM + wr * 64 + fr, col0 = u.pn * HALF + wc * 32 + 8 * fq;
        float sc[8];
        if (u.pm == pm0) {
#pragma unroll
            for (int q = 0; q < 8; ++q) sc[q] = tab[wr * 64 + fr + (q >> 2) * HALF + (q & 3) * 16];
        } else {
#pragma unroll
            for (int q = 0; q < 8; ++q) sc[q] = row_scale(ssq, row0 + (q >> 2) * HALF + (q & 3) * 16, fq);
        }
#pragma unroll
        for (int ai = 0; ai < 2; ++ai)
#pragma unroll
            for (int m = 0; m < 4; ++m) {
                const int row = row0 + ai * HALF + m * 16; const float s = sc[ai * 4 + m];
                const float k = s * -1.4426950408889634f, s2 = s * s;
                float o[8];
#pragma unroll
                for (int n = 0; n < 2; ++n)
#pragma unroll
                    for (int i = 0; i < 4; ++i) { const float g = acc[ai][0][m][n][i], up = acc[ai][1][m][n][i];
                        const float r = __builtin_amdgcn_rcpf(1.0f + __builtin_amdgcn_exp2f(g * k));
                        o[n * 4 + i] = (g * up) * (r * s2); }
                u32x4 w; w.x = cvt_pk_bf16(o[0], o[1]); w.y = cvt_pk_bf16(o[2], o[3]); w.z = cvt_pk_bf16(o[4], o[5]); w.w = cvt_pk_bf16(o[6], o[7]);
                *(u32x4*)((char*)O + ((unsigned)row * (unsigned)ldc + (unsigned)col0) * 2u) = w; }
    }
};
struct EpiScaleBf16 {
    static constexpr bool PERM = true, AFTER_DRAIN = false;
    bf16_t* O; size_t split_stride; const float* ssq; const PG8_LAS float* tab; int pm0;
    __device__ __forceinline__ void operator()(const f32x4 (&acc)[2][2][4][2], const Unit& u, int wr, int wc, int fr, int fq) const {
        const int row0 = u.pm * BM + wr * 64 + fr; const int t = u.pn >> 3;
        float sc[8];
        if (u.pm == pm0) {
#pragma unroll
            for (int q = 0; q < 8; ++q) sc[q] = tab[wr * 64 + fr + (q >> 2) * HALF + (q & 3) * 16];
        } else {
#pragma unroll
            for (int q = 0; q < 8; ++q) sc[q] = row_scale(ssq, row0 + (q >> 2) * HALF + (q & 3) * 16, fq);
        } bf16_t* base = O + (size_t)t * split_stride;
        const int col0 = (u.pn & 7) * BM + wc * 32 + 8 * fq;
#pragma unroll
        for (int ai = 0; ai < 2; ++ai)
#pragma unroll
            for (int m = 0; m < 4; ++m) {
                const int row = row0 + ai * HALF + m * 16; const float s = sc[ai * 4 + m];
                char* rowp = (char*)base + ((unsigned)row * 2048u + (unsigned)col0) * 2u;
#pragma unroll
                for (int bj = 0; bj < 2; ++bj) { const f32x4 v0 = acc[ai][bj][m][0] * s, v1 = acc[ai][bj][m][1] * s;
                    u32x4 w; w.x = cvt_pk_bf16(v0[0], v0[1]); w.y = cvt_pk_bf16(v0[2], v0[3]); w.z = cvt_pk_bf16(v1[0], v1[1]); w.w = cvt_pk_bf16(v1[2], v1[3]);
                    *(u32x4*)(rowp + bj * HALF * 2) = w; } }
    }
};
#ifndef RESID_LO
#define RESID_LO 0
#endif
__device__ __forceinline__ float bf_lo(unsigned w) { return __uint_as_float(w << 16); }
__device__ __forceinline__ float bf_hi(unsigned w) { return __uint_as_float(w & 0xffff0000u); }
struct EpiResid {
    static constexpr bool PERM = true, AFTER_DRAIN = false;
    const bf16_t* bhi; const void* blo; bf16_t* ohi; void* olo; float* ssq; float coef;
    __device__ __forceinline__ void operator()(const f32x4 (&acc)[2][2][4][2], const Unit& u, int wr, int wc, int fr, int fq) const {
        typedef unsigned u32x2v __attribute__((ext_vector_type(2))); typedef float f32x2v __attribute__((ext_vector_type(2)));
        const int row0 = u.pm * BM + wr * 64 + fr, col0 = u.pn * BM + wc * 32 + 8 * fq;
        float ssr[8];
#if RESID_LO == 2
        const char* hb = (const char*)bhi; const char* lb = (const char*)blo; char* ho = (char*)ohi; char* lo_ = (char*)olo;
        const unsigned hoff0 = ((unsigned)row0 * 2048u + (unsigned)col0) * 2u, loff0 = (unsigned)row0 * 2048u + (unsigned)(u.pn * BM + wc * 64 + fq * 16);
        const float c512 = 512.0f, i512 = 1.0f / 512.0f;
#pragma unroll
        for (int ai = 0; ai < 2; ++ai)
#pragma unroll
            for (int m = 0; m < 4; ++m) {
                const unsigned rofs = (unsigned)(ai * HALF + m * 16) * 2048u;
                const u32x4 h0 = *(const u32x4*)(hb + hoff0 + rofs * 2u), h1 = *(const u32x4*)(hb + hoff0 + rofs * 2u + HALF * 2), l16 = *(const u32x4*)(lb + loff0 + rofs);
                unsigned wh[8], wl[4] = {0u, 0u, 0u, 0u}; float ss = 0.f;
#pragma unroll
                for (int bj = 0; bj < 2; ++bj)
#pragma unroll
                    for (int j = 0; j < 4; ++j) { const unsigned hw = bj ? h1[j] : h0[j]; const unsigned lw = l16[2 * bj + (j >> 1)];
                        const f32x2v lf = (j & 1) ? __builtin_amdgcn_cvt_pk_f32_fp8((int)lw, true) : __builtin_amdgcn_cvt_pk_f32_fp8((int)lw, false);
                        const float a0 = acc[ai][bj][m][j >> 1][(2 * j) & 3], a1 = acc[ai][bj][m][j >> 1][(2 * j + 1) & 3];
                        const float o0 = __builtin_fmaf(a0, coef, __builtin_fmaf(lf.x, i512, bf_lo(hw))), o1 = __builtin_fmaf(a1, coef, __builtin_fmaf(lf.y, i512, bf_hi(hw)));
                        const unsigned nh = cvt_pk_bf16(o0, o1); wh[4 * bj + j] = nh;
                        const float r0 = (o0 - bf_lo(nh)) * c512, r1 = (o1 - bf_hi(nh)) * c512;
                        wl[2 * bj + (j >> 1)] = (j & 1) ? (unsigned)__builtin_amdgcn_cvt_pk_fp8_f32(r0, r1, (int)wl[2 * bj + (j >> 1)], true) : (unsigned)__builtin_amdgcn_cvt_pk_fp8_f32(r0, r1, (int)wl[2 * bj + (j >> 1)], false);
                        ss = __builtin_fmaf(o0, o0, ss); ss = __builtin_fmaf(o1, o1, ss); }
                *(u32x4*)(ho + hoff0 + rofs * 2u) = (u32x4){wh[0], wh[1], wh[2], wh[3]}; *(u32x4*)(ho + hoff0 + rofs * 2u + HALF * 2) = (u32x4){wh[4], wh[5], wh[6], wh[7]};
                *(u32x4*)(lo_ + loff0 + rofs) = (u32x4){wl[0], wl[1], wl[2], wl[3]};
                ss += __shfl_xor(ss, 16); ss += __shfl_xor(ss, 32); ssr[ai * 4 + m] = ss;
                if (m == 3) asm volatile("" ::: "memory");
            }
#elif RESID_LO == 0
        const char* hb = (const char*)bhi; char* ho = (char*)ohi;
        const unsigned hoff0 = ((unsigned)row0 * 2048u + (unsigned)col0) * 2u;
#pragma unroll
        for (int ai = 0; ai < 2; ++ai)
#pragma unroll
            for (int m = 0; m < 4; ++m) {
                const unsigned rofs = (unsigned)(ai * HALF + m * 16) * 4096u;
                const u32x4 h0 = *(const u32x4*)(hb + hoff0 + rofs), h1 = *(const u32x4*)(hb + hoff0 + rofs + HALF * 2);
                unsigned wh[8]; float ss = 0.f;
#pragma unroll
                for (int bj = 0; bj < 2; ++bj)
#pragma unroll
                    for (int j = 0; j < 4; ++j) { const unsigned hw = bj ? h1[j] : h0[j];
                        const float a0 = acc[ai][bj][m][j >> 1][(2 * j) & 3], a1 = acc[ai][bj][m][j >> 1][(2 * j + 1) & 3];
                        const float o0 = __builtin_fmaf(a0, coef, bf_lo(hw)), o1 = __builtin_fmaf(a1, coef, bf_hi(hw));
                        wh[4 * bj + j] = cvt_pk_bf16(o0, o1);
                        ss = __builtin_fmaf(o0, o0, ss); ss = __builtin_fmaf(o1, o1, ss); }
                *(u32x4*)(ho + hoff0 + rofs) = (u32x4){wh[0], wh[1], wh[2], wh[3]}; *(u32x4*)(ho + hoff0 + rofs + HALF * 2) = (u32x4){wh[4], wh[5], wh[6], wh[7]};
                ss += __shfl_xor(ss, 16); ss += __shfl_xor(ss, 32); ssr[ai * 4 + m] = ss;
                if (m == 3) asm volatile("" ::: "memory");
            }
#else
#pragma unroll
        for (int ai = 0; ai < 2; ++ai)
#pragma unroll
            for (int m = 0; m < 4; ++m) {
                const int q = ai * 4 + m; const int row = row0 + ai * HALF + m * 16; const size_t off = (size_t)row * 2048 + col0; float ss = 0.f;
                u32x4 hvq[2], lvq[2]; u32x2v l8q[2];
#pragma unroll
                for (int bj = 0; bj < 2; ++bj) { hvq[bj] = *(const u32x4*)(bhi + off + bj * HALF);
                    if (RESID_LO == 1) lvq[bj] = *(const u32x4*)((const bf16_t*)blo + off + bj * HALF);
                }
                if (RESID_LO == 2) { const u32x4 l16 = *(const u32x4*)((const unsigned char*)blo + (size_t)row * 2048 + u.pn * BM + wc * 64 + fq * 16);
                    l8q[0] = (u32x2v){l16[0], l16[1]}; l8q[1] = (u32x2v){l16[2], l16[3]}; }
                u32x4 w16 = {0u, 0u, 0u, 0u};
#pragma unroll
                for (int bj = 0; bj < 2; ++bj) { float o[8]; u32x4 wh, wl; u32x2v w8 = {0u, 0u};
#pragma unroll
                    for (int j = 0; j < 4; ++j) { const unsigned hw = hvq[bj][j]; float b0 = bf_lo(hw), b1 = bf_hi(hw);
                        if (RESID_LO == 1) { const unsigned lw = lvq[bj][j]; b0 += bf_lo(lw); b1 += bf_hi(lw); }
                        if (RESID_LO == 2) { const f32x2v lf = (j & 1) ? __builtin_amdgcn_cvt_pk_f32_fp8((int)l8q[bj][j >> 1], true) : __builtin_amdgcn_cvt_pk_f32_fp8((int)l8q[bj][j >> 1], false);
                            b0 += lf.x * (1.0f / 512.0f); b1 += lf.y * (1.0f / 512.0f); }
                        o[2 * j] = b0 + acc[ai][bj][m][j >> 1][(2 * j) & 3] * coef; o[2 * j + 1] = b1 + acc[ai][bj][m][j >> 1][(2 * j + 1) & 3] * coef;
                        const unsigned nh = cvt_pk_bf16(o[2 * j], o[2 * j + 1]); wh[j] = nh;
                        if (RESID_LO == 1) wl[j] = cvt_pk_bf16(o[2 * j] - bf_lo(nh), o[2 * j + 1] - bf_hi(nh));
                        if (RESID_LO == 2) { const float r0 = (o[2 * j] - bf_lo(nh)) * 512.0f, r1 = (o[2 * j + 1] - bf_hi(nh)) * 512.0f;
                            w8[j >> 1] = (j & 1) ? (unsigned)__builtin_amdgcn_cvt_pk_fp8_f32(r0, r1, (int)w8[j >> 1], true) : (unsigned)__builtin_amdgcn_cvt_pk_fp8_f32(r0, r1, (int)w8[j >> 1], false); }
                        ss += o[2 * j] * o[2 * j] + o[2 * j + 1] * o[2 * j + 1]; }
                    *(u32x4*)(ohi + off + bj * HALF) = wh;
                    if (RESID_LO == 1) *(u32x4*)((bf16_t*)olo + off + bj * HALF) = wl;
                    if (RESID_LO == 2) { w16[2 * bj] = w8[0]; w16[2 * bj + 1] = w8[1]; } }
                if (RESID_LO == 2) *(u32x4*)((unsigned char*)olo + (size_t)row * 2048 + u.pn * BM + wc * 64 + fq * 16) = w16;
                ss += __shfl_xor(ss, 16); ss += __shfl_xor(ss, 32); ssr[q] = ss;
                if (m == 3) asm volatile("" ::: "memory");
            }
#endif
        { const float v0 = fq == 0 ? ssr[0] : fq == 1 ? ssr[2] : fq == 2 ? ssr[4] : ssr[6], v1 = fq == 0 ? ssr[1] : fq == 1 ? ssr[3] : fq == 2 ? ssr[5] : ssr[7];
          float* p = ssq + (size_t)(row0 + (fq >> 1) * HALF + (fq & 1) * 32) * 32 + u.pn * 4 + wc; p[0] = v0; p[16 * 32] = v1; }
    }
};

template <class E1> struct EpiTwice {
    static constexpr bool PERM = E1::PERM, AFTER_DRAIN = false;
    E1 a, b;
    __device__ __forceinline__ void operator()(const f32x4 (&acc)[2][2][4][2], const Unit& u, int wr, int wc, int fr, int fq) const { a(acc, u, wr, wc, fr, fq); asm volatile("" ::: "memory"); b(acc, u, wr, wc, fr, fq); }
};
struct NoPre { __device__ __forceinline__ void operator()() const {} };
template <class Epi, class Sched, bool ALIGN_EPI = false, bool SP2 = false, class Pre = NoPre>
__device__ __forceinline__ void gemm_phase(PG8_LAS unsigned char* lds, const Gemm g, const Sched& S, const Epi& E, const int tid, const Pre& pre = Pre{}) {
    const int wid = __builtin_amdgcn_readfirstlane(tid >> 6), lane = tid & 63, wr = wid >> 2, wc = wid & 3, fr = lane & 15, fq = lane >> 4;
    const int K = g.K, nt = K / BK;
    unsigned voffA[2], voffB[2];
#pragma unroll
    for (int i = 0; i < 2; ++i) { int R, C; stage_rc(tid * 16 + i * 8192, R, C); const int Rb = Epi::PERM ? ((R & ~31) + perm32(R & 31)) : R;
        voffA[i] = (unsigned)(R * K + C) * 2u; voffB[i] = (unsigned)(Rb * K + C) * 2u; }
    const size_t kstep = (size_t)(BK * 2);
    const size_t hstep = (size_t)HALF * K * 2;
    const size_t tstep = 2 * hstep;
    const unsigned ldsw = (unsigned)wid * 1024u;
    const int aoff = lds_byte(wr * 64 + fr, fq * 8), boff = lds_byte(wc * 32 + fr, fq * 8);
#define PG8_SA(b, h) (((b) * 2 + (h)) * HTB)
#define PG8_SB(b, h) ((4 + (b) * 2 + (h)) * HTB)
#define PG8_STAGE(bufoff, gbase, voff) do { _Pragma("unroll") for (int _i = 0; _i < 2; ++_i) \
        __builtin_amdgcn_global_load_lds((const unsigned*)((const char*)(gbase) + (voff)[_i]), (PG8_LAS unsigned*)(lds + (bufoff) + ldsw + _i * 8192), 16, 0, 0); } while (0)
#define PG8_LDA(dst, b, h) do { _Pragma("unroll") for (int m = 0; m < 4; ++m) _Pragma("unroll") for (int k = 0; k < 2; ++k) dst[m][k] = *(const PG8_LAS bf16x8*)(lds + PG8_SA(b, h) + aoff + m * 2048 + k * 1024); } while (0)
#define PG8_LDB(dst, b, h) do { _Pragma("unroll") for (int n = 0; n < 2; ++n) _Pragma("unroll") for (int k = 0; k < 2; ++k) dst[n][k] = *(const PG8_LAS bf16x8*)(lds + PG8_SB(b, h) + boff + n * 2048 + k * 1024); } while (0)
#define PG8_MMA(ai, bj, At, Bt) do { __builtin_amdgcn_s_setprio(1); _Pragma("unroll") for (int m = 0; m < 4; ++m) _Pragma("unroll") for (int n = 0; n < 2; ++n) _Pragma("unroll") for (int k = 0; k < 2; ++k) \
        acc[ai][bj][m][n] = __builtin_amdgcn_mfma_f32_16x16x32_bf16(Bt[n][k], At[m][k], acc[ai][bj][m][n], 0, 0, 0); __builtin_amdgcn_s_setprio(0); } while (0)
#define PG8_WAIT_V(n) asm volatile("s_waitcnt vmcnt(" #n ")" ::: "memory")
#define PG8_WAIT_L(n) asm volatile("s_waitcnt lgkmcnt(" #n ")" ::: "memory")
#define PG8_BAR __builtin_amdgcn_s_barrier()
#define PG8_SCHED __builtin_amdgcn_sched_barrier(0)
    Unit cur, nxt; int ui = 0;
    if (!S.next(0, cur)) return;
    f32x4 acc[2][2][4][2];
#pragma unroll
    for (int a = 0; a < 2; ++a)
#pragma unroll
        for (int b = 0; b < 2; ++b)
#pragma unroll
            for (int m = 0; m < 4; ++m)
#pragma unroll
                for (int n = 0; n < 2; ++n) acc[a][b][m][n] = (f32x4){0.f, 0.f, 0.f, 0.f};
    bf16x8 At[4][2], B0[2][2], B1[2][2];
    const char* cA = (const char*)g.A + (size_t)cur.pm * tstep; const char* cB = (const char*)g.Bt + (size_t)cur.pn * tstep;
    S.a_ready(cur);
    if constexpr (SP2) {
        PG8_STAGE(PG8_SB(0, 0), cB, voffB); PG8_STAGE(PG8_SB(0, 1), cB + hstep, voffB); PG8_STAGE(PG8_SA(0, 0), cA, voffA); PG8_STAGE(PG8_SA(0, 1), cA + hstep, voffA);
        pre();
        if (wr == 1) PG8_BAR;
        PG8_WAIT_V(2); PG8_BAR;
        PG8_STAGE(PG8_SB(1, 0), cB + kstep, voffB); PG8_STAGE(PG8_SA(1, 0), cA + kstep, voffA); PG8_STAGE(PG8_SB(1, 1), cB + hstep + kstep, voffB);
        PG8_WAIT_V(6); PG8_BAR;
    } else {
        PG8_STAGE(PG8_SB(0, 0), cB, voffB); PG8_STAGE(PG8_SA(0, 0), cA, voffA); PG8_STAGE(PG8_SB(0, 1), cB + hstep, voffB); PG8_STAGE(PG8_SA(0, 1), cA + hstep, voffA);
        if (wr == 1) PG8_BAR;
        PG8_WAIT_V(4); PG8_BAR;
        PG8_STAGE(PG8_SB(1, 0), cB + kstep, voffB); PG8_STAGE(PG8_SA(1, 0), cA + kstep, voffA); PG8_STAGE(PG8_SB(1, 1), cB + hstep + kstep, voffB);
        PG8_WAIT_V(6); PG8_BAR;
    }
    for (;;) {
        const bool has_next = S.next(ui + 1, nxt);
        const char* nA = has_next ? (const char*)g.A + (size_t)nxt.pm * tstep : cA; const char* nB = has_next ? (const char*)g.Bt + (size_t)nxt.pn * tstep : cB;
        for (int t = 0; t < nt; t += 2) {
            const bool last = (t == nt - 2);
            const char* a1 = cA + (size_t)(t + 1) * kstep;
            const char* a2 = last ? nA : cA + (size_t)(t + 2) * kstep; const char* b2 = last ? nB : cB + (size_t)(t + 2) * kstep;
            const char* a3 = a2 + kstep; const char* b3 = b2 + kstep;
            if (last && has_next) S.a_ready(nxt);
            if constexpr (SP2) {
            PG8_LDB(B0, 0, 0); PG8_LDB(B1, 0, 1); PG8_SCHED; PG8_LDA(At, 0, 0); PG8_STAGE(PG8_SA(1, 1), a1 + hstep, voffA);
            PG8_WAIT_V(8); PG8_WAIT_L(0); PG8_BAR; PG8_MMA(0, 0, At, B0); PG8_MMA(0, 1, At, B1); PG8_BAR; PG8_SCHED;
            PG8_LDA(At, 0, 1); PG8_STAGE(PG8_SB(0, 0), b2, voffB); PG8_STAGE(PG8_SB(0, 1), b2 + hstep, voffB); PG8_STAGE(PG8_SA(0, 0), a2, voffA);
            PG8_WAIT_V(8); PG8_WAIT_L(0); PG8_BAR; PG8_MMA(1, 0, At, B0); PG8_MMA(1, 1, At, B1); PG8_BAR; PG8_SCHED;
            PG8_LDB(B0, 1, 0); PG8_LDB(B1, 1, 1); PG8_SCHED; PG8_LDA(At, 1, 0); PG8_STAGE(PG8_SA(0, 1), a2 + hstep, voffA);
            PG8_WAIT_V(8); PG8_WAIT_L(0); PG8_BAR; PG8_MMA(0, 0, At, B0); PG8_MMA(0, 1, At, B1); PG8_BAR; PG8_SCHED;
            PG8_LDA(At, 1, 1); PG8_STAGE(PG8_SB(1, 0), b3, voffB); PG8_STAGE(PG8_SB(1, 1), b3 + hstep, voffB); PG8_STAGE(PG8_SA(1, 0), a3, voffA);
            PG8_WAIT_V(8); PG8_WAIT_L(0); PG8_BAR; PG8_MMA(1, 0, At, B0); PG8_MMA(1, 1, At, B1); PG8_BAR; PG8_SCHED;
            } else {
            PG8_LDB(B0, 0, 0); PG8_SCHED; PG8_LDA(At, 0, 0); PG8_STAGE(PG8_SA(1, 1), a1 + hstep, voffA);
            PG8_WAIT_L(8); PG8_BAR; PG8_WAIT_L(0); PG8_MMA(0, 0, At, B0); PG8_BAR; PG8_SCHED;
            PG8_LDB(B1, 0, 1); PG8_STAGE(PG8_SB(0, 0), b2, voffB);
            PG8_BAR; PG8_WAIT_L(0); PG8_MMA(0, 1, At, B1); PG8_BAR;
            PG8_LDA(At, 0, 1); PG8_STAGE(PG8_SA(0, 0), a2, voffA);
            PG8_BAR; PG8_WAIT_L(0); PG8_MMA(1, 0, At, B0); PG8_BAR; PG8_SCHED;
            PG8_STAGE(PG8_SB(0, 1), b2 + hstep, voffB);
            PG8_WAIT_V(6); PG8_BAR; PG8_MMA(1, 1, At, B1); PG8_BAR;
            PG8_LDB(B0, 1, 0); PG8_SCHED; PG8_LDA(At, 1, 0); PG8_STAGE(PG8_SA(0, 1), a2 + hstep, voffA);
            PG8_WAIT_L(8); PG8_BAR; PG8_WAIT_L(0); PG8_MMA(0, 0, At, B0); PG8_BAR; PG8_SCHED;
            PG8_LDB(B1, 1, 1); PG8_STAGE(PG8_SB(1, 0), b3, voffB);
            PG8_BAR; PG8_WAIT_L(0); PG8_MMA(0, 1, At, B1); PG8_BAR;
            PG8_LDA(At, 1, 1); PG8_STAGE(PG8_SA(1, 0), a3, voffA);
            PG8_BAR; PG8_WAIT_L(0); PG8_MMA(1, 0, At, B0); PG8_BAR; PG8_SCHED;
            PG8_STAGE(PG8_SB(1, 1), b3 + hstep, voffB);
            PG8_WAIT_V(6); PG8_BAR; PG8_MMA(1, 1, At, B1); PG8_BAR;
            }
        }
        if constexpr (ALIGN_EPI) { if (wr == 0) PG8_BAR; }
        if constexpr (!Epi::AFTER_DRAIN) { E(acc, cur, wr, wc, fr, fq); S.done(cur); }
        if (!has_next) break;
#pragma unroll
        for (int a = 0; a < 2; ++a)
#pragma unroll
            for (int b = 0; b < 2; ++b)
#pragma unroll
                for (int m = 0; m < 4; ++m)
#pragma unroll
                    for (int n = 0; n < 2; ++n) acc[a][b][m][n] = (f32x4){0.f, 0.f, 0.f, 0.f};
        cur = nxt; cA = nA; cB = nB; ++ui;
        if constexpr (ALIGN_EPI) { if (wr == 1) PG8_BAR; }
    }
    PG8_WAIT_V(0);
    if constexpr (!ALIGN_EPI) { if (wr == 0) PG8_BAR; }
    PG8_BAR;
    if constexpr (Epi::AFTER_DRAIN) { E.fused(acc, cur, wr, wc, fr, fq, lds, wid, lane); S.done(cur); }
#undef PG8_SA
#undef PG8_SB
#undef PG8_STAGE
#undef PG8_LDA
#undef PG8_LDB
#undef PG8_MMA
#undef PG8_WAIT_V
#undef PG8_WAIT_L
#undef PG8_BAR
#undef PG8_SCHED
}
}

#define GAS __attribute__((address_space(1)))
#define LAS __attribute__((address_space(3)))
typedef unsigned short bf16;
typedef unsigned v4u __attribute__((ext_vector_type(4)));
typedef float f32x4 __attribute__((ext_vector_type(4)));
typedef short bf16x8 __attribute__((ext_vector_type(8)));
typedef GAS unsigned gu32;
typedef GAS unsigned long long gu64;
#define RLX_AGENT __ATOMIC_RELAXED, __HIP_MEMORY_SCOPE_AGENT
#define LDS_WAIT() asm volatile("s_waitcnt lgkmcnt(0)" ::: "memory")
#define VM_WAIT() asm volatile("s_waitcnt vmcnt(0)" ::: "memory")
__device__ __forceinline__ unsigned long long rt() { return __builtin_amdgcn_s_memrealtime(); }
__device__ __forceinline__ unsigned f2bf(float f) { unsigned u = __builtin_bit_cast(unsigned, f); return (u + 0x7fffu + ((u >> 16) & 1u)) >> 16; }
__device__ __forceinline__ unsigned pk2(float lo, float hi) { return f2bf(lo) | (f2bf(hi) << 16); }

#define XB_TMO      128
#define XB_XCNT(j)  (256  + 64 * (j))
#define XB_XSUB(j)  (1280 + 64 * (j))
#define XB_XGEN(j)  (2304 + 64 * (j))
#define XB_TOP      3328
#define XB_TOPGEN   3392
#define XCD_BAR_WORDS 3456
#define XB_SPIN_CAP (1u << 18)

__device__ __forceinline__ unsigned xb_ld(unsigned* p)              { return __hip_atomic_load(p, __ATOMIC_RELAXED, __HIP_MEMORY_SCOPE_AGENT); }
__device__ __forceinline__ unsigned xb_add(unsigned* p, unsigned v) { return __hip_atomic_fetch_add(p, v, __ATOMIC_RELAXED, __HIP_MEMORY_SCOPE_AGENT); }
__device__ __forceinline__ unsigned xb_xcc_id() { return (unsigned)__builtin_amdgcn_s_getreg((3 << 11) | 20) & 0xFu; }
#define XB_SPIN(cond, bar) do { unsigned _sp = 0; while (cond) { __builtin_amdgcn_s_sleep(1); \
    if ((++_sp & 255u) == 0u) { if (xb_ld(&(bar)[XB_TMO])) break; if (_sp > XB_SPIN_CAP) { atomicAdd(&(bar)[XB_TMO], 1u); break; } } } } while (0)

struct XcdBarrier {
    unsigned* bar; unsigned x;
    volatile LAS unsigned* st;
};

__device__ __forceinline__ XcdBarrier xcd_barrier_post(unsigned* bar, volatile LAS unsigned* st) {
    XcdBarrier b; b.bar = bar; b.x = xb_xcc_id(); b.st = st;
    if (threadIdx.x == 0) { const unsigned rk = xb_add(&bar[XB_XCNT(b.x)], 1u); st[2] = rk; st[3] = b.x; }
    return b;
}
__device__ __forceinline__ void xcd_barrier_complete(unsigned* bar, unsigned x, unsigned& nloc, unsigned& nx) {
    const unsigned G = gridDim.x * gridDim.y * gridDim.z;
    unsigned sum, cnt, mine, sp = 0u;
    for (;;) {
        sum = 0u; cnt = 0u; mine = 0u;
#pragma unroll
        for (unsigned j = 0; j < 16; ++j) { const unsigned c = xb_ld(&bar[XB_XCNT(j)]); sum += c; cnt += (c > 0u) ? 1u : 0u; mine = (j == x) ? c : mine; }
        if (sum == G) break;
        __builtin_amdgcn_s_sleep(1);
        if ((++sp & 255u) == 0u) { if (xb_ld(&bar[XB_TMO])) break; if (sp > XB_SPIN_CAP) { atomicAdd(&bar[XB_TMO], 1u); break; } }
    }
    nloc = mine > 0u ? mine : 1u; nx = cnt > 0u ? cnt : 1u;
}

__device__ __forceinline__ void xcd_barrier_t0(const XcdBarrier& b) {
        unsigned* bar = b.bar;
        __builtin_amdgcn_s_waitcnt(0);
        unsigned nloc = b.st[0], nx = b.st[1];
        if (nloc == 0u) { xcd_barrier_complete(bar, b.x, nloc, nx); b.st[0] = nloc; b.st[1] = nx; }
        const unsigned old = xb_add(&bar[XB_XSUB(b.x)], 1u);
        const unsigned gen = old / nloc;
        if (old + 1u == (gen + 1u) * nloc) {
            __builtin_amdgcn_fence(__ATOMIC_RELEASE, "agent");
            asm volatile("s_waitcnt vmcnt(0)" ::: "memory");
            const unsigned og = xb_add(&bar[XB_TOP], 1u);
            const unsigned tg = og / nx;
            if (og + 1u == (tg + 1u) * nx) xb_add(&bar[XB_TOPGEN], 1u);
            else XB_SPIN(xb_ld(&bar[XB_TOPGEN]) == tg, bar);
            __builtin_amdgcn_fence(__ATOMIC_ACQUIRE, "agent");
            xb_add(&bar[XB_XGEN(b.x)], 1u);
            asm volatile("s_waitcnt vmcnt(0)" ::: "memory");
        } else {
            XB_SPIN(xb_ld(&bar[XB_XGEN(b.x)]) == gen, bar);
            __builtin_amdgcn_fence(__ATOMIC_ACQUIRE, "agent");
            asm volatile("s_waitcnt vmcnt(0)" ::: "memory");
        }
}
__device__ __forceinline__ void xcd_barrier(const XcdBarrier& b) {
    asm volatile("s_waitcnt vmcnt(0)" ::: "memory");
    __syncthreads();
    if (threadIdx.x == 0) xcd_barrier_t0(b);
    __syncthreads();
}
template <class Fn> __device__ __forceinline__ void xcd_barrier_side(const XcdBarrier& b, int wave, const Fn& side) {
    asm volatile("s_waitcnt vmcnt(0)" ::: "memory");
    __syncthreads();
    if (wave == 0) { if (threadIdx.x == 0) xcd_barrier_t0(b); }
    else side();
    __syncthreads();
}

constexpr int BATCH = 4, SEQ = 2048, DM = 2048, NH = 16, HD = 128, FF = 5632, DEPTH = 4;
constexpr int M = BATCH * SEQ;
constexpr float RMS_EPS = 1e-6f;
constexpr int NWAVES = 8;

constexpr size_t MiB = 1u << 20;
constexpr size_t WS_CTL = 0, CTL_ZERO_BYTES = 1 * MiB;
constexpr size_t WS_SSQ = 1 * MiB;
constexpr size_t WS_H = 2 * MiB;
constexpr size_t WS_HB = 66 * MiB;
constexpr size_t WS_Q = 98 * MiB, WS_K = 130 * MiB, WS_V = 162 * MiB;
constexpr size_t WS_MIX = 194 * MiB;
constexpr size_t WS_ACT = 226 * MiB;
constexpr size_t WS_W = 320 * MiB;
constexpr size_t W_FFN_STRIDE = 66 * MiB, W_FFN_DOWN = 44 * MiB;
constexpr size_t WS_WATT = WS_W + 8 * W_FFN_STRIDE;
constexpr size_t WS_END = WS_WATT + 112 * MiB;
constexpr int CW_BAR = 4096;

constexpr int RING_OFF = 0;
constexpr int SCALE_OFF = 135168;
constexpr int LDSCTL_OFF = 139264;
constexpr int LDS_BYTES = 147456;

namespace att {
using bf16x8 = __attribute__((ext_vector_type(8))) short;
using s16x4  = __attribute__((ext_vector_type(4))) short;
using f32x16 = __attribute__((ext_vector_type(16))) float;
using u32x4  = __attribute__((ext_vector_type(4))) unsigned;
constexpr int D = 128, QBLK = 32, KVBLK = 64, PITCH = 2048;
constexpr float SCALE = 0.088388347648318440f, LOG2E = 1.4426950408889634f;
constexpr int SHM_V = KVBLK * D * 2, SHM_K = KVBLK * D * 2;
constexpr int OST_ROW = 272, OST_WAVE = 32 * OST_ROW;
constexpr int OFF_V = 0, OFF_K = 2 * SHM_V, OFF_WS = NWAVES * OST_WAVE, OFF_BIAS = OFF_WS + NWAVES * 256;
static_assert(OFF_WS >= 2 * SHM_V + 2 * SHM_K && OFF_BIAS + (513 + 64) * 4 <= 131072, "attention LDS map");
#define KSWZ(row, colB) ((row) * 256 + ((colB) ^ (((row) & 7) << 4)))
#define SBAR() __builtin_amdgcn_sched_barrier(0)
__device__ __forceinline__ int crow(int r, int hi) { return (r & 3) + 8 * (r >> 2) + 4 * hi; }
__device__ __forceinline__ unsigned cvtpk(float lo, float hi) { unsigned r; asm volatile("v_cvt_pk_bf16_f32 %0, %1, %2" : "=v"(r) : "v"(lo), "v"(hi)); return r; }
__device__ __forceinline__ void qkt(f32x16& p0, f32x16& p1, const char* Ks, const bf16x8* qr, int r32, int hi) {
  p0 = f32x16{}; p1 = f32x16{};
  bf16x8 ka[4], kb[4];
#pragma unroll
  for (int hb = 0; hb < 2; ++hb) {
#pragma unroll
    for (int d = 0; d < 4; ++d) { const int cb = ((hb * 4 + d) * 16 + hi * 8) * 2;
      ka[d] = *reinterpret_cast<const bf16x8*>(Ks + KSWZ(r32, cb)); kb[d] = *reinterpret_cast<const bf16x8*>(Ks + KSWZ(32 + r32, cb)); }
    SBAR();
#pragma unroll
    for (int d = 0; d < 4; ++d) {
      p0 = __builtin_amdgcn_mfma_f32_32x32x16_bf16(ka[d], qr[hb * 4 + d], p0, 0, 0, 0);
      p1 = __builtin_amdgcn_mfma_f32_32x32x16_bf16(kb[d], qr[hb * 4 + d], p1, 0, 0, 0); }
    SBAR();
  }
}
__device__ __forceinline__ int v_st(int k, int c) { const int kk = (k & ~0xC) | ((k & 4) << 1) | ((k & 8) >> 1); return ((kk >> 3) * 4 + (c >> 5)) * 512 + ((kk & 7) * 32 + (c & 31)) * 2; }
__device__ __forceinline__ int v_rd_base(int lane) { return ((lane & 3) << 3) | (((lane >> 2) & 3) << 6) | (((lane >> 4) & 1) << 5) | (((lane >> 5) & 1) << 8); }
constexpr int v_rd_off(int d0, int ks, int half) { return d0 * 512 + ks * 4096 + half * 2048; }
template <int OFF> __device__ __forceinline__ s16x4 tr_read(int vb) {
  s16x4 r; asm volatile("ds_read_b64_tr_b16 %0, %1 offset:%2" : "=&v"(r) : "v"(vb), "i"(OFF) : "memory"); return r;
}
struct VFrag { s16x4 l0, h0, l1, h1, l2, h2, l3, h3; };
template <int D0> __device__ __forceinline__ void v_reads(VFrag& f, int vb) {
  f.l0 = tr_read<v_rd_off(D0, 0, 0)>(vb); f.h0 = tr_read<v_rd_off(D0, 0, 1)>(vb); f.l1 = tr_read<v_rd_off(D0, 1, 0)>(vb); f.h1 = tr_read<v_rd_off(D0, 1, 1)>(vb);
  f.l2 = tr_read<v_rd_off(D0, 2, 0)>(vb); f.h2 = tr_read<v_rd_off(D0, 2, 1)>(vb); f.l3 = tr_read<v_rd_off(D0, 3, 0)>(vb); f.h3 = tr_read<v_rd_off(D0, 3, 1)>(vb);
}
__device__ __forceinline__ void pv_mma(f32x16& od, const VFrag& f, bf16x8 pa0, bf16x8 pa1, bf16x8 pa2, bf16x8 pa3) {
#define PK(L, H) (bf16x8){L[0], L[1], L[2], L[3], H[0], H[1], H[2], H[3]}
  od = __builtin_amdgcn_mfma_f32_32x32x16_bf16(pa0, PK(f.l0, f.h0), od, 0, 0, 0);
  od = __builtin_amdgcn_mfma_f32_32x32x16_bf16(pa1, PK(f.l1, f.h1), od, 0, 0, 0);
  od = __builtin_amdgcn_mfma_f32_32x32x16_bf16(pa2, PK(f.l2, f.h2), od, 0, 0, 0);
  od = __builtin_amdgcn_mfma_f32_32x32x16_bf16(pa3, PK(f.l3, f.h3), od, 0, 0, 0);
#undef PK
}
__device__ __forceinline__ void pv_d0(f32x16* o, int vb, bf16x8 pa0, bf16x8 pa1, bf16x8 pa2, bf16x8 pa3) {
  VFrag fa, fb;
  v_reads<0>(fa, vb); v_reads<1>(fb, vb);
  asm volatile("s_waitcnt lgkmcnt(8)" ::: "memory"); SBAR(); pv_mma(o[0], fa, pa0, pa1, pa2, pa3); SBAR();
  v_reads<2>(fa, vb);
  asm volatile("s_waitcnt lgkmcnt(8)" ::: "memory"); SBAR(); pv_mma(o[1], fb, pa0, pa1, pa2, pa3); SBAR();
  v_reads<3>(fb, vb);
  asm volatile("s_waitcnt lgkmcnt(8)" ::: "memory"); SBAR(); pv_mma(o[2], fa, pa0, pa1, pa2, pa3); SBAR();
  asm volatile("s_waitcnt lgkmcnt(0)" ::: "memory"); SBAR(); pv_mma(o[3], fb, pa0, pa1, pa2, pa3);
}
__device__ __forceinline__ void pack_p(const f32x16& p0, const f32x16& p1, bf16x8& pa0, bf16x8& pa1, bf16x8& pa2, bf16x8& pa3) {
#define PK4(P, BASE, OUT) do { unsigned a0 = cvtpk(P[BASE + 0], P[BASE + 1]), a1 = cvtpk(P[BASE + 2], P[BASE + 3]);   \
    unsigned b0 = cvtpk(P[BASE + 4], P[BASE + 5]), b1 = cvtpk(P[BASE + 6], P[BASE + 7]);                              \
    auto r0 = __builtin_amdgcn_permlane32_swap(a0, b0, false, false); auto r1 = __builtin_amdgcn_permlane32_swap(a1, b1, false, false); \
    u32x4 w = {r0[0], r1[0], r0[1], r1[1]}; OUT = *reinterpret_cast<bf16x8*>(&w); } while (0)
  PK4(p0, 0, pa0); PK4(p0, 8, pa1); PK4(p1, 0, pa2); PK4(p1, 8, pa3);
#undef PK4
}
__device__ __forceinline__ void swap2(float x, float& lo, float& hi) {
  auto rr = __builtin_amdgcn_permlane32_swap(__float_as_uint(x), __float_as_uint(x), false, false); lo = __uint_as_float(rr[0]); hi = __uint_as_float(rr[1]);
}
__device__ __forceinline__ unsigned short f2bf1(float f) { return (unsigned short)(cvtpk(f, 0.f) & 0xffffu); }

struct Stg { bf16x8 vs0, vs1, ks0, ks1; };
__device__ __forceinline__ void sload(Stg& s, const unsigned short* Kh, const unsigned short* Vh, int k0, int sr, int sc) {
  s.vs0 = *reinterpret_cast<const bf16x8*>(Vh + (size_t)(k0 + sr) * PITCH + sc); s.vs1 = *reinterpret_cast<const bf16x8*>(Vh + (size_t)(k0 + 32 + sr) * PITCH + sc);
  s.ks0 = *reinterpret_cast<const bf16x8*>(Kh + (size_t)(k0 + sr) * PITCH + sc); s.ks1 = *reinterpret_cast<const bf16x8*>(Kh + (size_t)(k0 + 32 + sr) * PITCH + sc);
}
__device__ __forceinline__ void swrite(const Stg& s, char* lds, int buf, int sr, int sc, int vst0, int vst1) {
  *(bf16x8*)(lds + OFF_V + buf * SHM_V + vst0) = s.vs0; *(bf16x8*)(lds + OFF_V + buf * SHM_V + vst1) = s.vs1; const int kc = sc * 2;
  *(bf16x8*)(lds + OFF_K + buf * SHM_K + KSWZ(sr, kc)) = s.ks0; *(bf16x8*)(lds + OFF_K + buf * SHM_K + KSWZ(32 + sr, kc)) = s.ks1;
}
__device__ __forceinline__ void store_o(const f32x16* o, const float* rs, unsigned short* Ow, int r32, int hi, char* lds, int wid, int lane) {
  char* stg = lds + wid * OST_WAVE;
#pragma unroll
  for (int r = 0; r < 16; ++r) { const int orow = crow(r, hi);
#pragma unroll
    for (int d0 = 0; d0 < 4; ++d0) *(unsigned short*)(stg + orow * OST_ROW + (d0 * 32 + r32) * 2) = f2bf1(o[d0][r] * rs[r]); }
  asm volatile("s_waitcnt lgkmcnt(0)" ::: "memory");
#pragma unroll
  for (int j = 0; j < 8; ++j) { const int row = (lane >> 4) + 4 * j; const u32x4 v = *(const u32x4*)(stg + row * OST_ROW + (lane & 15) * 16);
    *(u32x4*)(Ow + (size_t)row * PITCH + (lane & 15) * 8) = v; }
}

template <bool MASK> __device__ __forceinline__ void stick_tile(f32x16& p0, f32x16& p1, float& Rm, int& Re, int tkh, int hi) {
  constexpr float C2 = SCALE * LOG2E;
  float x0[16], x1[16];
#pragma unroll
  for (int r = 0; r < 16; ++r) {
    { const float y = fmaxf(p0[r] * C2, -126.f); const float e = __builtin_amdgcn_exp2f(-y); const float sg = __builtin_amdgcn_rcpf(1.0f + e); const float om = e * sg;
      p0[r] = sg; x0[r] = (!MASK || ((r & 3) + 8 * (r >> 2)) < tkh) ? om : 1.0f; }
    { const float y = fmaxf(p1[r] * C2, -126.f); const float e = __builtin_amdgcn_exp2f(-y); const float sg = __builtin_amdgcn_rcpf(1.0f + e); const float om = e * sg;
      p1[r] = sg; x1[r] = (!MASK || (32 + (r & 3) + 8 * (r >> 2)) < tkh) ? om : 1.0f; }
  }
  float G[16];
#pragma unroll
  for (int c = 0; c < 4; ++c) {
    swap2((x0[4 * c] * x0[4 * c + 1]) * (x0[4 * c + 2] * x0[4 * c + 3]), G[2 * c], G[2 * c + 1]); swap2((x1[4 * c] * x1[4 * c + 1]) * (x1[4 * c + 2] * x1[4 * c + 3]), G[8 + 2 * c], G[8 + 2 * c + 1]);
  }
  float SG[16]; SG[15] = 1.0f;
#pragma unroll
  for (int g = 14; g >= 0; --g) SG[g] = SG[g + 1] * G[g + 1];
  const float total = SG[0] * G[0];
  const float Rs = ldexpf(Rm, Re);
#pragma unroll
  for (int c = 0; c < 4; ++c) {
    const float b0 = Rs * (hi ? SG[2 * c + 1] : SG[2 * c]), b1 = Rs * (hi ? SG[8 + 2 * c + 1] : SG[8 + 2 * c]);
    float e0[4], e1[4];
    e0[3] = b0; e0[2] = e0[3] * x0[4 * c + 3]; e0[1] = e0[2] * x0[4 * c + 2]; e0[0] = e0[1] * x0[4 * c + 1];
    e1[3] = b1; e1[2] = e1[3] * x1[4 * c + 3]; e1[1] = e1[2] * x1[4 * c + 2]; e1[0] = e1[1] * x1[4 * c + 1];
#pragma unroll
    for (int i = 0; i < 4; ++i) { const int r = 4 * c + i;
      const float a0 = p0[r] * e0[i], a1 = p1[r] * e1[i];
      p0[r] = (!MASK || ((r & 3) + 8 * (r >> 2)) < tkh) ? a0 : 0.f; p1[r] = (!MASK || (32 + (r & 3) + 8 * (r >> 2)) < tkh) ? a1 : 0.f; }
  }
  Rm *= total;
#pragma unroll
  for (int k = 0; k < 2; ++k) { const bool sm = Rm < 5.421010862427522e-20f; Rm = sm ? Rm * 18446744073709551616.0f : Rm; Re = sm ? Re - 64 : Re; }
}

__device__ __forceinline__ void stick_unit(const unsigned short* Q, const unsigned short* K, const unsigned short* V, unsigned short* O, int b, int h, int qb, char* lds, const int tid) {
  const int wid = __builtin_amdgcn_readfirstlane(tid >> 6), lane = tid & 63, r32 = lane & 31, hi = lane >> 5;
  const int t = 256 * qb + 32 * wid + r32;
  const int tmaxw = 256 * qb + 32 * wid + 31, tminw = 256 * qb + 32 * wid;
  const size_t rowb = (size_t)b * SEQ;
  bf16x8 qr[8];
  { const unsigned short* Qw = Q + (rowb + t) * PITCH + h * HD + hi * 8;
#pragma unroll
    for (int d0 = 0; d0 < 8; ++d0) qr[d0] = *reinterpret_cast<const bf16x8*>(Qw + d0 * 16); }
  const unsigned short* Kh = K + rowb * PITCH + h * HD; const unsigned short* Vh = V + rowb * PITCH + h * HD;
  const int sr = tid >> 4, sc = (tid & 15) * 8, vst0 = v_st(sr, sc), vst1 = v_st(32 + sr, sc);
  const int vb0 = (int)(uintptr_t)(lds + OFF_V) + v_rd_base(lane);
  f32x16 o[4] = {}; float Rm = 1.0f; int Re = 0;
  const int NT = 4 * qb + 4; int buf = 0;
  Stg st;
  volatile __attribute__((address_space(3))) int* flags = (volatile __attribute__((address_space(3))) int*)(lds + OFF_WS);
  bool wdone = false;
  __syncthreads();
  if (lane < 2) flags[lane * 8 + wid] = 0;
  sload(st, Kh, Vh, (NT - 1) * KVBLK, sr, sc); asm volatile("s_waitcnt vmcnt(0)" ::: "memory"); swrite(st, lds, 0, sr, sc, vst0, vst1); __syncthreads();
  for (int kt = NT - 1; kt >= 0; --kt) {
    if (kt > 0) sload(st, Kh, Vh, (kt - 1) * KVBLK, sr, sc);
    const int k0 = kt * KVBLK;
    if (k0 < tmaxw && !wdone) {
      f32x16 p0, p1;
      qkt(p0, p1, lds + OFF_K + buf * SHM_K, qr, r32, hi);
      const int tkh = t - k0 - 4 * hi;
      if (k0 + 63 < tminw) stick_tile<false>(p0, p1, Rm, Re, tkh, hi); else stick_tile<true>(p0, p1, Rm, Re, tkh, hi);
      bf16x8 pa0, pa1, pa2, pa3; pack_p(p0, p1, pa0, pa1, pa2, pa3);
      pv_d0(o, vb0 + buf * SHM_V, pa0, pa1, pa2, pa3);
      wdone = __all(Re <= -192 || Rm == 0.f);
    }
    if (lane == 0) flags[(kt & 1) * 8 + wid] = wdone ? 1 : 0;
    if (kt > 0) { asm volatile("s_waitcnt vmcnt(0)" ::: "memory"); swrite(st, lds, buf ^ 1, sr, sc, vst0, vst1); }
    __syncthreads();
    buf ^= 1;
    { const int fl = flags[(kt & 1) * 8 + (lane & 7)]; if (__all(fl != 0)) break; }
  }
  float rs[16];
#pragma unroll
  for (int r = 0; r < 16; ++r) rs[r] = 1.0f;
  store_o(o, rs, O + (rowb + 256 * qb + 32 * wid) * PITCH + h * HD, r32, hi, lds, wid, lane);
  if (PROBE_DUP == 10) { asm volatile("s_waitcnt vmcnt(0)" ::: "memory"); store_o(o, rs, O + (rowb + 256 * qb + 32 * wid) * PITCH + h * HD, r32, hi, lds, wid, lane); }
}

__device__ __forceinline__ void band_unit(const unsigned short* Q, const unsigned short* K, const unsigned short* V, unsigned short* O, const float* bias  , int b, int h, int qb, char* lds, const int tid) {
  const int wid = __builtin_amdgcn_readfirstlane(tid >> 6), lane = tid & 63, r32 = lane & 31, hi = lane >> 5;
  const int t = 256 * qb + 32 * wid + r32;
  const int cq = 4 * qb + (wid >> 1);
  const size_t rowb = (size_t)b * SEQ;
  bf16x8 qr[8];
  { const unsigned short* Qw = Q + (rowb + t) * PITCH + h * HD + hi * 8;
#pragma unroll
    for (int d0 = 0; d0 < 8; ++d0) qr[d0] = *reinterpret_cast<const bf16x8*>(Qw + d0 * 16); }
  const unsigned short* Kh = K + rowb * PITCH + h * HD; const unsigned short* Vh = V + rowb * PITCH + h * HD;
  const int sr = tid >> 4, sc = (tid & 15) * 8, vst0 = v_st(sr, sc), vst1 = v_st(32 + sr, sc);
  const int vb0 = (int)(uintptr_t)(lds + OFF_V) + v_rd_base(lane);
  float* wsf = (float*)(lds + OFF_WS) + wid * 64; float* al_l = wsf + 32;
  float* bias_l = (float*)(lds + OFF_BIAS);
  f32x16 o[4] = {}; f32x16 lacc = {}; float m_reg = -1e30f;
  const int kc_lo = (4 * qb - 8) > 0 ? (4 * qb - 8) : 0, kc_hi = 4 * qb + 3; int buf = 0;
  Stg st;
  const bf16x8 ones = {0x3F80, 0x3F80, 0x3F80, 0x3F80, 0x3F80, 0x3F80, 0x3F80, 0x3F80};
  constexpr float THR2 = 8.0f * LOG2E;
  __syncthreads();
  for (int i = tid; i < 513 + 64; i += NWAVES * 64) bias_l[i] = bias[i < 512 ? i : 512] * LOG2E;
  sload(st, Kh, Vh, kc_lo * KVBLK, sr, sc); asm volatile("s_waitcnt vmcnt(0)" ::: "memory"); swrite(st, lds, 0, sr, sc, vst0, vst1); __syncthreads();
  for (int kc = kc_lo; kc <= kc_hi; ++kc) {
    if (kc < kc_hi) sload(st, Kh, Vh, (kc + 1) * KVBLK, sr, sc);
    if (kc >= cq - 8 && kc <= cq) {
      f32x16 p0, p1;
      qkt(p0, p1, lds + OFF_K + buf * SHM_K, qr, r32, hi);
      constexpr float C2 = SCALE * LOG2E;
      float pmax = -1e30f;
      if (kc <= cq - 5) {
        const float bfar = bias_l[512];
#pragma unroll
        for (int r = 0; r < 16; ++r) { p0[r] = p0[r] * C2 + bfar; p1[r] = p1[r] * C2 + bfar; pmax = fmaxf(pmax, fmaxf(p0[r], p1[r])); }
      } else {
        const float* bp = bias_l + (t - kc * KVBLK - 4 * hi + 256);
        float bv0[16], bv1[16];
#pragma unroll
        for (int r = 0; r < 16; ++r) { bv0[r] = bp[-((r & 3) + 8 * (r >> 2))]; bv1[r] = bp[-(32 + (r & 3) + 8 * (r >> 2))]; }
        SBAR();
#pragma unroll
        for (int r = 0; r < 16; ++r) { p0[r] = p0[r] * C2 + bv0[r]; p1[r] = p1[r] * C2 + bv1[r]; pmax = fmaxf(pmax, fmaxf(p0[r], p1[r])); }
      }
      { float lo, hh; swap2(pmax, lo, hh); pmax = fmaxf(lo, hh); }
      float mn, alpha;
      if (__all(pmax - m_reg <= THR2)) { mn = m_reg; alpha = 1.f; } else { mn = fmaxf(m_reg, pmax); alpha = __builtin_amdgcn_exp2f(m_reg - mn); m_reg = mn; }
#pragma unroll
      for (int r = 0; r < 16; ++r) { p0[r] = __builtin_amdgcn_exp2f(p0[r] - mn); p1[r] = __builtin_amdgcn_exp2f(p1[r] - mn); }
      if (__any(alpha < 1.f)) { if (hi == 0) al_l[r32] = alpha; asm volatile("s_waitcnt lgkmcnt(0)" ::: "memory");
#pragma unroll
        for (int r = 0; r < 16; ++r) { const float a = al_l[crow(r, hi)]; lacc[r] *= a;
#pragma unroll
          for (int d = 0; d < 4; ++d) o[d][r] *= a; } }
      bf16x8 pa0, pa1, pa2, pa3; pack_p(p0, p1, pa0, pa1, pa2, pa3);
      lacc = __builtin_amdgcn_mfma_f32_32x32x16_bf16(pa0, ones, lacc, 0, 0, 0); lacc = __builtin_amdgcn_mfma_f32_32x32x16_bf16(pa1, ones, lacc, 0, 0, 0);
      lacc = __builtin_amdgcn_mfma_f32_32x32x16_bf16(pa2, ones, lacc, 0, 0, 0); lacc = __builtin_amdgcn_mfma_f32_32x32x16_bf16(pa3, ones, lacc, 0, 0, 0);
      pv_d0(o, vb0 + buf * SHM_V, pa0, pa1, pa2, pa3);
    }
    if (kc < kc_hi) { asm volatile("s_waitcnt vmcnt(0)" ::: "memory"); swrite(st, lds, buf ^ 1, sr, sc, vst0, vst1); }
    __syncthreads();
    buf ^= 1;
  }
  float rs[16];
#pragma unroll
  for (int r = 0; r < 16; ++r) rs[r] = __builtin_amdgcn_rcpf(lacc[r]);
  store_o(o, rs, O + (rowb + 256 * qb + 32 * wid) * PITCH + h * HD, r32, hi, lds, wid, lane);
  if (PROBE_DUP == 10) { asm volatile("s_waitcnt vmcnt(0)" ::: "memory"); store_o(o, rs, O + (rowb + 256 * qb + 32 * wid) * PITCH + h * HD, r32, hi, lds, wid, lane); }
}
#undef KSWZ
#undef SBAR
}

struct Frame {
    LAS unsigned char* lds;
    volatile LAS unsigned* MISC;
    gu32* ctl;
    int tid, lane, wave;
    int vcu, G;
};
__device__ __forceinline__ float wave_sum(float v) {
#pragma unroll
    for (int o = 1; o < 64; o <<= 1) v += __shfl_xor(v, o);
    return v;
}
struct ConvItem { const float* src; const float* gain; bf16* dst; int N, Kd; };
__device__ __forceinline__ void tr_load(const ConvItem& c, f32x4 (&v)[16], int lane) {
    const float* src = c.src + (size_t)(lane >> 4) * c.N + (lane & 15) * 4;
#pragma unroll
    for (int j = 0; j < 16; ++j) v[j] = __builtin_nontemporal_load((const f32x4*)(src + (size_t)(4 * j) * c.N));
}
__device__ __forceinline__ void tr_lds_write(const f32x4 (&v)[16], LAS float* scr, int lane) {
    LAS float* d = scr + (lane >> 4) * 65 + (lane & 15) * 4;
#pragma unroll
    for (int j = 0; j < 16; ++j) { d[(4 * j) * 65 + 0] = v[j][0]; d[(4 * j) * 65 + 1] = v[j][1]; d[(4 * j) * 65 + 2] = v[j][2]; d[(4 * j) * 65 + 3] = v[j][3]; }
}
__device__ __forceinline__ void tr_store(const ConvItem& it, LAS float* scr, int lane) {
    const int c = lane & 7;
    float gk[8];
#pragma unroll
    for (int i = 0; i < 8; ++i) gk[i] = it.gain ? it.gain[8 * c + i] : 1.0f;
    LDS_WAIT(); asm volatile("" ::: "memory");
#pragma unroll
    for (int j = 0; j < 8; ++j) { const int n = (lane >> 3) + 8 * j; const LAS float* s = scr + (8 * c) * 65 + n;
        v4u o; o.x = pk2(s[0 * 65] * gk[0], s[1 * 65] * gk[1]); o.y = pk2(s[2 * 65] * gk[2], s[3 * 65] * gk[3]); o.z = pk2(s[4 * 65] * gk[4], s[5 * 65] * gk[5]); o.w = pk2(s[6 * 65] * gk[6], s[7 * 65] * gk[7]);
        __builtin_nontemporal_store(o, (GAS v4u*)(it.dst + (size_t)n * it.Kd + 8 * c)); }
    LDS_WAIT(); asm volatile("" ::: "memory");
}

struct Args { const float* in[14]; float* out; unsigned char* ws; int ph_lo, ph_hi; };

__device__ __forceinline__ bf16* w_gu(unsigned char* ws, int f) { return (bf16*)(ws + WS_W + (size_t)f * W_FFN_STRIDE); }
__device__ __forceinline__ bf16* w_dn(unsigned char* ws, int f) { return (bf16*)(ws + WS_W + (size_t)f * W_FFN_STRIDE + W_FFN_DOWN); }
__device__ __forceinline__ bf16* w_mix1(unsigned char* ws, int layer) { return (bf16*)(ws + WS_WATT + (size_t)layer * 32 * MiB); }
__device__ __forceinline__ bf16* w_mixo(unsigned char* ws, int layer) { return (bf16*)(ws + WS_WATT + (size_t)layer * 32 * MiB + (layer < 3 ? 24 : 8) * MiB); }

constexpr int CONV_TOTAL = 81920;
#ifndef CONV_CAP
#define CONV_CAP 8192
#endif
#ifndef CONV_NBW
#define CONV_NBW 4
#endif
constexpr int CONV_NB = CONV_NBW * 256;
constexpr int bar_off(int b) { if (b <= 0) return 0; const int L = (b - 1) / 7, j = (b - 1) % 7 + 1; return CONV_NB + L * (7 * CONV_NB + 2 * CONV_CAP) + CONV_CAP + (j - 1) * CONV_NB + (j >= 6 ? CONV_CAP : 0); }
constexpr int slot_off(int k) { return CONV_NB + (k / 2) * (7 * CONV_NB + 2 * CONV_CAP) + ((k & 1) ? CONV_CAP + 5 * CONV_NB : 0); }
constexpr int conv_up() { int u = 0;
    for (int L = 0; L < 4; ++L) { const int base = L * 20992, msz = L < 3 ? 4096 : 2048, q = L < 3 ? 3072 : 1024;
        const int need[6] = {base + 5632, base + 8448, base + 8448 + q, base + 8448 + msz, base + 8448 + msz + 5632, base + 8448 + msz + 8448};
        const int at[6] = {7 * L, 7 * L + 1, 7 * L + 2, 7 * L + 4, 7 * L + 5, 7 * L + 6};
        for (int i = 0; i < 6; ++i) { const int d = need[i] - bar_off(at[i]); if (d > u) u = d; } }
    return u < CONV_TOTAL ? u : CONV_TOTAL; }
constexpr int CONV_UP = (CONV_CAP > 0 || CONV_NBW > 0) ? conv_up() : CONV_TOTAL;
static_assert(CONV_UP + bar_off(27) >= CONV_TOTAL, "conversion schedule covers every item");
static_assert(CONV_NBW >= 0 && CONV_NBW <= 7, "waves 1..7 only");
__device__ __forceinline__ void conv_decode(const Args& a, int it, ConvItem& ci) {
    unsigned char* ws = a.ws;
    const float *g_ffn = a.in[1], *wg = a.in[2], *wu = a.in[3], *wd = a.in[4], *g_mix = a.in[5], *wqkv = a.in[6], *woa = a.in[7], *g_kv = a.in[8], *wkv = a.in[9], *wqb = a.in[10], *wob = a.in[11];
        const float* W; const float* gain = nullptr; bf16* WT; int N, Kd, kb, nb, drow_add = 0; bool ilv = false; int mat = 0;
        int L = it / 20992; if (L > 3) L = 3; int r = it - L * 20992;
        const int msz = L < 3 ? 4096 : 2048;
        int f = 2 * L; bool ffn = true;
        if (r >= 8448) { r -= 8448; if (r < msz) ffn = false; else { r -= msz; f = 2 * L + 1; } }
        if (ffn) { mat = r / 2816; r -= mat * 2816;
            if (mat < 2) { N = FF; Kd = DM; W = (mat == 0 ? wg : wu) + (size_t)f * DM * FF; gain = g_ffn + (size_t)f * DM; WT = w_gu(ws, f); kb = r / 88; nb = r - kb * 88; ilv = true; }
            else { N = DM; Kd = FF; W = wd + (size_t)f * FF * DM; WT = w_dn(ws, f); kb = r / 32; nb = r - kb * 32; }
        } else if (L < 2) {
            if (r < 3072) { N = 3 * DM; Kd = DM; W = wqkv + (size_t)L * DM * 3 * DM; gain = g_mix + (size_t)L * DM; WT = w_mix1(ws, L); kb = r / 96; nb = r - kb * 96; }
            else { r -= 3072; N = DM; Kd = DM; W = woa + (size_t)L * DM * DM; WT = w_mixo(ws, L); kb = r / 32; nb = r - kb * 32; }
        } else if (L == 2) {
            if (r < 1024) { N = DM; Kd = DM; W = wqb; gain = g_mix + 2 * DM; WT = w_mix1(ws, 2); kb = r / 32; nb = r - kb * 32; }
            else if (r < 3072) { r -= 1024; N = 2 * DM; Kd = DM; W = wkv; gain = g_kv; WT = w_mix1(ws, 2); kb = r / 64; nb = r - kb * 64; drow_add = DM; }
            else { r -= 3072; N = DM; Kd = DM; W = wob; WT = w_mixo(ws, 2); kb = r / 32; nb = r - kb * 32; }
        } else {
            if (r < 1024) { N = DM; Kd = DM; W = wqb + (size_t)DM * DM; gain = g_mix + 3 * DM; WT = w_mix1(ws, 3); kb = r / 32; nb = r - kb * 32; }
            else { r -= 1024; N = DM; Kd = DM; W = wob + (size_t)DM * DM; WT = w_mixo(ws, 3); kb = r / 32; nb = r - kb * 32; }
        }
        const int n0 = nb * 64, k0 = kb * 64; const int drow = ilv ? (256 * (n0 >> 7) + (n0 & 127) + 128 * mat) : (n0 + drow_add);
        ci.src = W + (size_t)k0 * N + n0; ci.gain = gain ? gain + k0 : nullptr; ci.dst = WT + (size_t)drow * Kd + k0; ci.N = N; ci.Kd = Kd;
}
__device__ __forceinline__ void conv_one(Frame& F, const Args& a, int it) {
    LAS float* scr = (LAS float*)(F.lds + RING_OFF + F.wave * 16640);
    int lane_ = threadIdx.x; asm volatile("" : "+v"(lane_)); lane_ &= 63;
    ConvItem c; f32x4 v[16]; conv_decode(a, it, c); tr_load(c, v, lane_); tr_lds_write(v, scr, lane_); tr_store(c, scr, lane_);
}
__device__ __forceinline__ void conv_items(Frame& F, const Args& a, int it_lo, int it_hi, int rank, int nranks) {
    LAS float* scr = (LAS float*)(F.lds + RING_OFF + F.wave * 16640);
    auto decode = [&](int it, ConvItem& ci) { conv_decode(a, it, ci); };
    const int stride = nranks * NWAVES; int it = it_lo + rank * NWAVES + F.wave;
    int lane_ = threadIdx.x; asm volatile("" : "+v"(lane_)); lane_ &= 63;
    ConvItem cA, cB; f32x4 vA[16], vB[16];
    if (it < it_hi) { decode(it, cA); tr_load(cA, vA, lane_); }
    if (it + stride < it_hi) { decode(it + stride, cB); tr_load(cB, vB, lane_); }
    while (it < it_hi) {
        tr_lds_write(vA, scr, lane_);
        { const ConvItem cur = cA; const int itn = it + 2 * stride; if (itn < it_hi) { decode(itn, cA); tr_load(cA, vA, lane_); } tr_store(cur, scr, lane_); }
        it += stride; if (it >= it_hi) break;
        tr_lds_write(vB, scr, lane_);
        { const ConvItem cur = cB; const int itn = it + 2 * stride; if (itn < it_hi) { decode(itn, cB); tr_load(cB, vB, lane_); } tr_store(cur, scr, lane_); }
        it += stride;
    }
}
__device__ __forceinline__ int lo_perm(int c) { return (c & ~255) | (((c >> 5) & 3) << 6) | (((c >> 3) & 3) << 4) | (((c >> 7) & 1) << 3) | (c & 7); }
__device__ __forceinline__ void p0_prologue(Frame& F, const Args& a) {
    unsigned char* ws = a.ws;
    const int gw = F.vcu * NWAVES + F.wave, NGW = F.G * NWAVES;
    conv_items(F, a, 0, CONV_UP, F.vcu, F.G);
    const float* x = a.in[0]; bf16* hb = (bf16*)(ws + WS_HB); bf16* hl = (bf16*)(ws + WS_H); float* ssq = (float*)(ws + WS_SSQ);
    int lane_ = threadIdx.x; asm volatile("" : "+v"(lane_)); lane_ &= 63;
    for (int m = gw; m < M; m += NGW) {
        const GAS f32x4* xr = (const GAS f32x4*)(x + (size_t)m * DM) + lane_; f32x4 v[8]; float s = 0.f;
#pragma unroll
        for (int j = 0; j < 8; ++j) { v[j] = xr[64 * j]; s += (v[j].x * v[j].x + v[j].y * v[j].y) + (v[j].z * v[j].z + v[j].w * v[j].w); }
        s = wave_sum(s);
        GAS unsigned long long* o8 = (GAS unsigned long long*)(hb + (size_t)m * DM) + lane_; GAS unsigned long long* l8 = (GAS unsigned long long*)(hl + (size_t)m * DM) + lane_;
#pragma unroll
        for (int j = 0; j < 8; ++j) { const unsigned h0 = pk2(v[j].x, v[j].y), h1 = pk2(v[j].z, v[j].w);
            o8[64 * j] = (unsigned long long)h0 | ((unsigned long long)h1 << 32);
            if (RESID_LO == 1) l8[64 * j] = (unsigned long long)pk2(v[j].x - pg8::bf_lo(h0), v[j].y - pg8::bf_hi(h0)) | ((unsigned long long)pk2(v[j].z - pg8::bf_lo(h1), v[j].w - pg8::bf_hi(h1)) << 32);
            if (RESID_LO == 2) { int w = __builtin_amdgcn_cvt_pk_fp8_f32((v[j].x - pg8::bf_lo(h0)) * 512.0f, (v[j].y - pg8::bf_hi(h0)) * 512.0f, 0, false);
                w = __builtin_amdgcn_cvt_pk_fp8_f32((v[j].z - pg8::bf_lo(h1)) * 512.0f, (v[j].w - pg8::bf_hi(h1)) * 512.0f, w, true);
                *(GAS unsigned*)((unsigned char*)hl + (size_t)m * DM + lo_perm(4 * (lane_ + 64 * j))) = (unsigned)w; } }
        if (lane_ < 32) ssq[(size_t)m * 32 + lane_] = lane_ == 0 ? s : 0.f;
    }
}
__device__ __forceinline__ void final_norm(Frame& F, const Args& a) {
    const int gw = F.vcu * NWAVES + F.wave, NGW = F.G * NWAVES;
    const bf16* hb = (const bf16*)(a.ws + WS_HB); const bf16* hl = (const bf16*)(a.ws + WS_H); const float* ssq = (const float*)(a.ws + WS_SSQ); const float* g = a.in[13];
    int lane_ = threadIdx.x; asm volatile("" : "+v"(lane_)); lane_ &= 63;
    f32x4 gv[8];
#pragma unroll
    for (int j = 0; j < 8; ++j) gv[j] = ((const GAS f32x4*)g)[lane_ + 64 * j];
    for (int m = gw; m < M; m += NGW) {
        float s = lane_ < 32 ? ssq[(size_t)m * 32 + lane_] : 0.f; s = wave_sum(s);
        const float rs = __builtin_amdgcn_rsqf(s * (1.0f / DM) + RMS_EPS);
        const GAS unsigned long long* hr = (const GAS unsigned long long*)(hb + (size_t)m * DM) + lane_; const GAS unsigned long long* lr = (const GAS unsigned long long*)(hl + (size_t)m * DM) + lane_;
        GAS f32x4* orow = (GAS f32x4*)(a.out + (size_t)m * DM) + lane_;
#pragma unroll
        for (int j = 0; j < 8; ++j) { const unsigned long long hw = hr[64 * j]; const unsigned h0 = (unsigned)hw, h1 = (unsigned)(hw >> 32);
            f32x4 hv = {pg8::bf_lo(h0), pg8::bf_hi(h0), pg8::bf_lo(h1), pg8::bf_hi(h1)};
            if (RESID_LO == 1) { const unsigned long long lw = lr[64 * j]; const unsigned l0 = (unsigned)lw, l1 = (unsigned)(lw >> 32); hv += (f32x4){pg8::bf_lo(l0), pg8::bf_hi(l0), pg8::bf_lo(l1), pg8::bf_hi(l1)}; }
            if (RESID_LO == 2) { typedef float f32x2v __attribute__((ext_vector_type(2))); const int w = (int)*(const GAS unsigned*)((const unsigned char*)hl + (size_t)m * DM + lo_perm(4 * (lane_ + 64 * j)));
                const f32x2v a = __builtin_amdgcn_cvt_pk_f32_fp8(w, false), b = __builtin_amdgcn_cvt_pk_f32_fp8(w, true); hv += (f32x4){a.x, a.y, b.x, b.y} * (1.0f / 512.0f); }
            orow[64 * j] = hv * rs * gv[j]; }
    }
}

#ifndef KN_ALIGN
#define KN_ALIGN true
#endif
#ifndef KN_SP2
#define KN_SP2 true
#endif
#ifndef MK_PER_PHASE
#define MK_PER_PHASE 0
#endif
constexpr size_t WS_DUMMY = 960 * MiB;
constexpr int N_PHASES = 38;
__global__ void __launch_bounds__(NWAVES * 64, 2) mega_fwd(Args args) {
    extern __shared__ __attribute__((aligned(16))) unsigned char lds[];
    Frame F;
    F.lds = (LAS unsigned char*)lds;
    F.MISC = (volatile LAS unsigned*)(F.lds + LDSCTL_OFF);
    F.tid = threadIdx.x; F.lane = F.tid & 63; F.wave = __builtin_amdgcn_readfirstlane(F.tid >> 6);
    F.G = gridDim.x; { const int bx = blockIdx.x; F.vcu = (F.G % 8 == 0) ? (bx % 8) * (F.G / 8) + bx / 8 : bx; }
    unsigned char* ws = args.ws;
    F.ctl = (gu32*)(ws + WS_CTL);
    for (int u = F.tid; u < 256; u += NWAVES * 64) ((LAS unsigned*)(F.lds + LDSCTL_OFF))[u] = 0u;
    __syncthreads();
#if MK_PER_PHASE
#define GRID_BAR() do { } while (0)
#else
    XcdBarrier bar = xcd_barrier_post((unsigned*)(F.ctl + CW_BAR), F.MISC + 8);
    int bar_cls = 0;
#ifndef PROBE_BLK
#define PROBE_BLK 0
#endif
#ifndef PROBE_CLS
#define PROBE_CLS -1
#endif
#define GRID_BAR() do { unsigned long long t0_ = 0; if (PROBE_DUP == 13 && blockIdx.x == PROBE_BLK && F.tid == 0) t0_ = __builtin_amdgcn_s_memrealtime(); xcd_barrier(bar); if (PROBE_DUP == 12) xcd_barrier(bar); \
    if (PROBE_DUP == 13 && blockIdx.x == PROBE_BLK && F.tid == 0 && (PROBE_CLS < 0 || PROBE_CLS == bar_cls)) { volatile unsigned long long* pw = (volatile unsigned long long*)(ws + WS_CTL + 8192); *pw = *pw + (__builtin_amdgcn_s_memrealtime() - t0_); } } while (0)
#endif
#if MK_PER_PHASE || CONV_NBW == 0
#define GRID_BARC() GRID_BAR()
#else
    int bidx = 0;
#define GRID_BARC() do { const int bo_ = CONV_UP + bar_off(bidx); ++bidx; \
    xcd_barrier_side(bar, F.wave, [&]() { if (F.wave <= CONV_NBW) for (int j_ = F.vcu * CONV_NBW + F.wave - 1; j_ < CONV_NB; j_ += F.G * CONV_NBW) { const int it_ = bo_ + j_; if (it_ < CONV_TOTAL) conv_one(F, args, it_); } }); } while (0)
#endif
    const int lo = args.ph_lo, hi = args.ph_hi;
#define IN(k) (lo <= (k) && (k) < hi)
#define BOTH(k) (IN(k) && (k) + 1 < hi)

    bf16* HL = (bf16*)(ws + WS_H); bf16* HB = (bf16*)(ws + WS_HB); float* SSQ = (float*)(ws + WS_SSQ);
    bf16* QB = (bf16*)(ws + WS_Q); bf16* KB = (bf16*)(ws + WS_K); bf16* VB = (bf16*)(ws + WS_V); bf16* MIX = (bf16*)(ws + WS_MIX); bf16* ACT = (bf16*)(ws + WS_ACT);

    if (IN(0)) { p0_prologue(F, args); if (PROBE_DUP == 1) { GRID_BAR(); p0_prologue(F, args); } if (BOTH(0)) GRID_BARC(); }
    int cid = (int)blockIdx.x;
#if !MK_PER_PHASE
    if (lo == 0 && hi > 1) {
        if (F.tid == 0) { bool ok = (F.G % 8) == 0;
            for (unsigned j = 0; j < 16; ++j) { const unsigned cnt = xb_ld((unsigned*)(F.ctl + CW_BAR) + XB_XCNT(j)); ok = ok && (cnt == (j < 8 ? (unsigned)F.G / 8u : 0u)); }
            F.MISC[12] = ok ? (F.MISC[10] * 8u + F.MISC[11]) : (unsigned)blockIdx.x; }
        __syncthreads();
        cid = __builtin_amdgcn_readfirstlane((int)F.MISC[12]);
    }
#endif
    const int vcid = (F.G % 8 == 0) ? (cid % 8) * (F.G / 8) + cid / 8 : cid;

#pragma unroll 1
    for (int s = 0; s < 12; ++s) {
        const int layer = s / 3, kind = s - 3 * layer, pb = 1 + 3 * s;
        int ltid = threadIdx.x; asm volatile("" : "+v"(ltid));
        unsigned long long pc0 = 0, pr0 = 0;
        if (PROBE_DUP == 11 && s == 3 && blockIdx.x == 0 && F.tid == 0) { pc0 = __builtin_amdgcn_s_memtime(); pr0 = __builtin_amdgcn_s_memrealtime(); }
        if (IN(pb)) {
          for (int rep = 0; rep < (((PROBE_DUP == 4 && kind != 1) || (PROBE_DUP == 6 && kind == 1)) ? 2 : 1); ++rep) {
            if (rep) GRID_BAR();
            asm volatile("" : "+v"(ltid));
            int pm0 = -1; const PG8_LAS float* stab = (const PG8_LAS float*)(F.lds + SCALE_OFF);
            { pg8::StaticOrder S0; S0.init(M, kind != 1 ? 2 * FF : (layer < 3 ? 3 * DM : DM), F.G, cid); pg8::Unit u0;
              if (S0.next(0, u0)) pm0 = u0.pm; }
            f32x4 sv[4];
#pragma unroll
            for (int q = 0; q < 4; ++q) sv[q] = (f32x4){0.f, 0.f, 0.f, 0.f};
            if (pm0 >= 0) { const f32x4* p = (const f32x4*)(SSQ + (size_t)(pm0 * 256 + (ltid >> 1)) * 32 + (ltid & 1) * 16);
#pragma unroll
                for (int q = 0; q < 4; ++q) sv[q] = p[q]; }
            auto pre = [&]() { if (pm0 >= 0) { float a = 0.f;
#pragma unroll
                for (int q = 0; q < 4; ++q) a += (sv[q][0] + sv[q][1]) + (sv[q][2] + sv[q][3]);
                a += __shfl_xor(a, 1);
                if ((ltid & 1) == 0) ((PG8_LAS float*)(F.lds + SCALE_OFF))[ltid >> 1] = __builtin_amdgcn_rsqf(a * (1.0f / DM) + RMS_EPS); } };
            if (kind != 1) {
                const int f = 2 * layer + (kind >> 1);
                pg8::Gemm g{HB, w_gu(ws, f), M, 2 * FF, DM}; pg8::StaticOrder S; S.init(M, 2 * FF, F.G, cid);
                pg8::EpiSwiglu E{ACT, FF, SSQ, stab, pm0};
                const int nu = (M / 256) * (2 * FF / 256), rem = nu % F.G, c = cid;
                const int lo_it = CONV_UP + (CONV_NB + (f >> 1) * (7 * CONV_NB + 2 * CONV_CAP) + ((f & 1) ? CONV_CAP + 5 * CONV_NB : 0)), hi_it = (lo_it + CONV_CAP) < CONV_TOTAL ? (lo_it + CONV_CAP) : CONV_TOTAL;
                const bool cv = CONV_CAP > 0 && lo_it < hi_it && (rem == 0 || c >= rem); const int crank = rem == 0 ? c : c - rem, cn = rem == 0 ? F.G : F.G - rem;
                pg8::gemm_phase<pg8::EpiSwiglu, pg8::StaticOrder, KN_ALIGN, KN_SP2>(F.lds + RING_OFF, g, S, E, ltid, pre);
                if (cv) conv_items(F, args, lo_it, hi_it, crank, cn);
            } else {
                const int N = layer < 3 ? 3 * DM : DM;
                pg8::Gemm g{HB, w_mix1(ws, layer), M, N, DM}; pg8::StaticOrder S; S.init(M, N, F.G, cid);
                pg8::EpiScaleBf16 E{QB, (size_t)(WS_K - WS_Q) / 2, SSQ, stab, pm0};
                pg8::gemm_phase<pg8::EpiScaleBf16, pg8::StaticOrder, KN_ALIGN, KN_SP2>(F.lds + RING_OFF, g, S, E, ltid, pre);
            }
          }
            if (PROBE_DUP == 11 && s == 3 && blockIdx.x == 0 && F.tid == 0) {
                const unsigned long long cyc = __builtin_amdgcn_s_memtime() - pc0, rt = __builtin_amdgcn_s_memrealtime() - pr0;
                const unsigned long long delay = cyc * 10000ull / (rt ? rt : 1ull);
                const unsigned long long t0 = __builtin_amdgcn_s_memrealtime(); while (__builtin_amdgcn_s_memrealtime() - t0 < delay) __builtin_amdgcn_s_sleep(8);
            }
            bar_cls = kind != 1 ? 1 : 3; if (BOTH(pb)) GRID_BARC();
        }
        if (kind == 1 && IN(pb + 1)) {
          for (int rep = 0; rep < (((PROBE_DUP == 2 && layer < 2) || (PROBE_DUP == 3 && layer >= 2)) ? 2 : 1); ++rep) {
            if (rep) GRID_BAR();
            for (int p = vcid; p < 256; p += F.G) {
                const int bh = p >> 2, j = p & 3, b = bh >> 4, h = bh & 15;
                if (layer < 2) {
#pragma unroll 1
                    for (int uu = 0; uu < 2; ++uu) { asm volatile("" : "+v"(ltid)); att::stick_unit(QB, KB, VB, MIX, b, h, uu == 0 ? 7 - j : j, (char*)lds + RING_OFF, ltid); }
                } else { const float* bias = args.in[12] + ((size_t)(layer - 2) * NH + h) * 513;
#pragma unroll 1
                    for (int uu = 0; uu < 2; ++uu) { asm volatile("" : "+v"(ltid)); att::band_unit(QB, KB, VB, MIX, bias, b, h, uu == 0 ? 7 - j : j, (char*)lds + RING_OFF, ltid); }
                }
            }
          }
            bar_cls = 4; if (BOTH(pb + 1)) GRID_BARC();
        }
        if (IN(pb + 2)) {
            const bool ffn = kind != 1; const int f = 2 * layer + (kind >> 1);
            pg8::Gemm g{ffn ? ACT : MIX, ffn ? w_dn(ws, f) : w_mixo(ws, layer), M, DM, ffn ? FF : DM}; pg8::StaticOrder S; S.init(M, DM, F.G, cid);
          for (int rep = (((PROBE_DUP == 5 && ffn) || (PROBE_DUP == 7 && !ffn)) ? 0 : 1); rep < 2; ++rep) {
            const bool dummy = rep == 0;
            asm volatile("" : "+v"(ltid));
            pg8::EpiResid E{HB, HL, dummy ? (bf16*)(ws + WS_DUMMY + 64 * MiB) : HB, dummy ? (bf16*)(ws + WS_DUMMY) : HL, dummy ? (float*)(ws + WS_DUMMY + 96 * MiB) : SSQ, ffn ? 0.5f : 1.0f};
#if PROBE_DUP == 9
            pg8::EpiResid Ed{HB, HL, (bf16*)(ws + WS_DUMMY + 64 * MiB), (bf16*)(ws + WS_DUMMY), (float*)(ws + WS_DUMMY + 96 * MiB), ffn ? 0.5f : 1.0f};
            pg8::EpiTwice<pg8::EpiResid> E2{Ed, E};
            pg8::gemm_phase<pg8::EpiTwice<pg8::EpiResid>, pg8::StaticOrder, KN_ALIGN, KN_SP2>(F.lds + RING_OFF, g, S, E2, ltid);
#else
            pg8::gemm_phase<pg8::EpiResid, pg8::StaticOrder, KN_ALIGN, KN_SP2>(F.lds + RING_OFF, g, S, E, ltid);
#endif
            if (dummy) GRID_BAR();
          }
            bar_cls = ffn ? 2 : 5; if (BOTH(pb + 2)) GRID_BARC();
        }
    }
    if (PROBE_DUP == 13 && blockIdx.x == PROBE_BLK && F.tid == 0) { const unsigned long long bw_acc = *(volatile unsigned long long*)(ws + WS_CTL + 8192); const unsigned long long t0 = __builtin_amdgcn_s_memrealtime(); while (__builtin_amdgcn_s_memrealtime() - t0 < bw_acc) __builtin_amdgcn_s_sleep(8); }
    if (IN(37)) { final_norm(F, args); if (PROBE_DUP == 8) { GRID_BAR(); final_norm(F, args); } }
#undef IN
#undef BOTH
}

extern "C" void kernel_launch(void* const* d_in, const int* in_sizes, int n_in, void* d_out, int out_size, void* d_ws, size_t ws_size, hipStream_t stream) {
    static int grid = 0;
    if (grid == 0) {
        if (n_in != 14 || in_sizes[0] != M * DM || out_size != M * DM || ws_size < WS_END) { fprintf(stderr, "kernel_launch: shape mismatch: n_in %d in0 %d out %d ws %zu (need %zu)\n", n_in, n_in > 0 ? in_sizes[0] : -1, out_size, ws_size, (size_t)WS_END); grid = -1; return; }
        int dev = 0, cus = 0, per_cu = 0;
        if (hipGetDevice(&dev) != hipSuccess || hipDeviceGetAttribute(&cus, hipDeviceAttributeMultiprocessorCount, dev) != hipSuccess) { fprintf(stderr, "kernel_launch: device query failed\n"); grid = -1; return; }
        if (hipFuncSetAttribute((const void*)mega_fwd, hipFuncAttributeMaxDynamicSharedMemorySize, LDS_BYTES) != hipSuccess) { fprintf(stderr, "kernel_launch: hipFuncSetAttribute failed\n"); grid = -1; return; }
        if (hipOccupancyMaxActiveBlocksPerMultiprocessor(&per_cu, (const void*)mega_fwd, NWAVES * 64, LDS_BYTES) != hipSuccess || per_cu < 1) { fprintf(stderr, "kernel_launch: occupancy query reports %d workgroups per CU\n", per_cu); (void)hipGetLastError(); grid = -1; return; }
        grid = cus;
    }
    if (grid < 0) return;
    if (hipMemsetAsync((char*)d_ws + WS_CTL, 0, CTL_ZERO_BYTES, stream) != hipSuccess) { fprintf(stderr, "kernel_launch: hipMemsetAsync failed\n"); return; }
    Args a{};
    for (int i = 0; i < 14; ++i) a.in[i] = (const float*)d_in[i];
    a.out = (float*)d_out; a.ws = (unsigned char*)d_ws;
#if MK_PER_PHASE
    for (int ph = 0; ph < N_PHASES; ++ph) {
        if (ph >= 1 && ph <= 36) { const int s = (ph - 1) / 3, j = (ph - 1) % 3; if (j == 1 && (s % 3) != 1) continue; }
        a.ph_lo = ph; a.ph_hi = ph + 1;
        hipLaunchKernelGGL(mega_fwd, dim3(grid), dim3(NWAVES * 64), LDS_BYTES, stream, a);
    }
#else
    a.ph_lo = 0; a.ph_hi = N_PHASES;
    hipLaunchKernelGGL(mega_fwd, dim3(grid), dim3(NWAVES * 64), LDS_BYTES, stream, a);
#endif
    const hipError_t le = hipPeekAtLastError();
    if (le != hipSuccess) fprintf(stderr, "kernel_launch: launch failed: %s (grid %d)\n", hipGetErrorName(le), grid);
}
```
